# Optimizing an MI355X kernel written in HIP

```python
import math
import jax, jax.numpy as jnp
from jax import lax
import numpy as np

D_MODEL = 1024
BATCH = 8
SEQ = 2048
DEPTH = 1
DEC_BATCH = 128
DEC_SEQ = 4
PAST_LEN = 16384
PAGE_SIZE = 128

D_MIX = D_MODEL
D_POOL = D_MIX // 4
POOL_WINDOWS = (2, 4, 8, 16)
N_POOL_GROUPS = len(POOL_WINDOWS)
POOL_GW = D_POOL // N_POOL_GROUPS
POOL_BUF = max(POOL_WINDOWS) - 1
D_SSM = D_MIX - D_POOL
SSM_HEADDIM = 64
SSM_HEADS = D_SSM // SSM_HEADDIM
SSM_GROUPS = 2
SSM_HPG = SSM_HEADS // SSM_GROUPS
SSM_STATE = 128
CONV_W = 4
CONV_DIM = D_SSM + 2 * SSM_GROUPS * SSM_STATE
CHUNK = 128
D_IN = D_POOL + D_SSM + CONV_DIM + SSM_HEADS
N_MEM = 256
MEM_HEADS = 4
MEM_HD = D_MODEL // MEM_HEADS
D_FF = 2816
EPS = 1e-6

kernel_name = 'hybrid_pool_ssd_macaron_decode_step'


def rmsnorm(x, g):
    xf = x.astype(jnp.float32)
    y = xf * lax.rsqrt(jnp.mean(xf * xf, axis=-1, keepdims=True) + EPS)
    return (y * g.astype(jnp.float32)).astype(x.dtype)


def swiglu(h, w_gate, w_up, w_down):
    return (jax.nn.silu(h @ w_gate) * (h @ w_up)) @ w_down


def pool_mix(u, buf, start_pos, w_pool, pool_scale):
    b, t, _ = u.shape
    ext = jnp.concatenate([buf, u], axis=1)
    cs = jnp.cumsum(ext.astype(jnp.float32), axis=1)
    cs = jnp.concatenate([jnp.zeros_like(cs[:, :1]), cs], axis=1)
    pos = start_pos + jnp.arange(t)
    means = []
    for g, w in enumerate(POOL_WINDOWS):
        sl = slice(g * POOL_GW, (g + 1) * POOL_GW)
        hi = cs[:, POOL_BUF + 1:POOL_BUF + 1 + t, sl]
        lo = cs[:, POOL_BUF + 1 - w:POOL_BUF + 1 - w + t, sl]
        cnt = jnp.minimum(pos + 1, w).astype(jnp.float32)
        means.append((hi - lo) / cnt[None, :, None])
    mean = jnp.concatenate(means, axis=-1).astype(u.dtype)
    p = (mean - u).reshape(b, t, N_POOL_GROUPS, POOL_GW)
    out = jnp.einsum('btgc,gcd->btgd', p, w_pool).reshape(b, t, D_POOL) * pool_scale
    return out, ext[:, -POOL_BUF:]


def causal_conv(xbc, conv_buf, conv_w, conv_b):
    t = xbc.shape[1]
    ext = jnp.concatenate([conv_buf, xbc], axis=1)
    out = sum(ext[:, k:k + t] * conv_w[k] for k in range(CONV_W)) + conv_b
    return jax.nn.silu(out), ext[:, -(CONV_W - 1):]


def ssd_chunked(x, dt, a, bm, cm, h0, chunk):
    b, t = x.shape[:2]
    nc = t // chunk
    r = lambda z: z.reshape((b, nc, chunk) + z.shape[2:])
    xc, dtc, bc, cc = r(x), r(dt), r(bm), r(cm)
    acs = jnp.cumsum(dtc * a, axis=2)
    seg = acs[:, :, :, None] - acs[:, :, None, :]
    causal = (jnp.arange(chunk)[:, None] >= jnp.arange(chunk)[None, :])[None, None, :, :, None, None]
    decay = jnp.exp(jnp.where(causal, seg, -jnp.inf))
    scores = jnp.einsum('bclgn,bcsgn->bclsg', cc, bc)
    wgt = scores[..., None] * decay * dtc[:, :, None]
    y_diag = jnp.einsum('bclsgk,bcsgkp->bclgkp', wgt, xc)
    decay_end = jnp.exp(acs[:, :, -1:] - acs) * dtc
    states = jnp.einsum('bclgn,bclgk,bclgkp->bcgkpn', bc, decay_end, xc)
    chunk_decay = jnp.exp(acs[:, :, -1])

    def step(h, inp):
        st, dec = inp
        return h * dec[..., None, None] + st, h

    h_last, h_prev = lax.scan(step, h0, (jnp.moveaxis(states, 1, 0), jnp.moveaxis(chunk_decay, 1, 0)))
    h_prev = jnp.moveaxis(h_prev, 0, 1)
    y_off = jnp.einsum('bclgn,bcgkpn,bclgk->bclgkp', cc, h_prev, jnp.exp(acs))
    y = (y_diag + y_off).reshape(b, t, SSM_GROUPS, SSM_HPG, SSM_HEADDIM)
    return y, h_last


def token_mix(h, pool_buf, conv_buf, ssm_h0, start_pos, w_in, conv_w, conv_b, dt_bias, a_log,
              d_skip, ssm_norm, w_pool, pool_scale, w_out):
    b, t, _ = h.shape
    proj = h @ w_in
    u, z, xbc, dt_raw = jnp.split(proj, [D_POOL, D_POOL + D_SSM, D_POOL + D_SSM + CONV_DIM], axis=-1)
    pool_out, new_pool = pool_mix(u, pool_buf, start_pos, w_pool, pool_scale)
    xbc, new_conv = causal_conv(xbc, conv_buf, conv_w, conv_b)
    xs, bm, cm = jnp.split(xbc, [D_SSM, D_SSM + SSM_GROUPS * SSM_STATE], axis=-1)
    xs = xs.reshape(b, t, SSM_GROUPS, SSM_HPG, SSM_HEADDIM)
    bm = bm.reshape(b, t, SSM_GROUPS, SSM_STATE)
    cm = cm.reshape(b, t, SSM_GROUPS, SSM_STATE)
    dt = jax.nn.softplus(dt_raw.astype(jnp.float32) + dt_bias.astype(jnp.float32))
    dt = dt.reshape(b, t, SSM_GROUPS, SSM_HPG)
    a = -jnp.exp(a_log.astype(jnp.float32)).reshape(SSM_GROUPS, SSM_HPG)
    h0 = ssm_h0.astype(jnp.float32).reshape(b, SSM_GROUPS, SSM_HPG, SSM_HEADDIM, SSM_STATE)
    chunk = CHUNK if t % CHUNK == 0 else t
    y, h_last = ssd_chunked(xs, dt, a, bm, cm, h0, chunk)
    y = y + xs * d_skip.reshape(SSM_GROUPS, SSM_HPG, 1)
    y = y.reshape(b, t, D_SSM).astype(h.dtype)
    y = rmsnorm(y * jax.nn.silu(z), ssm_norm)
    out = jnp.concatenate([pool_out, y], axis=-1) @ w_out
    new_ssm = h_last.reshape(b, SSM_HEADS, SSM_HEADDIM, SSM_STATE)
    return out, new_pool, new_conv, new_ssm


def mem_kv(mem, g_mem, w_mem_k, w_mem_v):
    b = mem.shape[0]
    m = rmsnorm(mem, g_mem)
    k = (m @ w_mem_k).reshape(b, N_MEM, MEM_HEADS, MEM_HD)
    v = (m @ w_mem_v).reshape(b, N_MEM, MEM_HEADS, MEM_HD)
    return k, v


def cross_attn(h, k, v, w_xq, w_xo):
    b, t, _ = h.shape
    q = (h @ w_xq).reshape(b, t, MEM_HEADS, MEM_HD)
    s = jnp.einsum('bthd,bmhd->bhtm', q, k).astype(jnp.float32) * (MEM_HD ** -0.5)
    p = jax.nn.softmax(s, axis=-1).astype(v.dtype)
    o = jnp.einsum('bhtm,bmhd->bthd', p, v).reshape(b, t, D_MODEL)
    return o @ w_xo


def layer(x, k_mem, v_mem, pool_buf, conv_buf, ssm_h0, start_pos, lw):
    (g_ffn1, w1_gate, w1_up, w1_down, g_mix, w_in, conv_w, conv_b, dt_bias, a_log, d_skip,
     ssm_norm, w_pool, pool_scale, w_out, g_xq, w_xq, w_xo, g_ffn2, w2_gate, w2_up, w2_down) = lw
    x = x + 0.5 * swiglu(rmsnorm(x, g_ffn1), w1_gate, w1_up, w1_down)
    mix, new_pool, new_conv, new_ssm = token_mix(rmsnorm(x, g_mix), pool_buf, conv_buf, ssm_h0, start_pos,
                                                 w_in, conv_w, conv_b, dt_bias, a_log, d_skip, ssm_norm,
                                                 w_pool, pool_scale, w_out)
    x = x + mix
    x = x + cross_attn(rmsnorm(x, g_xq), k_mem, v_mem, w_xq, w_xo)
    x = x + 0.5 * swiglu(rmsnorm(x, g_ffn2), w2_gate, w2_up, w2_down)
    return x, new_pool, new_conv, new_ssm


def setup_inputs(seed: int = 0) -> dict:
    key = jax.random.key(seed)
    keys = iter(jax.random.split(key, 48))
    f32 = jnp.float32
    L = DEPTH

    def nrm(shape, scale):
        return jax.random.normal(next(keys), shape, f32) * scale

    def gain(shape):
        return 1.0 + 0.05 * jax.random.normal(next(keys), shape, f32)

    d = {}
    d['x_prompt'] = nrm((BATCH, SEQ, D_MODEL), 1.0)
    d['x_sample'] = nrm((DEC_BATCH, DEC_SEQ, D_MODEL), 1.0)
    d['mem_prompt'] = nrm((BATCH, N_MEM, D_MODEL), 1.0)
    d['cache_mem_k'] = nrm((L, DEC_BATCH, N_MEM, MEM_HEADS, MEM_HD), 1.0)
    d['cache_mem_v'] = nrm((L, DEC_BATCH, N_MEM, MEM_HEADS, MEM_HD), 1.0)
    d['state_pool'] = nrm((L, DEC_BATCH, POOL_BUF, D_POOL), 1.0)
    d['state_conv'] = nrm((L, DEC_BATCH, CONV_W - 1, CONV_DIM), 1.0)
    d['state_ssm'] = nrm((L, DEC_BATCH, SSM_HEADS, SSM_HEADDIM, SSM_STATE), 0.5)
    d['g_ffn1'] = gain((L, D_MODEL))
    d['w1_gate'] = nrm((L, D_MODEL, D_FF), D_MODEL ** -0.5)
    d['w1_up'] = nrm((L, D_MODEL, D_FF), D_MODEL ** -0.5)
    d['w1_down'] = nrm((L, D_FF, D_MODEL), D_FF ** -0.5)
    d['g_mix'] = gain((L, D_MODEL))
    d['w_in'] = nrm((L, D_MODEL, D_IN), D_MODEL ** -0.5)
    d['conv_w'] = nrm((L, CONV_W, CONV_DIM), CONV_W ** -0.5)
    d['conv_b'] = nrm((L, CONV_DIM), 0.02)
    dt0 = jnp.exp(jax.random.uniform(next(keys), (L, SSM_HEADS), f32, math.log(1e-3), math.log(1e-1)))
    d['dt_bias'] = dt0 + jnp.log(-jnp.expm1(-dt0))
    d['a_log'] = jnp.log(jax.random.uniform(next(keys), (L, SSM_HEADS), f32, 1.0, 16.0))
    d['d_skip'] = gain((L, SSM_HEADS))
    d['ssm_norm'] = gain((L, D_SSM))
    d['w_pool'] = nrm((L, N_POOL_GROUPS, POOL_GW, POOL_GW), POOL_GW ** -0.5)
    d['pool_scale'] = 0.5 + 0.1 * jax.random.normal(next(keys), (L, D_POOL), f32)
    d['w_out'] = nrm((L, D_MIX, D_MODEL), D_MIX ** -0.5)
    d['g_mem'] = gain((L, D_MODEL))
    d['w_mem_k'] = nrm((L, D_MODEL, D_MODEL), D_MODEL ** -0.5)
    d['w_mem_v'] = nrm((L, D_MODEL, D_MODEL), D_MODEL ** -0.5)
    d['g_xq'] = gain((L, D_MODEL))
    d['w_xq'] = nrm((L, D_MODEL, D_MODEL), D_MODEL ** -0.5)
    d['w_xo'] = nrm((L, D_MODEL, D_MODEL), D_MODEL ** -0.5)
    d['g_ffn2'] = gain((L, D_MODEL))
    d['w2_gate'] = nrm((L, D_MODEL, D_FF), D_MODEL ** -0.5)
    d['w2_up'] = nrm((L, D_MODEL, D_FF), D_MODEL ** -0.5)
    d['w2_down'] = nrm((L, D_FF, D_MODEL), D_FF ** -0.5)
    d['g_final'] = gain((D_MODEL,))
    return d


def reference(x_prompt, x_sample, mem_prompt, cache_mem_k, cache_mem_v, state_pool, state_conv, state_ssm,
              g_ffn1, w1_gate, w1_up, w1_down, g_mix, w_in, conv_w, conv_b, dt_bias, a_log, d_skip,
              ssm_norm, w_pool, pool_scale, w_out, g_mem, w_mem_k, w_mem_v, g_xq, w_xq, w_xo,
              g_ffn2, w2_gate, w2_up, w2_down, g_final):
    bp = x_prompt.shape[0]
    hp, hs = x_prompt, x_sample
    mk_p, mv_p, pool_p, conv_p, ssm_p = [], [], [], [], []
    pool_s, conv_s, ssm_s = [], [], []
    for l in range(DEPTH):
        lw = (g_ffn1[l], w1_gate[l], w1_up[l], w1_down[l], g_mix[l], w_in[l], conv_w[l], conv_b[l],
              dt_bias[l], a_log[l], d_skip[l], ssm_norm[l], w_pool[l], pool_scale[l], w_out[l],
              g_xq[l], w_xq[l], w_xo[l], g_ffn2[l], w2_gate[l], w2_up[l], w2_down[l])
        k_p, v_p = mem_kv(mem_prompt, g_mem[l], w_mem_k[l], w_mem_v[l])
        zero_pool = jnp.zeros((bp, POOL_BUF, D_POOL), x_prompt.dtype)
        zero_conv = jnp.zeros((bp, CONV_W - 1, CONV_DIM), x_prompt.dtype)
        zero_ssm = jnp.zeros((bp, SSM_HEADS, SSM_HEADDIM, SSM_STATE), jnp.float32)
        hp, pb, cb, sb = layer(hp, k_p, v_p, zero_pool, zero_conv, zero_ssm, 0, lw)
        mk_p.append(k_p)
        mv_p.append(v_p)
        pool_p.append(pb)
        conv_p.append(cb)
        ssm_p.append(sb)
        hs, pb2, cb2, sb2 = layer(hs, cache_mem_k[l], cache_mem_v[l], state_pool[l], state_conv[l],
                                  state_ssm[l], PAST_LEN, lw)
        pool_s.append(pb2)
        conv_s.append(cb2)
        ssm_s.append(sb2)
    y_prompt = rmsnorm(hp, g_final)
    y_sample = rmsnorm(hs, g_final)
    return (y_prompt, y_sample, jnp.stack(mk_p), jnp.stack(mv_p), jnp.stack(pool_p), jnp.stack(conv_p),
            jnp.stack(ssm_p), jnp.stack(pool_s), jnp.stack(conv_s), jnp.stack(ssm_s))
```

```cpp
#include <hip/hip_runtime.h>
#include <cstdio>
#include <cstdint>
#include <cmath>

#ifndef MK_N_LAUNCHES
#define MK_N_LAUNCHES 1
#endif

namespace pg8 {
#define PG8_LAS __attribute__((address_space(3)))
typedef unsigned short bf16_t;
typedef short bf16x8 __attribute__((ext_vector_type(8)));
typedef float f32x4 __attribute__((ext_vector_type(4)));
typedef unsigned u32x4 __attribute__((ext_vector_type(4)));
typedef unsigned u32x2 __attribute__((ext_vector_type(2)));
constexpr int BM = 256, BK = 64, HALF = 128, HTB = HALF * BK * 2  , STAGE_BYTES = 8 * HTB, NXCD = 8, WGM = 8;

__host__ __device__ __forceinline__ int lds_byte(int r, int c) { const int st = (r >> 4) * 2 + (c >> 5), rr = r & 15, cc = c & 31, ob = rr * 64 + cc * 2; return st * 1024 + (ob ^ (((ob >> 9) & 1) << 5)); }
__host__ __device__ __forceinline__ void stage_rc(int b, int& R, int& C) { const int st = b / 1024, sb = b % 1024, swz = sb ^ (((sb >> 9) & 1) << 5); R = (st >> 1) * 16 + swz / 64; C = (st & 1) * 32 + (swz % 64) / 2; }
__host__ __device__ __forceinline__ int perm32(int rho) { const int n = rho >> 4, i = rho & 15; return 8 * (i >> 2) + 4 * n + (i & 3); }

struct Unit { int pm, pn; };
struct Gemm { const bf16_t* A; const bf16_t* Bt; int M, N, K, lda, ldb; };

struct StaticOrder {
    int nM, nN, nwg, G, c;
    __host__ __device__ void init(int M, int N, int G_, int c_) { nM = M / BM; nN = N / BM; nwg = nM * nN; G = G_; c = c_; }
    __host__ __device__ bool next(int i, Unit& u) const {
        const long L = (long)i * G + c; if (L >= nwg) return false;
        int wgid = (int)L; { const int q = nwg / NXCD, r = nwg % NXCD, xcd = wgid % NXCD, off = wgid / NXCD; wgid = (xcd < r ? xcd * (q + 1) : r * (q + 1) + (xcd - r) * q) + off; }
        const int nig = WGM * nN, gid = wgid / nig, fm = gid * WGM, gsz = (nM - fm) < WGM ? (nM - fm) : WGM;
        u.pm = fm + ((wgid % nig) % gsz); u.pn = (wgid % nig) / gsz; return true;
    }
    __device__ __forceinline__ const char* abase(const Gemm& g, const Unit& u) const { return (const char*)g.A + (size_t)u.pm * 256 * g.lda * 2; }
    __device__ __forceinline__ const char* bbase(const Gemm& g, const Unit& u) const { return (const char*)g.Bt + (size_t)u.pn * 256 * g.ldb * 2; }
    __device__ __forceinline__ void a_ready(const Unit&) const {}
    __device__ __forceinline__ void done(const Unit&) const {}
};
struct OffsetOrder {
    int nM, nN, nwg, G, c;
    __device__ void init(int M, int N, int G_, int c_, int off) { nM = M / BM; nN = N / BM; nwg = nM * nN; G = G_; c = (c_ - off % G_ + G_) % G_; }
    __device__ bool next(int i, Unit& u) const { const long L = (long)i * G + c; if (L >= nwg) return false; u.pm = (int)L % nM; u.pn = (int)L / nM; return true; }
    __device__ __forceinline__ const char* abase(const Gemm& g, const Unit& u) const { return (const char*)g.A + (size_t)u.pm * 256 * g.lda * 2; }
    __device__ __forceinline__ const char* bbase(const Gemm& g, const Unit& u) const { return (const char*)g.Bt + (size_t)u.pn * 256 * g.ldb * 2; }
    __device__ __forceinline__ void a_ready(const Unit&) const {}
    __device__ __forceinline__ void done(const Unit&) const {}
};
template <int MODE> struct AttnOrder {
    int G, c;
    __device__ void init(int G_, int c_) { G = G_; c = c_; }
    __device__ bool next(int i, Unit& u) const { const long L = (long)i * G + c; if (L >= 256) return false; const int b = (int)L >> 5, h = ((int)L >> 3) & 3, qt = (int)L & 7; u.pm = 8 * b + qt; u.pn = h; return true; }
    __device__ __forceinline__ const char* abase(const Gemm& g, const Unit& u) const { return (const char*)g.A + ((size_t)u.pm * 256 * 1024 + (size_t)u.pn * 256) * 2; }
    __device__ __forceinline__ const char* bbase(const Gemm& g, const Unit& u) const {
        const int b = u.pm >> 3;
        if (MODE == 0) return (const char*)g.Bt + ((size_t)b * 256 * 1024 + (size_t)u.pn * 256) * 2;
        return (const char*)g.Bt + (size_t)(4 * b + u.pn) * 256 * 256 * 2;
    }
    __device__ __forceinline__ void a_ready(const Unit&) const {}
    __device__ __forceinline__ void done(const Unit&) const {}
};

__device__ __forceinline__ unsigned cvt_pk_bf16(float lo, float hi) { unsigned r; asm volatile("v_cvt_pk_bf16_f32 %0, %1, %2" : "=v"(r) : "v"(lo), "v"(hi)); return r; }
constexpr float RMS_EPS = 1e-6f;
__device__ __forceinline__ float rstd16(const float* ssq, int row) {
    const f32x4* p = (const f32x4*)(ssq + (size_t)row * 16); const f32x4 a = p[0], b = p[1], c = p[2], d = p[3];
    const float s = ((a[0] + a[1]) + (a[2] + a[3])) + ((b[0] + b[1]) + (b[2] + b[3])) + ((c[0] + c[1]) + (c[2] + c[3])) + ((d[0] + d[1]) + (d[2] + d[3]));
    return 1.0f / sqrtf(s * (1.0f / 1024.0f) + RMS_EPS);
}
__device__ __forceinline__ float silu_f(float x) { return x / (1.0f + __expf(-x)); }

struct EpiGateUp {
    static constexpr bool PERM = true, AFTER_DRAIN = false;
    bf16_t* O; int ldc; const float* ssq;
    __device__ __forceinline__ void operator()(const f32x4 (&acc)[2][2][4][2], const Unit& u, int wr, int wc, int fr, int fq) const {
        const int row0 = u.pm * BM + wr * 64 + fr, col0 = u.pn * HALF + wc * 32 + 8 * fq;
#pragma unroll
        for (int ai = 0; ai < 2; ++ai)
#pragma unroll
            for (int m = 0; m < 4; ++m) { const int r = row0 + ai * HALF + m * 16; const float rs = rstd16(ssq, r);
                f32x4 g0 = acc[ai][0][m][0] * rs, g1 = acc[ai][0][m][1] * rs, u0 = acc[ai][1][m][0] * rs, u1 = acc[ai][1][m][1] * rs;
                float o[8];
#pragma unroll
                for (int j = 0; j < 4; ++j) { o[j] = silu_f(g0[j]) * u0[j]; o[4 + j] = silu_f(g1[j]) * u1[j]; }
                u32x4 w; w.x = cvt_pk_bf16(o[0], o[1]); w.y = cvt_pk_bf16(o[2], o[3]); w.z = cvt_pk_bf16(o[4], o[5]); w.w = cvt_pk_bf16(o[6], o[7]);
                *(u32x4*)(O + (size_t)r * ldc + col0) = w; }
    }
};
struct EpiRowBf16 {
    static constexpr bool PERM = true, AFTER_DRAIN = false;
    bf16_t* O; int ldc; const float* ssq;
    __device__ __forceinline__ void operator()(const f32x4 (&acc)[2][2][4][2], const Unit& u, int wr, int wc, int fr, int fq) const {
        const int row0 = u.pm * BM + wr * 64 + fr, col0 = u.pn * BM + wc * 32 + 8 * fq;
#pragma unroll
        for (int ai = 0; ai < 2; ++ai)
#pragma unroll
            for (int m = 0; m < 4; ++m) { const int r = row0 + ai * HALF + m * 16; const float rs = ssq ? rstd16(ssq, r) : 1.0f; bf16_t* rowp = O + (size_t)r * ldc + col0;
#pragma unroll
                for (int bj = 0; bj < 2; ++bj) { const f32x4 v0 = acc[ai][bj][m][0] * rs, v1 = acc[ai][bj][m][1] * rs;
                    u32x4 w; w.x = cvt_pk_bf16(v0[0], v0[1]); w.y = cvt_pk_bf16(v0[2], v0[3]); w.z = cvt_pk_bf16(v1[0], v1[1]); w.w = cvt_pk_bf16(v1[2], v1[3]);
                    *(u32x4*)(rowp + bj * HALF) = w; } }
    }
};
struct EpiResid {
    static constexpr bool PERM = false, AFTER_DRAIN = false;
    const float* res; const float* res2; int split; float* out; bf16_t* outb; float alpha; const float* ssq_in; float* ssq_out;
    __device__ __forceinline__ void operator()(const f32x4 (&acc)[2][2][4][2], const Unit& u, int wr, int wc, int fr, int fq) const {
        const int row0 = u.pm * BM + wr * 64 + fr, col0 = u.pn * BM + wc * 32 + 4 * fq;
#pragma unroll
        for (int ai = 0; ai < 2; ++ai)
#pragma unroll
            for (int m = 0; m < 4; ++m) { const int r = row0 + ai * HALF + m * 16; const float sc = alpha * (ssq_in ? rstd16(ssq_in, r) : 1.0f);
                const float* rp = (r < split) ? res + (size_t)r * 1024 : res2 + (size_t)(r - split) * 1024; const size_t off = (size_t)r * 1024 + col0; float q = 0.f;
#pragma unroll
                for (int bj = 0; bj < 2; ++bj)
#pragma unroll
                    for (int n = 0; n < 2; ++n) { const int cc = bj * HALF + n * 16; const f32x4 bs = *(const f32x4*)(rp + col0 + cc); const f32x4 o = bs + acc[ai][bj][m][n] * sc;
                        *(f32x4*)(out + off + cc) = o; q += (o[0] * o[0] + o[1] * o[1]) + (o[2] * o[2] + o[3] * o[3]);
                        if (outb) { u32x2 w; w.x = cvt_pk_bf16(o[0], o[1]); w.y = cvt_pk_bf16(o[2], o[3]); *(u32x2*)(outb + off + cc) = w; } }
                q += __shfl_xor(q, 16); q += __shfl_xor(q, 32);
                if (fq == 0) ssq_out[(size_t)r * 16 + u.pn * 4 + wc] = q; }
    }
};
struct EpiMem {
    static constexpr bool PERM = false, AFTER_DRAIN = false;
    float* outk; float* outv; bf16_t* km; bf16_t* vt; const float* ssq;
    __device__ __forceinline__ void operator()(const f32x4 (&acc)[2][2][4][2], const Unit& u, int wr, int wc, int fr, int fq) const {
        const int row0 = u.pm * BM + wr * 64 + fr; const bool isv = u.pn >= 4; const int col0 = (u.pn & 3) * BM + wc * 32 + 4 * fq;
#pragma unroll
        for (int ai = 0; ai < 2; ++ai)
#pragma unroll
            for (int m = 0; m < 4; ++m) { const int r = row0 + ai * HALF + m * 16; const float rs = rstd16(ssq, r); const size_t off = (size_t)r * 1024 + col0;
#pragma unroll
                for (int bj = 0; bj < 2; ++bj)
#pragma unroll
                    for (int n = 0; n < 2; ++n) { const int cc = bj * HALF + n * 16; const f32x4 o = acc[ai][bj][m][n] * rs;
                        if (!isv) { *(f32x4*)(outk + off + cc) = o; u32x2 w; w.x = cvt_pk_bf16(o[0], o[1]); w.y = cvt_pk_bf16(o[2], o[3]); *(u32x2*)(km + off + cc) = w; }
                        else { *(f32x4*)(outv + off + cc) = o; const int b = r >> 8, mm = r & 255; const int c = col0 + cc; const int h = c >> 8, d = c & 255;
                            bf16_t* vp = vt + ((size_t)(4 * b + h) * 256 + d) * 256 + mm; const unsigned w0 = cvt_pk_bf16(o[0], o[1]), w1 = cvt_pk_bf16(o[2], o[3]);
                            vp[0] = (bf16_t)(w0 & 0xffffu); vp[256] = (bf16_t)(w0 >> 16); vp[512] = (bf16_t)(w1 & 0xffffu); vp[768] = (bf16_t)(w1 >> 16); } } }
    }
};
struct EpiSoftmax {
    static constexpr bool PERM = true, AFTER_DRAIN = true;
    bf16_t* P;
    __device__ __forceinline__ void fused(f32x4 (&acc)[2][2][4][2], const Unit& u, int wr, int wc, int fr, int fq, PG8_LAS unsigned char* lds, int wid, int lane) const {
        PG8_LAS float* red = (PG8_LAS float*)lds;
        PG8_LAS float* red2 = (PG8_LAS float*)(lds + 4096);
#pragma unroll
        for (int ai = 0; ai < 2; ++ai)
#pragma unroll
            for (int m = 0; m < 4; ++m) { float mx = -3.0e38f;
#pragma unroll
                for (int bj = 0; bj < 2; ++bj)
#pragma unroll
                    for (int n = 0; n < 2; ++n) { const f32x4 x = acc[ai][bj][m][n]; mx = fmaxf(mx, fmaxf(fmaxf(x[0], x[1]), fmaxf(x[2], x[3]))); }
                mx = fmaxf(mx, __shfl_xor(mx, 16)); mx = fmaxf(mx, __shfl_xor(mx, 32));
                if (fq == 0) red[(ai * HALF + wr * 64 + m * 16 + fr) * 4 + wc] = mx; }
        asm volatile("s_waitcnt lgkmcnt(0)" ::: "memory"); __builtin_amdgcn_s_barrier(); asm volatile("" ::: "memory");
#pragma unroll
        for (int ai = 0; ai < 2; ++ai)
#pragma unroll
            for (int m = 0; m < 4; ++m) { const int rr = ai * HALF + wr * 64 + m * 16 + fr; const f32x4 q = *(const PG8_LAS f32x4*)(red + rr * 4);
                const float mx = fmaxf(fmaxf(q[0], q[1]), fmaxf(q[2], q[3])); float s = 0.f;
#pragma unroll
                for (int bj = 0; bj < 2; ++bj)
#pragma unroll
                    for (int n = 0; n < 2; ++n) { f32x4 x = acc[ai][bj][m][n];
#pragma unroll
                        for (int j = 0; j < 4; ++j) { x[j] = __expf(x[j] - mx); s += x[j]; }
                        acc[ai][bj][m][n] = x; }
                s += __shfl_xor(s, 16); s += __shfl_xor(s, 32);
                if (fq == 0) red2[rr * 4 + wc] = s; }
        asm volatile("s_waitcnt lgkmcnt(0)" ::: "memory"); __builtin_amdgcn_s_barrier(); asm volatile("" ::: "memory");
        const int col0 = u.pn * BM + wc * 32 + 8 * fq;
#pragma unroll
        for (int ai = 0; ai < 2; ++ai)
#pragma unroll
            for (int m = 0; m < 4; ++m) { const int rr = ai * HALF + wr * 64 + m * 16 + fr; const f32x4 q = *(const PG8_LAS f32x4*)(red2 + rr * 4);
                const float inv = 1.0f / ((q[0] + q[1]) + (q[2] + q[3])); bf16_t* rowp = P + (size_t)(u.pm * BM + rr) * 1024 + col0;
#pragma unroll
                for (int bj = 0; bj < 2; ++bj) { const f32x4 v0 = acc[ai][bj][m][0] * inv, v1 = acc[ai][bj][m][1] * inv;
                    u32x4 w; w.x = cvt_pk_bf16(v0[0], v0[1]); w.y = cvt_pk_bf16(v0[2], v0[3]); w.z = cvt_pk_bf16(v1[0], v1[1]); w.w = cvt_pk_bf16(v1[2], v1[3]);
                    *(u32x4*)(rowp + bj * HALF) = w; } }
        asm volatile("s_waitcnt lgkmcnt(0)" ::: "memory"); __builtin_amdgcn_s_barrier(); asm volatile("" ::: "memory");
    }
};

template <class Epi, class Sched, bool ALIGN_EPI = false, bool SP2 = false>
__device__ __forceinline__ void gemm_phase(PG8_LAS unsigned char* lds, const Gemm g, const Sched& S, const Epi& E) {
    const int tid = threadIdx.x, wid = __builtin_amdgcn_readfirstlane(tid >> 6), lane = tid & 63, wr = wid >> 2, wc = wid & 3, fr = lane & 15, fq = lane >> 4;
    const int K = g.K, nt = K / BK;
    unsigned voffA[2], voffB[2];
#pragma unroll
    for (int i = 0; i < 2; ++i) { int R, C; stage_rc(tid * 16 + i * 8192, R, C); const int Rb = Epi::PERM ? ((R & ~31) + perm32(R & 31)) : R;
        voffA[i] = (unsigned)(R * g.lda + C) * 2u; voffB[i] = (unsigned)(Rb * g.ldb + C) * 2u; }
    const size_t kstep = (size_t)(BK * 2);
    const size_t hstepA = (size_t)HALF * g.lda * 2, hstepB = (size_t)HALF * g.ldb * 2;
    const unsigned ldsw = (unsigned)wid * 1024u;
    const int aoff = lds_byte(wr * 64 + fr, fq * 8), boff = lds_byte(wc * 32 + fr, fq * 8);
#define PG8_SA(b, h) (((b) * 2 + (h)) * HTB)
#define PG8_SB(b, h) ((4 + (b) * 2 + (h)) * HTB)
#define PG8_STAGE(bufoff, gbase, voff) do { _Pragma("unroll") for (int _i = 0; _i < 2; ++_i) \
        __builtin_amdgcn_global_load_lds((const unsigned*)((const char*)(gbase) + (voff)[_i]), (PG8_LAS unsigned*)(lds + (bufoff) + ldsw + _i * 8192), 16, 0, 0); } while (0)
#define PG8_LDA(dst, b, h) do { _Pragma("unroll") for (int m = 0; m < 4; ++m) _Pragma("unroll") for (int k = 0; k < 2; ++k) dst[m][k] = *(const PG8_LAS bf16x8*)(lds + PG8_SA(b, h) + aoff + m * 2048 + k * 1024); } while (0)
#define PG8_LDB(dst, b, h) do { _Pragma("unroll") for (int n = 0; n < 2; ++n) _Pragma("unroll") for (int k = 0; k < 2; ++k) dst[n][k] = *(const PG8_LAS bf16x8*)(lds + PG8_SB(b, h) + boff + n * 2048 + k * 1024); } while (0)
#define PG8_MMA(ai, bj, At, Bt) do { __builtin_amdgcn_s_setprio(1); _Pragma("unroll") for (int m = 0; m < 4; ++m) _Pragma("unroll") for (int n = 0; n < 2; ++n) _Pragma("unroll") for (int k = 0; k < 2; ++k) \
        acc[ai][bj][m][n] = __builtin_amdgcn_mfma_f32_16x16x32_bf16(Bt[n][k], At[m][k], acc[ai][bj][m][n], 0, 0, 0); __builtin_amdgcn_s_setprio(0); } while (0)
#define PG8_WAIT_V(n) asm volatile("s_waitcnt vmcnt(" #n ")" ::: "memory")
#define PG8_WAIT_L(n) asm volatile("s_waitcnt lgkmcnt(" #n ")" ::: "memory")
#define PG8_BAR __builtin_amdgcn_s_barrier()
#define PG8_SCHED __builtin_amdgcn_sched_barrier(0)
    Unit cur, nxt; int ui = 0;
    if (!S.next(0, cur)) return;
    f32x4 acc[2][2][4][2];
#pragma unroll
    for (int a = 0; a < 2; ++a)
#pragma unroll
        for (int b = 0; b < 2; ++b)
#pragma unroll
            for (int m = 0; m < 4; ++m)
#pragma unroll
                for (int n = 0; n < 2; ++n) acc[a][b][m][n] = (f32x4){0.f, 0.f, 0.f, 0.f};
    bf16x8 At[4][2], B0[2][2], B1[2][2];
    const char* cA = S.abase(g, cur); const char* cB = S.bbase(g, cur);
    S.a_ready(cur);
    if constexpr (SP2) {
        PG8_STAGE(PG8_SB(0, 0), cB, voffB); PG8_STAGE(PG8_SB(0, 1), cB + hstepB, voffB); PG8_STAGE(PG8_SA(0, 0), cA, voffA); PG8_STAGE(PG8_SA(0, 1), cA + hstepA, voffA);
        if (wr == 1) PG8_BAR;
        PG8_WAIT_V(2); PG8_BAR;
        PG8_STAGE(PG8_SB(1, 0), cB + kstep, voffB); PG8_STAGE(PG8_SA(1, 0), cA + kstep, voffA); PG8_STAGE(PG8_SB(1, 1), cB + hstepB + kstep, voffB);
        PG8_WAIT_V(6); PG8_BAR;
    } else {
        PG8_STAGE(PG8_SB(0, 0), cB, voffB); PG8_STAGE(PG8_SA(0, 0), cA, voffA); PG8_STAGE(PG8_SB(0, 1), cB + hstepB, voffB); PG8_STAGE(PG8_SA(0, 1), cA + hstepA, voffA);
        if (wr == 1) PG8_BAR;
        PG8_WAIT_V(4); PG8_BAR;
        PG8_STAGE(PG8_SB(1, 0), cB + kstep, voffB); PG8_STAGE(PG8_SA(1, 0), cA + kstep, voffA); PG8_STAGE(PG8_SB(1, 1), cB + hstepB + kstep, voffB);
        PG8_WAIT_V(6); PG8_BAR;
    }
    for (;;) {
        const bool has_next = S.next(ui + 1, nxt);
        const char* nA = has_next ? S.abase(g, nxt) : cA; const char* nB = has_next ? S.bbase(g, nxt) : cB;
        for (int t = 0; t < nt; t += 2) {
            const bool last = (t == nt - 2);
            const char* a1 = cA + (size_t)(t + 1) * kstep;
            const char* a2 = last ? nA : cA + (size_t)(t + 2) * kstep; const char* b2 = last ? nB : cB + (size_t)(t + 2) * kstep;
            const char* a3 = a2 + kstep; const char* b3 = b2 + kstep;
            if (last && has_next) S.a_ready(nxt);
            if constexpr (SP2) {
            PG8_LDB(B0, 0, 0); PG8_LDB(B1, 0, 1); PG8_SCHED; PG8_LDA(At, 0, 0); PG8_STAGE(PG8_SA(1, 1), a1 + hstepA, voffA);
            PG8_WAIT_V(8); PG8_WAIT_L(0); PG8_BAR; PG8_MMA(0, 0, At, B0); PG8_MMA(0, 1, At, B1); PG8_BAR; PG8_SCHED;
            PG8_LDA(At, 0, 1); PG8_STAGE(PG8_SB(0, 0), b2, voffB); PG8_STAGE(PG8_SB(0, 1), b2 + hstepB, voffB); PG8_STAGE(PG8_SA(0, 0), a2, voffA);
            PG8_WAIT_V(8); PG8_WAIT_L(0); PG8_BAR; PG8_MMA(1, 0, At, B0); PG8_MMA(1, 1, At, B1); PG8_BAR; PG8_SCHED;
            PG8_LDB(B0, 1, 0); PG8_LDB(B1, 1, 1); PG8_SCHED; PG8_LDA(At, 1, 0); PG8_STAGE(PG8_SA(0, 1), a2 + hstepA, voffA);
            PG8_WAIT_V(8); PG8_WAIT_L(0); PG8_BAR; PG8_MMA(0, 0, At, B0); PG8_MMA(0, 1, At, B1); PG8_BAR; PG8_SCHED;
            PG8_LDA(At, 1, 1); PG8_STAGE(PG8_SB(1, 0), b3, voffB); PG8_STAGE(PG8_SB(1, 1), b3 + hstepB, voffB); PG8_STAGE(PG8_SA(1, 0), a3, voffA);
            PG8_WAIT_V(8); PG8_WAIT_L(0); PG8_BAR; PG8_MMA(1, 0, At, B0); PG8_MMA(1, 1, At, B1); PG8_BAR; PG8_SCHED;
            } else {
            PG8_LDB(B0, 0, 0); PG8_SCHED; PG8_LDA(At, 0, 0); PG8_STAGE(PG8_SA(1, 1), a1 + hstepA, voffA);
            PG8_WAIT_L(8); PG8_BAR; PG8_WAIT_L(0); PG8_MMA(0, 0, At, B0); PG8_BAR; PG8_SCHED;
            PG8_LDB(B1, 0, 1); PG8_STAGE(PG8_SB(0, 0), b2, voffB);
            PG8_BAR; PG8_WAIT_L(0); PG8_MMA(0, 1, At, B1); PG8_BAR;
            PG8_LDA(At, 0, 1); PG8_STAGE(PG8_SA(0, 0), a2, voffA);
            PG8_BAR; PG8_WAIT_L(0); PG8_MMA(1, 0, At, B0); PG8_BAR; PG8_SCHED;
            PG8_STAGE(PG8_SB(0, 1), b2 + hstepB, voffB);
            PG8_WAIT_V(6); PG8_BAR; PG8_MMA(1, 1, At, B1); PG8_BAR;
            PG8_LDB(B0, 1, 0); PG8_SCHED; PG8_LDA(At, 1, 0); PG8_STAGE(PG8_SA(0, 1), a2 + hstepA, voffA);
            PG8_WAIT_L(8); PG8_BAR; PG8_WAIT_L(0); PG8_MMA(0, 0, At, B0); PG8_BAR; PG8_SCHED;
            PG8_LDB(B1, 1, 1); PG8_STAGE(PG8_SB(1, 0), b3, voffB);
            PG8_BAR; PG8_WAIT_L(0); PG8_MMA(0, 1, At, B1); PG8_BAR;
            PG8_LDA(At, 1, 1); PG8_STAGE(PG8_SA(1, 0), a3, voffA);
            PG8_BAR; PG8_WAIT_L(0); PG8_MMA(1, 0, At, B0); PG8_BAR; PG8_SCHED;
            PG8_STAGE(PG8_SB(1, 1), b3 + hstepB, voffB);
            PG8_WAIT_V(6); PG8_BAR; PG8_MMA(1, 1, At, B1); PG8_BAR;
            }
        }
        if constexpr (ALIGN_EPI) { if (wr == 0) PG8_BAR; }
        if constexpr (!Epi::AFTER_DRAIN) { E(acc, cur, wr, wc, fr, fq); S.done(cur); }
        if (!has_next) break;
#pragma unroll
        for (int a = 0; a < 2; ++a)
#pragma unroll
            for (int b = 0; b < 2; ++b)
#pragma unroll
                for (int m = 0; m < 4; ++m)
#pragma unroll
                    for (int n = 0; n < 2; ++n) acc[a][b][m][n] = (f32x4){0.f, 0.f, 0.f, 0.f};
        cur = nxt; cA = nA; cB = nB; ++ui;
        if constexpr (ALIGN_EPI) { if (wr == 1) PG8_BAR; }
    }
    PG8_WAIT_V(0);
    if constexpr (!ALIGN_EPI) { if (wr == 0) PG8_BAR; }
    PG8_BAR;
    if constexpr (Epi::AFTER_DRAIN) { E.fused(acc, cur, wr, wc, fr, fq, lds, wid, lane); S.done(cur); }
#undef PG8_SA
#undef PG8_SB
#undef PG8_STAGE
#undef PG8_LDA
#undef PG8_LDB
#undef PG8_MMA
#undef PG8_WAIT_V
#undef PG8_WAIT_L
#undef PG8_BAR
#undef PG8_SCHED
}
}

constexpr int NWAVES = 8, NTHREADS = 512;
constexpr int N_PHASES = 15;
constexpr int N_LAUNCHES = MK_N_LAUNCHES;
constexpr int D = 1024, FF = 2816, NGU = 2 * FF, NIN = 2304, D_INP = 2316;
constexpr int BATCH = 8, SEQ = 2048, MP = BATCH * SEQ, DEC_B = 128, DEC_T = 4, MS = DEC_B * DEC_T, M = MP + MS;
constexpr int D_POOL = 256, D_SSM = 768, NH = 12, HD = 64, NST = 128, CONV_DIM = 1280, CHUNK = 128, NCH = SEQ / CHUNK;
constexpr int XBC0 = 1024;
constexpr int NMEM = 256, MEMROWS = BATCH * NMEM;
constexpr float EPS = 1e-6f;

constexpr size_t MiB = 1u << 20;
constexpr size_t WS_CTL = 0, CTL_ZERO_BYTES = 1 * MiB;
constexpr size_t WS_W1GU = 2 * MiB, WS_W1D = 13 * MiB, WS_WIN = 19 * MiB, WS_WOUT = 24 * MiB, WS_WQ = 26 * MiB, WS_WO = 28 * MiB, WS_WMKV = 30 * MiB, WS_W2GU = 34 * MiB, WS_W2D = 45 * MiB, WS_WDT = 51 * MiB;
constexpr size_t WS_SSQ0 = 52 * MiB, WS_SSQ1 = 54 * MiB, WS_SSQY = 56 * MiB, WS_SSQ2 = 58 * MiB, WS_SSQ3 = 60 * MiB, WS_SSQ4 = 62 * MiB, WS_SSQM = 64 * MiB;
constexpr size_t WS_EXPA = 65 * MiB, WS_CD = 66 * MiB;
constexpr size_t WS_MBF = 68 * MiB, WS_KM = 72 * MiB, WS_VT = 76 * MiB;
constexpr size_t WS_XB = 80 * MiB;
constexpr size_t WS_X = 114 * MiB;
constexpr size_t WS_A2 = 180 * MiB;
constexpr size_t WS_ACT = 214 * MiB;
constexpr size_t WS_YD = 214 * MiB, WS_ST = 262 * MiB;
constexpr size_t WS_PROJ = 310 * MiB;
constexpr size_t WS_Q = 310 * MiB, WS_PB = 343 * MiB;
constexpr size_t WS_HP = 385 * MiB, WS_CB = 409 * MiB;
constexpr size_t WS_O = 385 * MiB;
constexpr size_t WS_END = 420 * MiB;
static_assert(WS_W1GU + (size_t)NGU * D * 2 <= WS_W1D && WS_W1D + (size_t)D * FF * 2 <= WS_WIN && WS_WIN + (size_t)NIN * D * 2 <= WS_WOUT && WS_W2GU + (size_t)NGU * D * 2 <= WS_W2D && WS_W2D + (size_t)D * FF * 2 <= WS_WDT, "weights map");
static_assert(WS_SSQ0 + (size_t)M * 64 <= WS_SSQ1 && WS_XB + (size_t)M * D * 2 <= WS_X && WS_X + (size_t)M * D * 4 <= WS_A2 && WS_A2 + (size_t)M * D * 2 <= WS_ACT, "ws map 1");
static_assert(WS_ACT + (size_t)M * FF * 2 <= WS_PROJ && WS_YD + (size_t)MP * D_SSM * 4 <= WS_ST && WS_ST + (size_t)BATCH * NCH * NH * HD * NST * 4 <= WS_PROJ, "ws map 2");
static_assert(WS_PROJ + (size_t)M * NIN * 2 <= WS_HP && WS_Q + (size_t)M * D * 2 <= WS_PB && WS_PB + (size_t)MP * D * 2 <= WS_HP, "ws map 3");
static_assert(WS_HP + (size_t)BATCH * NCH * NH * HD * NST * 2 <= WS_CB && WS_CB + (size_t)MP * 256 * 2 <= WS_END && WS_O + (size_t)M * D * 2 <= WS_END, "ws map 4");
constexpr int CW_BAR = 4096;

constexpr size_t OUT_Y = 0, OUT_MK = (size_t)M * D, OUT_MV = OUT_MK + (size_t)MEMROWS * D, OUT_POOLP = OUT_MV + (size_t)MEMROWS * D, OUT_CONVP = OUT_POOLP + (size_t)BATCH * 15 * D_POOL,
    OUT_SSMP = OUT_CONVP + (size_t)BATCH * 3 * CONV_DIM, OUT_POOLS = OUT_SSMP + (size_t)BATCH * NH * HD * NST, OUT_CONVS = OUT_POOLS + (size_t)DEC_B * 15 * D_POOL, OUT_SSMS = OUT_CONVS + (size_t)DEC_B * 3 * CONV_DIM,
    OUT_TOTAL = OUT_SSMS + (size_t)DEC_B * NH * HD * NST;
static_assert(OUT_TOTAL == 35909632, "output size");

constexpr int RING_OFF = 0, RING_BYTES = 131072;
constexpr int LDSCTL_OFF = RING_BYTES, MISC_OFF = LDSCTL_OFF + 320;
constexpr int LDS_BYTES = 147456;
static_assert(MISC_OFF + 128 <= LDS_BYTES, "LDS map");

#define GAS __attribute__((address_space(1)))
#define LAS __attribute__((address_space(3)))
typedef unsigned short bf16;
typedef unsigned v4u __attribute__((ext_vector_type(4)));
typedef unsigned v2u __attribute__((ext_vector_type(2)));
typedef float f32x4 __attribute__((ext_vector_type(4)));
typedef short bf16x8 __attribute__((ext_vector_type(8)));
typedef GAS unsigned gu32;
#define RLX_AGENT __ATOMIC_RELAXED, __HIP_MEMORY_SCOPE_AGENT
#define LDS_WAIT() asm volatile("s_waitcnt lgkmcnt(0)" ::: "memory")
#define VM_WAIT() asm volatile("s_waitcnt vmcnt(0)" ::: "memory")
__device__ __forceinline__ unsigned f2bf(float f) { unsigned u = __builtin_bit_cast(unsigned, f); return (u + 0x7fffu + ((u >> 16) & 1u)) >> 16; }
__device__ __forceinline__ unsigned pk2(float lo, float hi) { return f2bf(lo) | (f2bf(hi) << 16); }
__device__ __forceinline__ float bf2f(unsigned b) { return __builtin_bit_cast(float, (b & 0xffffu) << 16); }
__device__ __forceinline__ float bflo(unsigned w) { return __builtin_bit_cast(float, w << 16); }
__device__ __forceinline__ float bfhi(unsigned w) { return __builtin_bit_cast(float, w & 0xffff0000u); }
__device__ __forceinline__ float siluf(float x) { return x / (1.0f + __expf(-x)); }
__device__ __forceinline__ float softplusf(float x) { return fmaxf(x, 0.f) + log1pf(__expf(-fabsf(x))); }
__device__ __forceinline__ float wave_sum(float v) {
#pragma unroll
    for (int o = 1; o < 64; o <<= 1) v += __shfl_xor(v, o);
    return v;
}
#define WG_BAR() do { asm volatile("s_waitcnt vmcnt(0) lgkmcnt(0)" ::: "memory"); __builtin_amdgcn_s_barrier(); asm volatile("" ::: "memory"); } while (0)
#define MFMA16(a, b, c) __builtin_amdgcn_mfma_f32_16x16x32_bf16((a), (b), (c), 0, 0, 0)

#define XB_TMO      128
#define XB_XCNT(j)  (256  + 64 * (j))
#define XB_XSUB(j)  (1280 + 64 * (j))
#define XB_XGEN(j)  (2304 + 64 * (j))
#define XB_TOP      3328
#define XB_TOPGEN   3392
#define XCD_BAR_WORDS 3456
#define XB_SPIN_CAP (1u << 18)

__device__ __forceinline__ unsigned xb_ld(unsigned* p)              { return __hip_atomic_load(p, __ATOMIC_RELAXED, __HIP_MEMORY_SCOPE_AGENT); }
__device__ __forceinline__ unsigned xb_add(unsigned* p, unsigned v) { return __hip_atomic_fetch_add(p, v, __ATOMIC_RELAXED, __HIP_MEMORY_SCOPE_AGENT); }
__device__ __forceinline__ unsigned xb_xcc_id() { return (unsigned)__builtin_amdgcn_s_getreg((3 << 11) | 20) & 0xFu; }
#define XB_SPIN(cond, bar) do { unsigned _sp = 0; while (cond) { __builtin_amdgcn_s_sleep(1); \
    if ((++_sp & 255u) == 0u) { if (xb_ld(&(bar)[XB_TMO])) break; if (_sp > XB_SPIN_CAP) { atomicAdd(&(bar)[XB_TMO], 1u); break; } } } } while (0)

struct XcdBarrier {
    unsigned* bar; unsigned x;
    volatile LAS unsigned* st;
};

__device__ __forceinline__ XcdBarrier xcd_barrier_post(unsigned* bar, volatile LAS unsigned* st) {
    XcdBarrier b; b.bar = bar; b.x = xb_xcc_id(); b.st = st;
    if (threadIdx.x == 0) (void)xb_add(&bar[XB_XCNT(b.x)], 1u);
    return b;
}
__device__ __forceinline__ void xcd_barrier_complete(unsigned* bar, unsigned x, unsigned& nloc, unsigned& nx) {
    const unsigned G = gridDim.x * gridDim.y * gridDim.z;
    unsigned sum, cnt, mine, sp = 0u;
    for (;;) {
        sum = 0u; cnt = 0u; mine = 0u;
#pragma unroll
        for (unsigned j = 0; j < 16; ++j) { const unsigned c = xb_ld(&bar[XB_XCNT(j)]); sum += c; cnt += (c > 0u) ? 1u : 0u; mine = (j == x) ? c : mine; }
        if (sum == G) break;
        __builtin_amdgcn_s_sleep(1);
        if ((++sp & 255u) == 0u) { if (xb_ld(&bar[XB_TMO])) break; if (sp > XB_SPIN_CAP) { atomicAdd(&bar[XB_TMO], 1u); break; } }
    }
    nloc = mine > 0u ? mine : 1u; nx = cnt > 0u ? cnt : 1u;
}

__device__ __forceinline__ void xcd_barrier(const XcdBarrier& b) {
    asm volatile("s_waitcnt vmcnt(0)" ::: "memory");
    __syncthreads();
    if (threadIdx.x == 0) {
        unsigned* bar = b.bar;
        __builtin_amdgcn_s_waitcnt(0);
        unsigned nloc = b.st[0], nx = b.st[1];
        if (nloc == 0u) { xcd_barrier_complete(bar, b.x, nloc, nx); b.st[0] = nloc; b.st[1] = nx; }
        const unsigned old = xb_add(&bar[XB_XSUB(b.x)], 1u);
        const unsigned gen = old / nloc;
        if (old + 1u == (gen + 1u) * nloc) {
            __builtin_amdgcn_fence(__ATOMIC_RELEASE, "agent");
            asm volatile("s_waitcnt vmcnt(0)" ::: "memory");
            const unsigned og = xb_add(&bar[XB_TOP], 1u);
            const unsigned tg = og / nx;
            if (og + 1u == (tg + 1u) * nx) xb_add(&bar[XB_TOPGEN], 1u);
            else XB_SPIN(xb_ld(&bar[XB_TOPGEN]) == tg, bar);
            __builtin_amdgcn_fence(__ATOMIC_ACQUIRE, "agent");
            xb_add(&bar[XB_XGEN(b.x)], 1u);
            asm volatile("s_waitcnt vmcnt(0)" ::: "memory");
        } else {
            XB_SPIN(xb_ld(&bar[XB_XGEN(b.x)]) == gen, bar);
            __builtin_amdgcn_fence(__ATOMIC_ACQUIRE, "agent");
            asm volatile("s_waitcnt vmcnt(0)" ::: "memory");
        }
    }
    __syncthreads();
}

struct Frame {
    LAS unsigned char* lds;
    volatile LAS unsigned* MISC;
    gu32* ctl;
    int tid, lane, wave, G, bid;
    LAS unsigned* ptab;
    float* out; unsigned char* ws;
};
__device__ __forceinline__ const float* ld_inp(const Frame& F, int i) {
    const unsigned lo = __builtin_amdgcn_readfirstlane(F.ptab[2 * i]), hi = __builtin_amdgcn_readfirstlane(F.ptab[2 * i + 1]);
    return (const float*)(const GAS float*)(((unsigned long long)hi << 32) | lo);
}
#define INP(i) ld_inp(F, (i))
enum { I_XP = 0, I_XS, I_MEMP, I_CK, I_CV, I_SPOOL, I_SCONV, I_SSSM, I_GFFN1, I_W1G, I_W1U, I_W1D, I_GMIX, I_WIN, I_CONVW, I_CONVB, I_DTB, I_ALOG, I_DSKIP, I_SSMN, I_WPOOL, I_PSCALE, I_WOUT,
       I_GMEM, I_WMK, I_WMV, I_GXQ, I_WXQ, I_WXO, I_GFFN2, I_W2G, I_W2U, I_W2D, I_GFIN };
#define WSP(T, off) ((T*)(F.ws + (off)))

__device__ __forceinline__ void p0_transpose_item(const float* W, int ldw, int N, bf16* WT, int ldt, int kdst, int rowmode, int row_off, const float* gain, float scale, LAS float* scr, int item, int lane) {
    const int nblk = N / 32, kb = item / nblk, nb = item % nblk, k0 = 64 * kb, n0 = 32 * nb;
#pragma unroll 8
    for (int i = 0; i < 32; ++i) { const int kk = 2 * i + (lane >> 5); const float gsc = (gain ? gain[k0 + kk] : 1.0f) * scale; scr[kk * 33 + (lane & 31)] = W[(size_t)(k0 + kk) * ldw + n0 + (lane & 31)] * gsc; }
    LDS_WAIT(); asm volatile("" ::: "memory");
    const int rowf = rowmode == 0 ? row_off + n0 : (n0 >> 7) * 256 + (rowmode == 2 ? 128 : 0) + (n0 & 127);
    const int c = lane & 7;
#pragma unroll
    for (int j = 0; j < 4; ++j) { const int n = (lane >> 3) + 8 * j; const LAS float* s = scr + (8 * c) * 33 + n;
        v4u o; o.x = pk2(s[0 * 33], s[1 * 33]); o.y = pk2(s[2 * 33], s[3 * 33]); o.z = pk2(s[4 * 33], s[5 * 33]); o.w = pk2(s[6 * 33], s[7 * 33]);
        *(GAS v4u*)(WT + (size_t)(rowf + n) * ldt + kdst + k0 + 8 * c) = o; }
    LDS_WAIT(); asm volatile("" ::: "memory");
}
__device__ __forceinline__ void row_to_bf16_ssq(const float* xrow, bf16* orow, float* ssq16, int lane) {
    const GAS f32x4* xr = (const GAS f32x4*)xrow + lane;
    f32x4 v[4]; float s = 0.f;
#pragma unroll
    for (int j = 0; j < 4; ++j) { v[j] = xr[64 * j]; s += (v[j].x * v[j].x + v[j].y * v[j].y) + (v[j].z * v[j].z + v[j].w * v[j].w); }
    s = wave_sum(s);
    GAS unsigned long long* o8 = (GAS unsigned long long*)orow + lane;
#pragma unroll
    for (int j = 0; j < 4; ++j) o8[64 * j] = (unsigned long long)pk2(v[j].x, v[j].y) | ((unsigned long long)pk2(v[j].z, v[j].w) << 32);
    if (lane < 16) ssq16[lane] = lane == 0 ? s : 0.f;
}
__device__ __forceinline__ void p0_prologue(Frame& F) {
    LAS float* scr = (LAS float*)(F.lds + RING_OFF + F.wave * 16384);
    const int gw = F.bid * NWAVES + F.wave, NGW = F.G * NWAVES, lane = F.lane;
    constexpr int I_GU = (D / 64) * (FF / 32), I_DN = (FF / 64) * (D / 32), I_IN = (D / 64) * (NIN / 32), I_OUT = (D_SSM / 64) * (D / 32), I_SQ = (D / 64) * (D / 32);
    constexpr int NT = 4 * I_GU + 2 * I_DN + I_IN + I_OUT + 4 * I_SQ;
    for (int it = gw; it < NT; it += NGW) {
        int r = it;
        if (r < I_GU) { p0_transpose_item(INP(I_W1G), FF, FF, WSP(bf16, WS_W1GU), D, 0, 1, 0, INP(I_GFFN1), 1.f, scr, r, lane); continue; } r -= I_GU;
        if (r < I_GU) { p0_transpose_item(INP(I_W1U), FF, FF, WSP(bf16, WS_W1GU), D, 0, 2, 0, INP(I_GFFN1), 1.f, scr, r, lane); continue; } r -= I_GU;
        if (r < I_GU) { p0_transpose_item(INP(I_W2G), FF, FF, WSP(bf16, WS_W2GU), D, 0, 1, 0, INP(I_GFFN2), 1.f, scr, r, lane); continue; } r -= I_GU;
        if (r < I_GU) { p0_transpose_item(INP(I_W2U), FF, FF, WSP(bf16, WS_W2GU), D, 0, 2, 0, INP(I_GFFN2), 1.f, scr, r, lane); continue; } r -= I_GU;
        if (r < I_DN) { p0_transpose_item(INP(I_W1D), D, D, WSP(bf16, WS_W1D), FF, 0, 0, 0, nullptr, 1.f, scr, r, lane); continue; } r -= I_DN;
        if (r < I_DN) { p0_transpose_item(INP(I_W2D), D, D, WSP(bf16, WS_W2D), FF, 0, 0, 0, nullptr, 1.f, scr, r, lane); continue; } r -= I_DN;
        if (r < I_IN) { p0_transpose_item(INP(I_WIN), D_INP, NIN, WSP(bf16, WS_WIN), D, 0, 0, 0, INP(I_GMIX), 1.f, scr, r, lane); continue; } r -= I_IN;
        if (r < I_OUT) { p0_transpose_item(INP(I_WOUT) + (size_t)D_POOL * D, D, D, WSP(bf16, WS_WOUT), D, D_POOL, 0, 0, INP(I_SSMN), 1.f, scr, r, lane); continue; } r -= I_OUT;
        if (r < I_SQ) { p0_transpose_item(INP(I_WXQ), D, D, WSP(bf16, WS_WQ), D, 0, 0, 0, INP(I_GXQ), 0.0625f, scr, r, lane); continue; } r -= I_SQ;
        if (r < I_SQ) { p0_transpose_item(INP(I_WXO), D, D, WSP(bf16, WS_WO), D, 0, 0, 0, nullptr, 1.f, scr, r, lane); continue; } r -= I_SQ;
        if (r < I_SQ) { p0_transpose_item(INP(I_WMK), D, D, WSP(bf16, WS_WMKV), D, 0, 0, 0, INP(I_GMEM), 1.f, scr, r, lane); continue; } r -= I_SQ;
        p0_transpose_item(INP(I_WMV), D, D, WSP(bf16, WS_WMKV), D, 0, 0, D, INP(I_GMEM), 1.f, scr, r, lane);
    }
    { const float* wp = INP(I_WPOOL); const float* ps = INP(I_PSCALE); const float* wo = INP(I_WOUT); bf16* WT = WSP(bf16, WS_WOUT);
        for (int it = gw; it < D * 4; it += NGW) { const int n = it >> 2, g = it & 3; float acc = 0.f; const float* wrow = wp + (size_t)(g * 64 + lane) * 64;
#pragma unroll 8
            for (int d = 0; d < 64; ++d) acc += wrow[d] * (ps[g * 64 + d] * wo[(size_t)(g * 64 + d) * D + n]);
            WT[(size_t)n * D + g * 64 + lane] = (bf16)f2bf(acc); } }
    { float* wdt = WSP(float, WS_WDT); const float* win = INP(I_WIN); const float* gm = INP(I_GMIX);
        for (int i = F.bid * NTHREADS + F.tid; i < NH * D; i += F.G * NTHREADS) { const int h = i >> 10, k = i & 1023; wdt[i] = gm[k] * win[(size_t)k * D_INP + NIN + h]; } }
    for (int m = gw; m < M; m += NGW) { const float* xr = m < MP ? INP(I_XP) + (size_t)m * D : INP(I_XS) + (size_t)(m - MP) * D; row_to_bf16_ssq(xr, WSP(bf16, WS_XB) + (size_t)m * D, WSP(float, WS_SSQ0) + (size_t)m * 16, lane); }
    for (int m = gw; m < MEMROWS; m += NGW) row_to_bf16_ssq(INP(I_MEMP) + (size_t)m * D, WSP(bf16, WS_MBF) + (size_t)m * D, WSP(float, WS_SSQM) + (size_t)m * 16, lane);
}

constexpr int MX_PITCHB = 272;
constexpr int MX_TILE = 128 * MX_PITCHB;
constexpr int MX_RC = 0, MX_RB = MX_TILE, MX_RBT = 2 * MX_TILE, MX_RAW = 3 * MX_TILE, MX_DT = MX_RAW + 17408, MX_ACS = MX_DT + 3072, MX_DE = MX_ACS + 3072, MX_END = MX_DE + 3072;
static_assert(MX_END <= RING_BYTES && 131 * 132 <= 17408, "mix LDS map");

__device__ __forceinline__ void stage_raw(Frame& F, const bf16* PROJ, int b, int t0, int col) {
    LAS unsigned* raw = (LAS unsigned*)(F.lds + MX_RAW);
    for (int pc = F.tid; pc < 131 * 8; pc += NTHREADS) { const int rr = pc >> 3, ch = pc & 7, t = t0 - 3 + rr;
        v4u v = (v4u){0u, 0u, 0u, 0u}; if (t >= 0) v = *(const v4u*)(PROJ + ((size_t)b * SEQ + t) * NIN + col + ch * 8);
        LAS unsigned* d = raw + rr * 33 + ch * 4; d[0] = v.x; d[1] = v.y; d[2] = v.z; d[3] = v.w; }
}
__device__ __forceinline__ void conv16(Frame& F, const float* cw, const float* cb, int cx, int l0, float (&v)[16]) {
    const LAS unsigned short* raw = (const LAS unsigned short*)(F.lds + MX_RAW); const int cn = F.tid & 63;
    const float w0 = cw[cx], w1 = cw[CONV_DIM + cx], w2 = cw[2 * CONV_DIM + cx], w3 = cw[3 * CONV_DIM + cx], bb = cb[cx];
    float in[19];
#pragma unroll
    for (int i = 0; i < 19; ++i) in[i] = bf2f(raw[(l0 + i) * 66 + cn]);
#pragma unroll
    for (int j = 0; j < 16; ++j) v[j] = siluf(in[j] * w0 + in[j + 1] * w1 + in[j + 2] * w2 + in[j + 3] * w3 + bb);
}
template <int W> __device__ __forceinline__ void pool_prompt_chunk(const bf16* PROJ, bf16* A2, float* outp, int b, int t0, int l0, int ucol, bool last_chunk) {
    const size_t rowbase = (size_t)b * SEQ;
    float v[31 + W];
#pragma unroll
    for (int i = 0; i < 31 + W; ++i) { const int t = t0 + l0 - (W - 1) + i; v[i] = t >= 0 ? bf2f(PROJ[(rowbase + t) * NIN + ucol]) : 0.f; }
#pragma unroll
    for (int i = 0; i < 32; ++i) { float s = 0.f;
#pragma unroll
        for (int j = 0; j < W; ++j) s += v[i + j];
        const int t = t0 + l0 + i; const float cnt = (float)(t + 1 < W ? t + 1 : W);
        const float u = v[i + W - 1], p = s / cnt - u;
        A2[(rowbase + t) * D + ucol] = (bf16)f2bf(p);
        if (last_chunk && t >= SEQ - 15) outp[((size_t)b * 15 + (t - (SEQ - 15))) * D_POOL + ucol] = u; }
}
__device__ __forceinline__ v4u pack8(const float* v) { v4u o; o.x = pk2(v[0], v[1]); o.y = pk2(v[2], v[3]); o.z = pk2(v[4], v[5]); o.w = pk2(v[6], v[7]); return o; }

__device__ __forceinline__ void mix_prompt_item(Frame& F, int b, int c, int g) {
    const int tid = F.tid, lane = F.lane, w = F.wave, fr = lane & 15, fq = lane >> 4;
    const int t0 = c * CHUNK; const size_t row0 = (size_t)b * SEQ + t0;
    const bf16* PROJ = WSP(const bf16, WS_PROJ); const float* X = WSP(const float, WS_X); const float* SSQ1 = WSP(const float, WS_SSQ1); const float* WDT = WSP(const float, WS_WDT);
    float* EXPA = WSP(float, WS_EXPA); float* CDp = WSP(float, WS_CD); bf16* CB = WSP(bf16, WS_CB); float* YD = WSP(float, WS_YD); float* ST = WSP(float, WS_ST); bf16* A2 = WSP(bf16, WS_A2);
    const float* cw = INP(I_CONVW); const float* cbias = INP(I_CONVB);
    LAS float* dtL = (LAS float*)(F.lds + MX_DT); LAS float* acsL = (LAS float*)(F.lds + MX_ACS); LAS float* deL = (LAS float*)(F.lds + MX_DE);
    LAS unsigned char* lds = F.lds;
    const bool lastc = (c == NCH - 1);
    {
        f32x4 wd[6][4];
#pragma unroll
        for (int hl = 0; hl < 6; ++hl)
#pragma unroll
            for (int j = 0; j < 4; ++j) wd[hl][j] = *(const f32x4*)(WDT + (size_t)(6 * g + hl) * D + 4 * lane + 256 * j);
        for (int i = 0; i < 16; ++i) { const int l = 16 * w + i; const size_t r = row0 + l;
            f32x4 xv[4];
#pragma unroll
            for (int j = 0; j < 4; ++j) xv[j] = *(const f32x4*)(X + r * D + 4 * lane + 256 * j);
            const float rs = pg8::rstd16(SSQ1, (int)r);
#pragma unroll
            for (int hl = 0; hl < 6; ++hl) { float s = 0.f;
#pragma unroll
                for (int j = 0; j < 4; ++j) s += (xv[j].x * wd[hl][j].x + xv[j].y * wd[hl][j].y) + (xv[j].z * wd[hl][j].z + xv[j].w * wd[hl][j].w);
                s = wave_sum(s);
                if (lane == 0) dtL[hl * 128 + l] = softplusf(rs * s + INP(I_DTB)[6 * g + hl]); } }
    }
    WG_BAR();
    if (w < 6) { const int h = 6 * g + w; const float a = -__expf(INP(I_ALOG)[h]);
        const float d0 = dtL[w * 128 + 2 * lane], d1 = dtL[w * 128 + 2 * lane + 1]; const float v0 = d0 * a, v1 = d1 * a; float s = v0 + v1;
#pragma unroll
        for (int o = 1; o < 64; o <<= 1) { const float t = __shfl_up(s, o); if (lane >= o) s += t; }
        const float a0 = s - v1, a1 = s, last = __shfl(s, 63);
        acsL[w * 128 + 2 * lane] = a0; acsL[w * 128 + 2 * lane + 1] = a1;
        deL[w * 128 + 2 * lane] = __expf(last - a0) * d0; deL[w * 128 + 2 * lane + 1] = __expf(last - a1) * d1;
        EXPA[(row0 + 2 * lane) * NH + h] = __expf(a0); EXPA[(row0 + 2 * lane + 1) * NH + h] = __expf(a1);
        if (lane == 63) CDp[((size_t)b * NCH + c) * NH + h] = __expf(last); }
    const int cn = tid & 63, lc = tid >> 6, l0 = 16 * lc;
    for (int rd = 0; rd < 4; ++rd) { const int isC = rd >> 1, hf = rd & 1, cx0 = D_SSM + isC * 256 + g * 128 + hf * 64;
        stage_raw(F, PROJ, b, t0, XBC0 + cx0); WG_BAR();
        float v[16]; conv16(F, cw, cbias, cx0 + cn, l0, v); const int n = hf * 64 + cn;
        if (!isC) {
#pragma unroll
            for (int j = 0; j < 16; ++j) *(LAS unsigned short*)(lds + MX_RB + (l0 + j) * MX_PITCHB + n * 2) = (unsigned short)f2bf(v[j]);
            *(LAS v4u*)(lds + MX_RBT + n * MX_PITCHB + l0 * 2) = pack8(v); *(LAS v4u*)(lds + MX_RBT + n * MX_PITCHB + l0 * 2 + 16) = pack8(v + 8);
        } else {
#pragma unroll
            for (int j = 0; j < 16; ++j) { const unsigned short q = (unsigned short)f2bf(v[j]); *(LAS unsigned short*)(lds + MX_RC + (l0 + j) * MX_PITCHB + n * 2) = q; CB[(row0 + l0 + j) * 256 + g * 128 + n] = q; }
        }
        if (lastc && lc == 0) { const LAS unsigned short* raw = (const LAS unsigned short*)(lds + MX_RAW);
#pragma unroll
            for (int j = 0; j < 3; ++j) F.out[OUT_CONVP + ((size_t)b * 3 + j) * CONV_DIM + cx0 + cn] = bf2f(raw[(128 + j) * 66 + cn]); }
        WG_BAR(); }
    f32x4 sc[8];
    { bf16x8 cf[4];
#pragma unroll
        for (int ks = 0; ks < 4; ++ks) cf[ks] = *(const LAS bf16x8*)(lds + MX_RC + (16 * w + fr) * MX_PITCHB + (32 * ks + 8 * fq) * 2);
#pragma unroll
        for (int sb = 0; sb < 8; ++sb) { f32x4 a = (f32x4){0.f, 0.f, 0.f, 0.f};
#pragma unroll
            for (int ks = 0; ks < 4; ++ks) { const bf16x8 bf_ = *(const LAS bf16x8*)(lds + MX_RB + (16 * sb + fr) * MX_PITCHB + (32 * ks + 8 * fq) * 2); a = MFMA16(bf_, cf[ks], a); }
            sc[sb] = a; } }
    WG_BAR();
    for (int i = lane; i < 256; i += 64) *(LAS v4u*)(lds + MX_RC + (16 * w + (i >> 4)) * MX_PITCHB + (i & 15) * 16) = (v4u){0u, 0u, 0u, 0u};
    for (int hl = 0; hl < 6; ++hl) { const int h = 6 * g + hl;
        stage_raw(F, PROJ, b, t0, XBC0 + h * 64); WG_BAR();
        { float v[16]; conv16(F, cw, cbias, h * 64 + cn, l0, v);
            *(LAS v4u*)(lds + MX_RB + cn * MX_PITCHB + l0 * 2) = pack8(v); *(LAS v4u*)(lds + MX_RB + cn * MX_PITCHB + l0 * 2 + 16) = pack8(v + 8);
            float vd[16];
#pragma unroll
            for (int j = 0; j < 16; ++j) vd[j] = v[j] * deL[hl * 128 + l0 + j];
            *(LAS v4u*)(lds + MX_RB + (64 + cn) * MX_PITCHB + l0 * 2) = pack8(vd); *(LAS v4u*)(lds + MX_RB + (64 + cn) * MX_PITCHB + l0 * 2 + 16) = pack8(vd + 8);
            if (lastc && lc == 0) { const LAS unsigned short* raw = (const LAS unsigned short*)(lds + MX_RAW);
#pragma unroll
                for (int j = 0; j < 3; ++j) F.out[OUT_CONVP + ((size_t)b * 3 + j) * CONV_DIM + h * 64 + cn] = bf2f(raw[(128 + j) * 66 + cn]); } }
        { const int l = 16 * w + fr; const float al = acsL[hl * 128 + l];
#pragma unroll
            for (int sb = 0; sb < 8; ++sb) if (sb <= w) { const int s0 = 16 * sb + 4 * fq; const f32x4 as = *(const LAS f32x4*)(acsL + hl * 128 + s0), ds = *(const LAS f32x4*)(dtL + hl * 128 + s0);
                float o[4];
#pragma unroll
                for (int r = 0; r < 4; ++r) o[r] = (s0 + r <= l) ? sc[sb][r] * __expf(fminf(al - as[r], 0.f)) * ds[r] : 0.f;
                v2u pw; pw.x = pk2(o[0], o[1]); pw.y = pk2(o[2], o[3]); *(LAS v2u*)(lds + MX_RC + l * MX_PITCHB + s0 * 2) = pw; } }
        WG_BAR();
        { f32x4 ya[4];
#pragma unroll
            for (int pb = 0; pb < 4; ++pb) ya[pb] = (f32x4){0.f, 0.f, 0.f, 0.f};
#pragma unroll
            for (int ks = 0; ks < 4; ++ks) if (32 * ks <= 16 * w + 15) { const bf16x8 wf = *(const LAS bf16x8*)(lds + MX_RC + (16 * w + fr) * MX_PITCHB + (32 * ks + 8 * fq) * 2);
#pragma unroll
                for (int pb = 0; pb < 4; ++pb) { const bf16x8 xf = *(const LAS bf16x8*)(lds + MX_RB + (16 * pb + fr) * MX_PITCHB + (32 * ks + 8 * fq) * 2); ya[pb] = MFMA16(xf, wf, ya[pb]); } }
            const float dsk = INP(I_DSKIP)[h]; const int l = 16 * w + fr;
#pragma unroll
            for (int pb = 0; pb < 4; ++pb) { f32x4 o;
#pragma unroll
                for (int r = 0; r < 4; ++r) { const int p = 16 * pb + 4 * fq + r; o[r] = ya[pb][r] + dsk * bf2f(*(const LAS unsigned short*)(lds + MX_RB + p * MX_PITCHB + l * 2)); }
                *(f32x4*)(YD + (row0 + l) * D_SSM + h * 64 + 16 * pb + 4 * fq) = o; } }
        { f32x4 sa[4];
#pragma unroll
            for (int pb = 0; pb < 4; ++pb) sa[pb] = (f32x4){0.f, 0.f, 0.f, 0.f};
#pragma unroll
            for (int ks = 0; ks < 4; ++ks) { const bf16x8 bf_ = *(const LAS bf16x8*)(lds + MX_RBT + (16 * w + fr) * MX_PITCHB + (32 * ks + 8 * fq) * 2);
#pragma unroll
                for (int pb = 0; pb < 4; ++pb) { const bf16x8 xf = *(const LAS bf16x8*)(lds + MX_RB + (64 + 16 * pb + fr) * MX_PITCHB + (32 * ks + 8 * fq) * 2); sa[pb] = MFMA16(bf_, xf, sa[pb]); } }
#pragma unroll
            for (int pb = 0; pb < 4; ++pb) *(f32x4*)(ST + ((((size_t)b * NCH + c) * NH + h) * HD + 16 * pb + fr) * NST + 16 * w + 4 * fq) = sa[pb]; }
        WG_BAR(); }
    { const int cc = tid & 127, lq = tid >> 7, ucol = g * 128 + cc; const int grp = __builtin_amdgcn_readfirstlane(ucol >> 6);
        float* outp = F.out + OUT_POOLP;
        if (grp == 0) pool_prompt_chunk<2>(PROJ, A2, outp, b, t0, 32 * lq, ucol, lastc);
        else if (grp == 1) pool_prompt_chunk<4>(PROJ, A2, outp, b, t0, 32 * lq, ucol, lastc);
        else if (grp == 2) pool_prompt_chunk<8>(PROJ, A2, outp, b, t0, 32 * lq, ucol, lastc);
        else pool_prompt_chunk<16>(PROJ, A2, outp, b, t0, 32 * lq, ucol, lastc); }
    WG_BAR();
}

constexpr int SM_XS = 0, SM_BM = 12288, SM_CM = 16384, SM_G = 20480, SM_DT = 32768, SM_ACS = SM_DT + 192, SM_DE = SM_ACS + 192, SM_EA = SM_DE + 192, SM_CD = SM_EA + 192, SM_SC = SM_CD + 64, SM_SSQ = SM_SC + 128;
template <int W> __device__ __forceinline__ void pool_sample4(const float* sp, const bf16* PROJ, float* outp, int b, size_t r0, int c, float (&p)[4]) {
    float v[19];
#pragma unroll
    for (int i = 0; i < 15; ++i) v[i] = sp[((size_t)b * 15 + i) * D_POOL + c];
#pragma unroll
    for (int t = 0; t < 4; ++t) v[15 + t] = bf2f(PROJ[(r0 + t) * NIN + c]);
#pragma unroll
    for (int t = 0; t < 4; ++t) { float s = 0.f;
#pragma unroll
        for (int j = 0; j < W; ++j) s += v[15 + t - (W - 1) + j];
        p[t] = s * (1.0f / W) - v[15 + t]; }
#pragma unroll
    for (int i = 0; i < 15; ++i) outp[((size_t)b * 15 + i) * D_POOL + c] = v[4 + i];
}
__device__ __forceinline__ void mix_sample_item(Frame& F, int b) {
    const int tid = F.tid, lane = F.lane, w = F.wave, fr = lane & 15, fq = lane >> 4; const size_t r0 = (size_t)MP + 4 * b;
    const bf16* PROJ = WSP(const bf16, WS_PROJ); const float* X = WSP(const float, WS_X); const float* SSQ1 = WSP(const float, WS_SSQ1); const float* WDT = WSP(const float, WS_WDT);
    bf16* A2 = WSP(bf16, WS_A2); float* SSQY = WSP(float, WS_SSQY);
    LAS unsigned char* lds = F.lds;
    LAS float* xsL = (LAS float*)(lds + SM_XS); LAS float* BmL = (LAS float*)(lds + SM_BM); LAS float* CmL = (LAS float*)(lds + SM_CM); LAS float* gL = (LAS float*)(lds + SM_G);
    LAS float* dtS = (LAS float*)(lds + SM_DT); LAS float* acsS = (LAS float*)(lds + SM_ACS); LAS float* deS = (LAS float*)(lds + SM_DE); LAS float* eaS = (LAS float*)(lds + SM_EA);
    LAS float* cdS = (LAS float*)(lds + SM_CD); LAS float* scS = (LAS float*)(lds + SM_SC); LAS float* ssqS = (LAS float*)(lds + SM_SSQ);
    { const float* scv = INP(I_SCONV); const float* cw = INP(I_CONVW); const float* cbias = INP(I_CONVB);
        for (int cx = tid; cx < CONV_DIM; cx += NTHREADS) { float e[7];
#pragma unroll
            for (int i = 0; i < 3; ++i) e[i] = scv[((size_t)b * 3 + i) * CONV_DIM + cx];
#pragma unroll
            for (int t = 0; t < 4; ++t) e[3 + t] = bf2f(PROJ[(r0 + t) * NIN + XBC0 + cx]);
            const float w0 = cw[cx], w1 = cw[CONV_DIM + cx], w2 = cw[2 * CONV_DIM + cx], w3 = cw[3 * CONV_DIM + cx], bb = cbias[cx];
#pragma unroll
            for (int t = 0; t < 4; ++t) { const float o = siluf(e[t] * w0 + e[t + 1] * w1 + e[t + 2] * w2 + e[t + 3] * w3 + bb);
                if (cx < D_SSM) xsL[t * D_SSM + cx] = o; else if (cx < D_SSM + 256) BmL[t * 256 + cx - D_SSM] = o; else CmL[t * 256 + cx - D_SSM - 256] = o; }
#pragma unroll
            for (int j = 0; j < 3; ++j) F.out[OUT_CONVS + ((size_t)b * 3 + j) * CONV_DIM + cx] = e[4 + j]; } }
    float pp[4] = {0.f, 0.f, 0.f, 0.f};
    if (tid < 256) { const int grp = __builtin_amdgcn_readfirstlane(tid >> 6); const float* sp = INP(I_SPOOL); float* outp = F.out + OUT_POOLS;
        if (grp == 0) pool_sample4<2>(sp, PROJ, outp, b, r0, tid, pp); else if (grp == 1) pool_sample4<4>(sp, PROJ, outp, b, r0, tid, pp);
        else if (grp == 2) pool_sample4<8>(sp, PROJ, outp, b, r0, tid, pp); else pool_sample4<16>(sp, PROJ, outp, b, r0, tid, pp); }
    else {
        const int t = w - 4; const size_t r = r0 + t; f32x4 xv[4];
#pragma unroll
        for (int j = 0; j < 4; ++j) xv[j] = *(const f32x4*)(X + r * D + 4 * lane + 256 * j);
        const float rs = pg8::rstd16(SSQ1, (int)r);
        for (int h = 0; h < NH; ++h) { float s = 0.f;
#pragma unroll
            for (int j = 0; j < 4; ++j) { const f32x4 wv = *(const f32x4*)(WDT + (size_t)h * D + 4 * lane + 256 * j); s += (xv[j].x * wv.x + xv[j].y * wv.y) + (xv[j].z * wv.z + xv[j].w * wv.w); }
            s = wave_sum(s);
            if (lane == 0) dtS[t * NH + h] = softplusf(rs * s + INP(I_DTB)[h]); } }
    WG_BAR();
    if (tid < NH) { const int h = tid; const float a = -__expf(INP(I_ALOG)[h]); float acc = 0.f, ac[4];
#pragma unroll
        for (int t = 0; t < 4; ++t) { acc += dtS[t * NH + h] * a; ac[t] = acc; acsS[t * NH + h] = acc; }
#pragma unroll
        for (int t = 0; t < 4; ++t) { deS[t * NH + h] = __expf(acc - ac[t]) * dtS[t * NH + h]; eaS[t * NH + h] = __expf(ac[t]); }
        cdS[h] = __expf(acc); }
#pragma unroll
    for (int k = 0; k < 4; ++k) { const int idx = 4 * w + k, gg = idx >> 4, l = (idx >> 2) & 3, s = idx & 3;
        float v = CmL[l * 256 + gg * 128 + lane] * BmL[s * 256 + gg * 128 + lane] + CmL[l * 256 + gg * 128 + 64 + lane] * BmL[s * 256 + gg * 128 + 64 + lane];
        v = wave_sum(v); if (lane == 0) scS[idx] = v; }
    WG_BAR();
    { const int gg = w >> 2; const float* h0 = INP(I_SSSM); float* hout = F.out + OUT_SSMS;
        bf16x8 cf[4];
#pragma unroll
        for (int ks = 0; ks < 4; ++ks) { v4u q = (v4u){0u, 0u, 0u, 0u};
            if (fr < 4) { const LAS float* cp = CmL + fr * 256 + gg * 128 + 32 * ks + 8 * fq; q.x = pk2(cp[0], cp[1]); q.y = pk2(cp[2], cp[3]); q.z = pk2(cp[4], cp[5]); q.w = pk2(cp[6], cp[7]); }
            cf[ks] = __builtin_bit_cast(bf16x8, q); }
        for (int i = 0; i < 6; ++i) { const int blk = 6 * w + i, h = blk >> 2, pb = blk & 3, p = 16 * pb + fr;
            const float cdh = cdS[h]; float cx[4];
#pragma unroll
            for (int l = 0; l < 4; ++l) cx[l] = deS[l * NH + h] * xsL[l * D_SSM + h * 64 + p];
            f32x4 acc = (f32x4){0.f, 0.f, 0.f, 0.f};
#pragma unroll
            for (int ks = 0; ks < 4; ++ks) { const int n0 = 32 * ks + 8 * fq; const size_t off = (((size_t)b * NH + h) * HD + p) * NST + n0;
                const f32x4 a0 = *(const f32x4*)(h0 + off), a1 = *(const f32x4*)(h0 + off + 4);
                v4u q; q.x = pk2(a0.x, a0.y); q.y = pk2(a0.z, a0.w); q.z = pk2(a1.x, a1.y); q.w = pk2(a1.z, a1.w);
                acc = MFMA16(__builtin_bit_cast(bf16x8, q), cf[ks], acc);
                f32x4 o0 = a0 * cdh, o1 = a1 * cdh;
#pragma unroll
                for (int l = 0; l < 4; ++l) { const f32x4 b0 = *(const LAS f32x4*)(BmL + l * 256 + gg * 128 + n0), b1 = *(const LAS f32x4*)(BmL + l * 256 + gg * 128 + n0 + 4); o0 += b0 * cx[l]; o1 += b1 * cx[l]; }
                *(f32x4*)(hout + off) = o0; *(f32x4*)(hout + off + 4) = o1; }
            if (fr < 4) { const int l = fr; const float eal = eaS[l * NH + h], dsk = INP(I_DSKIP)[h], al = acsS[l * NH + h];
#pragma unroll
                for (int r = 0; r < 4; ++r) { const int pc = h * 64 + 16 * pb + 4 * fq + r; float y = eal * acc[r] + dsk * xsL[l * D_SSM + pc];
#pragma unroll
                    for (int s = 0; s < 4; ++s) if (s <= l) y += scS[gg * 16 + l * 4 + s] * __expf(al - acsS[s * NH + h]) * dtS[s * NH + h] * xsL[s * D_SSM + pc];
                    const float z = bf2f(PROJ[(r0 + l) * NIN + D_POOL + pc]); gL[l * D_SSM + pc] = y * siluf(z); } } } }
    WG_BAR();
    if (w < 4) { float s = 0.f;
#pragma unroll
        for (int j = 0; j < 12; ++j) { const float v = gL[w * D_SSM + lane + 64 * j]; s += v * v; }
        s = wave_sum(s); if (lane == 0) ssqS[w] = s; }
    WG_BAR();
#pragma unroll
    for (int t = 0; t < 4; ++t) { const float tot = ssqS[t]; const float rsinv = sqrtf(tot * (1.0f / D_SSM) + EPS);
        for (int cc = tid; cc < D_SSM; cc += NTHREADS) A2[(r0 + t) * D + D_POOL + cc] = (bf16)f2bf(gL[t * D_SSM + cc]);
        if (tid < 256) A2[(r0 + t) * D + tid] = (bf16)f2bf(pp[t] * rsinv);
        if (tid < 16) SSQY[(r0 + t) * 16 + tid] = tid == 0 ? tot * (1024.0f / D_SSM) : 0.f; }
    WG_BAR();
}

__device__ __forceinline__ void scan_phase(Frame& F) {
    const float* ST = WSP(const float, WS_ST); const float* CDp = WSP(const float, WS_CD); bf16* HP = WSP(bf16, WS_HP); float* outp = F.out + OUT_SSMP;
    constexpr size_t CS = (size_t)NH * HD * NST;
    for (int idx = F.bid * NTHREADS + F.tid; idx < BATCH * NH * HD * (NST / 4); idx += F.G * NTHREADS) { const int n4 = idx & 31, p = (idx >> 5) & 63, bh = idx >> 11, h = bh % NH, b = bh / NH;
        const size_t base = ((((size_t)b * NCH) * NH + h) * HD + p) * NST + 4 * n4;
        f32x4 st[NCH];
#pragma unroll
        for (int c = 0; c < NCH; ++c) st[c] = *(const f32x4*)(ST + base + c * CS);
        f32x4 run = (f32x4){0.f, 0.f, 0.f, 0.f};
#pragma unroll
        for (int c = 0; c < NCH; ++c) { v2u q; q.x = pk2(run.x, run.y); q.y = pk2(run.z, run.w); *(v2u*)(HP + base + c * CS) = q; run = run * CDp[((size_t)b * NCH + c) * NH + h] + st[c]; }
        *(f32x4*)(outp + (((size_t)b * NH + h) * HD + p) * NST + 4 * n4) = run; }
}

__device__ __forceinline__ void mixc_item(Frame& F, int b, int c, int hf) {
    const int tid = F.tid, lane = F.lane, w = F.wave, fr = lane & 15, fq = lane >> 4, lb = w & 3, grp = w >> 2;
    const bf16* PROJ = WSP(const bf16, WS_PROJ); const float* EXPA = WSP(const float, WS_EXPA); const bf16* CB = WSP(const bf16, WS_CB); const float* YD = WSP(const float, WS_YD); const bf16* HP = WSP(const bf16, WS_HP);
    bf16* A2 = WSP(bf16, WS_A2); float* SSQY = WSP(float, WS_SSQY);
    LAS float* ssqL = (LAS float*)(F.lds);
    const size_t rowb = (size_t)b * SEQ + c * CHUNK + 64 * hf; const size_t row = rowb + 16 * lb + fr;
    bf16x8 cf[4];
#pragma unroll
    for (int ks = 0; ks < 4; ++ks) cf[ks] = *(const bf16x8*)(CB + row * 256 + grp * 128 + 32 * ks + 8 * fq);
    float ssq = 0.f;
    for (int hl = 0; hl < 6; ++hl) { const int h = 6 * grp + hl; const float ea = EXPA[row * NH + h]; const bf16* hp = HP + ((((size_t)b * NCH + c) * NH + h) * HD) * NST;
#pragma unroll
        for (int pb = 0; pb < 4; ++pb) { f32x4 acc = (f32x4){0.f, 0.f, 0.f, 0.f};
#pragma unroll
            for (int ks = 0; ks < 4; ++ks) { const bf16x8 af = *(const bf16x8*)(hp + (size_t)(16 * pb + fr) * NST + 32 * ks + 8 * fq); acc = MFMA16(af, cf[ks], acc); }
            const int p0 = h * 64 + 16 * pb + 4 * fq; const f32x4 yd = *(const f32x4*)(YD + row * D_SSM + p0); const v2u zz = *(const v2u*)(PROJ + row * NIN + D_POOL + p0);
            const float g0 = (yd[0] + ea * acc[0]) * siluf(bflo(zz.x)), g1 = (yd[1] + ea * acc[1]) * siluf(bfhi(zz.x)), g2 = (yd[2] + ea * acc[2]) * siluf(bflo(zz.y)), g3 = (yd[3] + ea * acc[3]) * siluf(bfhi(zz.y));
            ssq += (g0 * g0 + g1 * g1) + (g2 * g2 + g3 * g3);
            v2u q; q.x = pk2(g0, g1); q.y = pk2(g2, g3); *(v2u*)(A2 + row * D + D_POOL + p0) = q; } }
    ssq += __shfl_xor(ssq, 16); ssq += __shfl_xor(ssq, 32);
    if (fq == 0) ssqL[grp * 64 + 16 * lb + fr] = ssq;
    WG_BAR();
    { const int rl = tid >> 3, seg = tid & 7; const float tot = ssqL[rl] + ssqL[64 + rl]; const float rsinv = sqrtf(tot * (1.0f / D_SSM) + EPS); const size_t r = rowb + rl;
#pragma unroll
        for (int i = 0; i < 4; ++i) { v4u q = *(const v4u*)(A2 + r * D + seg * 32 + 8 * i);
            q.x = pk2(bflo(q.x) * rsinv, bfhi(q.x) * rsinv); q.y = pk2(bflo(q.y) * rsinv, bfhi(q.y) * rsinv); q.z = pk2(bflo(q.z) * rsinv, bfhi(q.z) * rsinv); q.w = pk2(bflo(q.w) * rsinv, bfhi(q.w) * rsinv);
            *(v4u*)(A2 + r * D + seg * 32 + 8 * i) = q; }
        if (seg < 4) *(f32x4*)(SSQY + r * 16 + 4 * seg) = (f32x4){seg == 0 ? tot * (1024.0f / D_SSM) : 0.f, 0.f, 0.f, 0.f}; }
    WG_BAR();
}

constexpr int SA_REDM = 0, SA_REDS = 512, SA_P = 1024, SA_O = 1024 + 8192;
__device__ __forceinline__ void attn_sample_item(Frame& F, int b, int hp) {
    const int tid = F.tid, lane = F.lane, w = F.wave, fr = lane & 15, fq = lane >> 4, hl = w >> 2, kq = w & 3, h = 2 * hp + hl; const size_t r0 = (size_t)MP + 4 * b;
    const bf16* Q = WSP(const bf16, WS_Q); bf16* O = WSP(bf16, WS_O); const float* ck = INP(I_CK); const float* cv = INP(I_CV);
    LAS float* redM = (LAS float*)(F.lds + SA_REDM); LAS float* redS = (LAS float*)(F.lds + SA_REDS); LAS float* pL = (LAS float*)(F.lds + SA_P); LAS float* oL = (LAS float*)(F.lds + SA_O);
    bf16x8 qf[8];
#pragma unroll
    for (int ks = 0; ks < 8; ++ks) { v4u q = (v4u){0u, 0u, 0u, 0u}; if (fr < 4) q = *(const v4u*)(Q + (r0 + fr) * D + h * 256 + 32 * ks + 8 * fq); qf[ks] = __builtin_bit_cast(bf16x8, q); }
    f32x4 s[4];
#pragma unroll
    for (int mb = 0; mb < 4; ++mb) { const int m = 64 * kq + 16 * mb + fr; const float* kp = ck + (((size_t)b * NMEM + m) * 4 + h) * 256 + 8 * fq; f32x4 acc = (f32x4){0.f, 0.f, 0.f, 0.f};
#pragma unroll
        for (int ks = 0; ks < 8; ++ks) { const f32x4 a0 = *(const f32x4*)(kp + 32 * ks), a1 = *(const f32x4*)(kp + 32 * ks + 4);
            v4u q; q.x = pk2(a0.x, a0.y); q.y = pk2(a0.z, a0.w); q.z = pk2(a1.x, a1.y); q.w = pk2(a1.z, a1.w); acc = MFMA16(__builtin_bit_cast(bf16x8, q), qf[ks], acc); }
        s[mb] = acc; }
    float mx = -3.0e38f;
#pragma unroll
    for (int mb = 0; mb < 4; ++mb) mx = fmaxf(mx, fmaxf(fmaxf(s[mb][0], s[mb][1]), fmaxf(s[mb][2], s[mb][3])));
    mx = fmaxf(mx, __shfl_xor(mx, 16)); mx = fmaxf(mx, __shfl_xor(mx, 32));
    if (fq == 0) redM[w * 16 + fr] = mx;
    WG_BAR();
    mx = fmaxf(fmaxf(redM[(4 * hl) * 16 + fr], redM[(4 * hl + 1) * 16 + fr]), fmaxf(redM[(4 * hl + 2) * 16 + fr], redM[(4 * hl + 3) * 16 + fr]));
    float sm = 0.f;
#pragma unroll
    for (int mb = 0; mb < 4; ++mb)
#pragma unroll
        for (int r = 0; r < 4; ++r) { const float p = __expf(s[mb][r] - mx); sm += p; if (fr < 4) pL[(hl * 256 + 64 * kq + 16 * mb + 4 * fq + r) * 4 + fr] = p; }
    sm += __shfl_xor(sm, 16); sm += __shfl_xor(sm, 32);
    if (fq == 0) redS[w * 16 + fr] = sm;
    WG_BAR();
    f32x4 o[4];
#pragma unroll
    for (int t = 0; t < 4; ++t) o[t] = (f32x4){0.f, 0.f, 0.f, 0.f};
    { const float* vp = cv + (((size_t)b * NMEM + 64 * kq) * 4 + h) * 256 + 4 * lane;
#pragma unroll 8
        for (int mi = 0; mi < 64; ++mi) { const f32x4 v = *(const f32x4*)(vp + (size_t)mi * 1024); const f32x4 pv = *(const LAS f32x4*)(pL + (hl * 256 + 64 * kq + mi) * 4);
#pragma unroll
            for (int t = 0; t < 4; ++t) o[t] += v * pv[t]; } }
#pragma unroll
    for (int t = 0; t < 4; ++t) *(LAS f32x4*)(oL + (w * 4 + t) * 256 + 4 * lane) = o[t];
    WG_BAR();
    { const int h2 = tid >> 8, t = (tid >> 6) & 3, d4 = (tid & 63) * 4; f32x4 a = (f32x4){0.f, 0.f, 0.f, 0.f}; float l = 0.f;
#pragma unroll
        for (int k = 0; k < 4; ++k) { a += *(const LAS f32x4*)(oL + ((4 * h2 + k) * 4 + t) * 256 + d4); l += redS[(4 * h2 + k) * 16 + t]; }
        const float inv = 1.0f / l; v2u q; q.x = pk2(a.x * inv, a.y * inv); q.y = pk2(a.z * inv, a.w * inv);
        *(v2u*)(O + (r0 + t) * D + (2 * hp + h2) * 256 + d4) = q; }
    WG_BAR();
}

__device__ __forceinline__ void final_norm_phase(Frame& F) {
    const float* SSQ4 = WSP(const float, WS_SSQ4); const float* gf = INP(I_GFIN); const int gw = F.bid * NWAVES + F.wave, NGW = F.G * NWAVES, lane = F.lane;
    f32x4 gv[4];
#pragma unroll
    for (int j = 0; j < 4; ++j) gv[j] = *(const f32x4*)(gf + 4 * lane + 256 * j);
    for (int m = gw; m < M; m += NGW) { const float rs = pg8::rstd16(SSQ4, m); float* yr = F.out + OUT_Y + (size_t)m * D;
#pragma unroll
        for (int j = 0; j < 4; ++j) { f32x4 v = *(const f32x4*)(yr + 4 * lane + 256 * j); v = v * rs * gv[j]; *(f32x4*)(yr + 4 * lane + 256 * j) = v; } }
}

struct Args { const float* in[34]; float* out; unsigned char* ws; int ph_lo, ph_hi, li, pad; };
__global__ void __launch_bounds__(NTHREADS, 2) mega_fwd(Args args) {
    extern __shared__ __attribute__((aligned(16))) unsigned char lds[];
    Frame F;
    F.lds = (LAS unsigned char*)lds;
    F.MISC = (volatile LAS unsigned*)(F.lds + MISC_OFF);
    F.tid = threadIdx.x; F.lane = F.tid & 63; F.wave = __builtin_amdgcn_readfirstlane(F.tid >> 6);
    F.G = gridDim.x; F.bid = blockIdx.x;
    F.out = args.out; F.ws = args.ws; F.ptab = (LAS unsigned*)(F.lds + LDSCTL_OFF);
    F.ctl = (gu32*)(F.ws + WS_CTL);
    for (int u = F.tid; u < (LDS_BYTES - LDSCTL_OFF) / 4; u += NTHREADS) ((LAS unsigned*)(F.lds + LDSCTL_OFF))[u] = 0u;
    __syncthreads();
    if (F.tid == 0) {
#pragma unroll
        for (int i = 0; i < 34; ++i) { const unsigned long long p = (unsigned long long)args.in[i]; F.ptab[2 * i] = (unsigned)p; F.ptab[2 * i + 1] = (unsigned)(p >> 32); } }
    __syncthreads();
    XcdBarrier bar; bar.bar = (unsigned*)(F.ctl + CW_BAR) + args.li * XCD_BAR_WORDS; bar.x = 0; bar.st = nullptr;
    if (N_LAUNCHES == 1) bar = xcd_barrier_post((unsigned*)(F.ctl + CW_BAR), F.MISC + 8);
    const int lo = args.ph_lo, hi = args.ph_hi;
#ifndef PHMASK
#define PHMASK 0x7fff
#endif
#define IN(k) ((((PHMASK) >> (k)) & 1) && lo <= (k) && (k) < hi)
#define SEAM(k) do { if (IN(k) && IN((k) + 1)) xcd_barrier(bar); } while (0)
    PG8_LAS unsigned char* ring = (PG8_LAS unsigned char*)(F.lds + RING_OFF);
    int K256 = 256; asm volatile("" : "+s"(K256));
    const pg8::bf16_t* XB = WSP(const pg8::bf16_t, WS_XB);
    float* X = WSP(float, WS_X);

    if (IN(0)) { p0_prologue(F); } SEAM(0);
    if (IN(1)) {
        { pg8::Gemm g{XB, WSP(const pg8::bf16_t, WS_W1GU), M, NGU, D, D, D}; pg8::StaticOrder S; S.init(M, NGU, F.G, F.bid);
          pg8::EpiGateUp E{WSP(pg8::bf16_t, WS_ACT), FF, WSP(const float, WS_SSQ0)};
          pg8::gemm_phase<pg8::EpiGateUp, pg8::StaticOrder, true, true>(ring, g, S, E); }
        { pg8::Gemm g{WSP(const pg8::bf16_t, WS_MBF), WSP(const pg8::bf16_t, WS_WMKV), MEMROWS, 2 * D, D, D, D}; pg8::OffsetOrder S; S.init(MEMROWS, 2 * D, F.G, F.bid, ((M / 256) * (NGU / 256)) % F.G);
          pg8::EpiMem E{F.out + OUT_MK, F.out + OUT_MV, WSP(pg8::bf16_t, WS_KM), WSP(pg8::bf16_t, WS_VT), WSP(const float, WS_SSQM)};
          pg8::gemm_phase<pg8::EpiMem, pg8::OffsetOrder, true, true>(ring, g, S, E); }
    } SEAM(1);
    if (IN(2)) {
        pg8::Gemm g{WSP(const pg8::bf16_t, WS_ACT), WSP(const pg8::bf16_t, WS_W1D), M, D, FF, FF, FF}; pg8::StaticOrder S; S.init(M, D, F.G, F.bid);
        pg8::EpiResid E{INP(I_XP), INP(I_XS), MP, X, WSP(pg8::bf16_t, WS_XB), 0.5f, nullptr, WSP(float, WS_SSQ1)};
        pg8::gemm_phase<pg8::EpiResid, pg8::StaticOrder, true, true>(ring, g, S, E);
    } SEAM(2);
    if (IN(3)) {
        pg8::Gemm g{XB, WSP(const pg8::bf16_t, WS_WIN), M, NIN, D, D, D}; pg8::StaticOrder S; S.init(M, NIN, F.G, F.bid);
        pg8::EpiRowBf16 E{WSP(pg8::bf16_t, WS_PROJ), NIN, WSP(const float, WS_SSQ1)};
        pg8::gemm_phase<pg8::EpiRowBf16, pg8::StaticOrder, true, true>(ring, g, S, E);
    } SEAM(3);
    if (IN(4)) {
        for (int it = F.bid; it < BATCH * NCH * 2; it += F.G) mix_prompt_item(F, it >> 5, (it >> 1) & 15, it & 1);
        for (int it = F.bid; it < DEC_B; it += F.G) mix_sample_item(F, it);
    } SEAM(4);
    if (IN(5)) { scan_phase(F); } SEAM(5);
    if (IN(6)) { for (int it = F.bid; it < BATCH * NCH * 2; it += F.G) mixc_item(F, it >> 5, (it >> 1) & 15, it & 1); } SEAM(6);
    if (IN(7)) {
        pg8::Gemm g{WSP(const pg8::bf16_t, WS_A2), WSP(const pg8::bf16_t, WS_WOUT), M, D, D, D, D}; pg8::StaticOrder S; S.init(M, D, F.G, F.bid);
        pg8::EpiResid E{X, X, M, X, WSP(pg8::bf16_t, WS_XB), 1.0f, WSP(const float, WS_SSQY), WSP(float, WS_SSQ2)};
        pg8::gemm_phase<pg8::EpiResid, pg8::StaticOrder, true, true>(ring, g, S, E);
    } SEAM(7);
    if (IN(8)) {
        pg8::Gemm g{XB, WSP(const pg8::bf16_t, WS_WQ), M, D, D, D, D}; pg8::StaticOrder S; S.init(M, D, F.G, F.bid);
        pg8::EpiRowBf16 E{WSP(pg8::bf16_t, WS_Q), D, WSP(const float, WS_SSQ2)};
        pg8::gemm_phase<pg8::EpiRowBf16, pg8::StaticOrder, true, true>(ring, g, S, E);
    } SEAM(8);
    if (IN(9)) {
        { pg8::Gemm g{WSP(const pg8::bf16_t, WS_Q), WSP(const pg8::bf16_t, WS_KM), MP, 256, K256, D, D}; pg8::AttnOrder<0> S; S.init(F.G, F.bid);
          pg8::EpiSoftmax E{WSP(pg8::bf16_t, WS_PB)};
          pg8::gemm_phase<pg8::EpiSoftmax, pg8::AttnOrder<0>, false, true>(ring, g, S, E); }
        for (int it = F.bid; it < DEC_B * 2; it += F.G) attn_sample_item(F, it >> 1, it & 1);
    } SEAM(9);
    if (IN(10)) {
        pg8::Gemm g{WSP(const pg8::bf16_t, WS_PB), WSP(const pg8::bf16_t, WS_VT), MP, 256, K256, D, 256}; pg8::AttnOrder<1> S; S.init(F.G, F.bid);
        pg8::EpiRowBf16 E{WSP(pg8::bf16_t, WS_O), D, nullptr};
        pg8::gemm_phase<pg8::EpiRowBf16, pg8::AttnOrder<1>, true, true>(ring, g, S, E);
    } SEAM(10);
    if (IN(11)) {
        pg8::Gemm g{WSP(const pg8::bf16_t, WS_O), WSP(const pg8::bf16_t, WS_WO), M, D, D, D, D}; pg8::StaticOrder S; S.init(M, D, F.G, F.bid);
        pg8::EpiResid E{X, X, M, X, WSP(pg8::bf16_t, WS_XB), 1.0f, nullptr, WSP(float, WS_SSQ3)};
        pg8::gemm_phase<pg8::EpiResid, pg8::StaticOrder, true, true>(ring, g, S, E);
    } SEAM(11);
    if (IN(12)) {
        pg8::Gemm g{XB, WSP(const pg8::bf16_t, WS_W2GU), M, NGU, D, D, D}; pg8::StaticOrder S; S.init(M, NGU, F.G, F.bid);
        pg8::EpiGateUp E{WSP(pg8::bf16_t, WS_ACT), FF, WSP(const float, WS_SSQ3)};
        pg8::gemm_phase<pg8::EpiGateUp, pg8::StaticOrder, true, true>(ring, g, S, E);
    } SEAM(12);
    if (IN(13)) {
        pg8::Gemm g{WSP(const pg8::bf16_t, WS_ACT), WSP(const pg8::bf16_t, WS_W2D), M, D, FF, FF, FF}; pg8::StaticOrder S; S.init(M, D, F.G, F.bid);
        pg8::EpiResid E{X, X, M, F.out + OUT_Y, nullptr, 0.5f, nullptr, WSP(float, WS_SSQ4)};
        pg8::gemm_phase<pg8::EpiResid, pg8::StaticOrder, true, true>(ring, g, S, E);
    } SEAM(13);
    if (IN(14)) { final_norm_phase(F); }
#undef IN
#undef SEAM
}

extern "C" void kernel_launch(void* const* d_in, const int* in_sizes, int n_in, void* d_out, int out_size, void* d_ws, size_t ws_size, hipStream_t stream) {
    static int grid = 0;
    if (grid == 0) {
        if (n_in != 34 || out_size != (int)OUT_TOTAL || ws_size < WS_END) { fprintf(stderr, "kernel_launch: expected 34 inputs, %zu outputs, >= %zu bytes of workspace; got n_in %d, out %d, ws %zu; nothing launched\n", (size_t)OUT_TOTAL, (size_t)WS_END, n_in, out_size, ws_size); grid = -1; return; }
        int dev = 0, cus = 0, per_cu = 0;
        if (hipGetDevice(&dev) != hipSuccess || hipDeviceGetAttribute(&cus, hipDeviceAttributeMultiprocessorCount, dev) != hipSuccess) { fprintf(stderr, "kernel_launch: device query failed\n"); grid = -1; return; }
        if (hipFuncSetAttribute((const void*)mega_fwd, hipFuncAttributeMaxDynamicSharedMemorySize, LDS_BYTES) != hipSuccess) { fprintf(stderr, "kernel_launch: hipFuncSetAttribute failed\n"); grid = -1; return; }
        if (hipOccupancyMaxActiveBlocksPerMultiprocessor(&per_cu, (const void*)mega_fwd, NTHREADS, LDS_BYTES) != hipSuccess || per_cu < 1) { fprintf(stderr, "kernel_launch: occupancy query reports %d blocks per CU; nothing launched\n", per_cu); (void)hipGetLastError(); grid = -1; return; }
        grid = cus;
        if (grid != 256) { fprintf(stderr, "kernel_launch: this kernel is built for a 256-CU device (found %d CUs); nothing launched\n", cus); grid = -1; return; }
    }
    if (grid < 0) return;
    if (hipMemsetAsync((char*)d_ws + WS_CTL, 0, CTL_ZERO_BYTES, stream) != hipSuccess) { fprintf(stderr, "kernel_launch: hipMemsetAsync failed\n"); return; }
    Args a{};
    for (int i = 0; i < 34; ++i) a.in[i] = (const float*)d_in[i];
    a.out = (float*)d_out; a.ws = (unsigned char*)d_ws;
    if (N_LAUNCHES == 1) { a.ph_lo = 0; a.ph_hi = N_PHASES; a.li = 0; hipLaunchKernelGGL(mega_fwd, dim3(grid), dim3(NTHREADS), LDS_BYTES, stream, a); }
    else for (int li = 0; li < N_PHASES; ++li) { a.ph_lo = li; a.ph_hi = li + 1; a.li = 0; hipLaunchKernelGGL(mega_fwd, dim3(grid), dim3(NTHREADS), LDS_BYTES, stream, a); }
    const hipError_t le = hipPeekAtLastError();
    if (le != hipSuccess) fprintf(stderr, "kernel_launch: launch failed: %s\n", hipGetErrorName(le));
}
```

```cpp
#include <hip/hip_runtime.h>
#include <cstdio>
#include <cstdint>
#include <cmath>

#ifndef MK_N_LAUNCHES
#define MK_N_LAUNCHES 1
#endif

namespace pg8 {
#define PG8_LAS __attribute__((address_space(3)))
typedef unsigned short bf16_t;
typedef short bf16x8 __attribute__((ext_vector_type(8)));
typedef float f32x4 __attribute__((ext_vector_type(4)));
typedef unsigned u32x4 __attribute__((ext_vector_type(4)));
typedef unsigned u32x2 __attribute__((ext_vector_type(2)));
constexpr int BM = 256, BK = 64, HALF = 128, HTB = HALF * BK * 2  , STAGE_BYTES = 8 * HTB, NXCD = 8, WGM = 8;

__host__ __device__ __forceinline__ int lds_byte(int r, int c) { const int st = (r >> 4) * 2 + (c >> 5), rr = r & 15, cc = c & 31, ob = rr * 64 + cc * 2; return st * 1024 + (ob ^ (((ob >> 9) & 1) << 5)); }
__host__ __device__ __forceinline__ void stage_rc(int b, int& R, int& C) { const int st = b / 1024, sb = b % 1024, swz = sb ^ (((sb >> 9) & 1) << 5); R = (st >> 1) * 16 + swz / 64; C = (st & 1) * 32 + (swz % 64) / 2; }
__host__ __device__ __forceinline__ int perm32(int rho) { const int n = rho >> 4, i = rho & 15; return 8 * (i >> 2) + 4 * n + (i & 3); }

struct Unit { int pm, pn; };
struct Gemm { const bf16_t* A; const bf16_t* Bt; int M, N, K, lda, ldb; };

struct StaticOrder {
    int nM, nN, nwg, G, c;
    __host__ __device__ void init(int M, int N, int G_, int c_) { nM = M / BM; nN = N / BM; nwg = nM * nN; G = G_; c = c_; }
    __host__ __device__ bool next(int i, Unit& u) const {
        const long L = (long)i * G + c; if (L >= nwg) return false;
        int wgid = (int)L; { const int q = nwg / NXCD, r = nwg % NXCD, xcd = wgid % NXCD, off = wgid / NXCD; wgid = (xcd < r ? xcd * (q + 1) : r * (q + 1) + (xcd - r) * q) + off; }
        const int nig = WGM * nN, gid = wgid / nig, fm = gid * WGM, gsz = (nM - fm) < WGM ? (nM - fm) : WGM;
        u.pm = fm + ((wgid % nig) % gsz); u.pn = (wgid % nig) / gsz; return true;
    }
    __device__ __forceinline__ const char* abase(const Gemm& g, const Unit& u) const { return (const char*)g.A + (size_t)u.pm * 256 * g.lda * 2; }
    __device__ __forceinline__ const char* bbase(const Gemm& g, const Unit& u) const { return (const char*)g.Bt + (size_t)u.pn * 256 * g.ldb * 2; }
    __device__ __forceinline__ void a_ready(const Unit&) const {}
    __device__ __forceinline__ void done(const Unit&) const {}
};
struct OffsetOrder {
    int nM, nN, nwg, G, c;
    __device__ void init(int M, int N, int G_, int c_, int off) { nM = M / BM; nN = N / BM; nwg = nM * nN; G = G_; c = (c_ - off % G_ + G_) % G_; }
    __device__ bool next(int i, Unit& u) const { const long L = (long)i * G + c; if (L >= nwg) return false; u.pm = (int)L % nM; u.pn = (int)L / nM; return true; }
    __device__ __forceinline__ const char* abase(const Gemm& g, const Unit& u) const { return (const char*)g.A + (size_t)u.pm * 256 * g.lda * 2; }
    __device__ __forceinline__ const char* bbase(const Gemm& g, const Unit& u) const { return (const char*)g.Bt + (size_t)u.pn * 256 * g.ldb * 2; }
    __device__ __forceinline__ void a_ready(const Unit&) const {}
    __device__ __forceinline__ void done(const Unit&) const {}
};
template <int MODE> struct AttnOrder {
    int G, c;
    __device__ void init(int G_, int c_) { G = G_; c = c_; }
    __device__ bool next(int i, Unit& u) const { const long L = (long)i * G + c; if (L >= 256) return false; const int b = (int)L >> 5, h = ((int)L >> 3) & 3, qt = (int)L & 7; u.pm = 8 * b + qt; u.pn = h; return true; }
    __device__ __forceinline__ const char* abase(const Gemm& g, const Unit& u) const { return (const char*)g.A + ((size_t)u.pm * 256 * 1024 + (size_t)u.pn * 256) * 2; }
    __device__ __forceinline__ const char* bbase(const Gemm& g, const Unit& u) const {
        const int b = u.pm >> 3;
        if (MODE == 0) return (const char*)g.Bt + ((size_t)b * 256 * 1024 + (size_t)u.pn * 256) * 2;
        return (const char*)g.Bt + (size_t)(4 * b + u.pn) * 256 * 256 * 2;
    }
    __device__ __forceinline__ void a_ready(const Unit&) const {}
    __device__ __forceinline__ void done(const Unit&) const {}
};

__device__ __forceinline__ unsigned cvt_pk_bf16(float lo, float hi) { unsigned r; asm volatile("v_cvt_pk_bf16_f32 %0, %1, %2" : "=v"(r) : "v"(lo), "v"(hi)); return r; }
constexpr float RMS_EPS = 1e-6f;
__device__ __forceinline__ float rstd16(const float* ssq, int row) {
    const f32x4* p = (const f32x4*)(ssq + (size_t)row * 16); const f32x4 a = p[0], b = p[1], c = p[2], d = p[3];
    const float s = ((a[0] + a[1]) + (a[2] + a[3])) + ((b[0] + b[1]) + (b[2] + b[3])) + ((c[0] + c[1]) + (c[2] + c[3])) + ((d[0] + d[1]) + (d[2] + d[3]));
    return 1.0f / sqrtf(s * (1.0f / 1024.0f) + RMS_EPS);
}
__device__ __forceinline__ float silu_f(float x) { return x / (1.0f + __expf(-x)); }

struct EpiGateUp {
    static constexpr bool PERM = true, AFTER_DRAIN = false;
    bf16_t* O; int ldc; const float* ssq;
    __device__ __forceinline__ void operator()(const f32x4 (&acc)[2][2][4][2], const Unit& u, int wr, int wc, int fr, int fq) const {
        const int row0 = u.pm * BM + wr * 64 + fr, col0 = u.pn * HALF + wc * 32 + 8 * fq;
#pragma unroll
        for (int ai = 0; ai < 2; ++ai)
#pragma unroll
            for (int m = 0; m < 4; ++m) { const int r = row0 + ai * HALF + m * 16; const float rs = rstd16(ssq, r);
                f32x4 g0 = acc[ai][0][m][0] * rs, g1 = acc[ai][0][m][1] * rs, u0 = acc[ai][1][m][0] * rs, u1 = acc[ai][1][m][1] * rs;
                float o[8];
#pragma unroll
                for (int j = 0; j < 4; ++j) { o[j] = silu_f(g0[j]) * u0[j]; o[4 + j] = silu_f(g1[j]) * u1[j]; }
                u32x4 w; w.x = cvt_pk_bf16(o[0], o[1]); w.y = cvt_pk_bf16(o[2], o[3]); w.z = cvt_pk_bf16(o[4], o[5]); w.w = cvt_pk_bf16(o[6], o[7]);
                *(u32x4*)(O + (size_t)r * ldc + col0) = w; }
    }
};
struct EpiRowBf16 {
    static constexpr bool PERM = true, AFTER_DRAIN = false;
    bf16_t* O; int ldc; const float* ssq;
    __device__ __forceinline__ void operator()(const f32x4 (&acc)[2][2][4][2], const Unit& u, int wr, int wc, int fr, int fq) const {
        const int row0 = u.pm * BM + wr * 64 + fr, col0 = u.pn * BM + wc * 32 + 8 * fq;
#pragma unroll
        for (int ai = 0; ai < 2; ++ai)
#pragma unroll
            for (int m = 0; m < 4; ++m) { const int r = row0 + ai * HALF + m * 16; const float rs = ssq ? rstd16(ssq, r) : 1.0f; bf16_t* rowp = O + (size_t)r * ldc + col0;
#pragma unroll
                for (int bj = 0; bj < 2; ++bj) { const f32x4 v0 = acc[ai][bj][m][0] * rs, v1 = acc[ai][bj][m][1] * rs;
                    u32x4 w; w.x = cvt_pk_bf16(v0[0], v0[1]); w.y = cvt_pk_bf16(v0[2], v0[3]); w.z = cvt_pk_bf16(v1[0], v1[1]); w.w = cvt_pk_bf16(v1[2], v1[3]);
                    *(u32x4*)(rowp + bj * HALF) = w; } }
    }
};
struct EpiProj {
    static constexpr bool PERM = true, AFTER_DRAIN = false;
    bf16_t* O; int ldc; const float* ssq; float* dtr;
    __device__ __forceinline__ void operator()(const f32x4 (&acc)[2][2][4][2], const Unit& u, int wr, int wc, int fr, int fq) const {
        const int row0 = u.pm * BM + wr * 64 + fr, col0 = u.pn * BM + wc * 32 + 8 * fq;
        if (u.pn < 9) {
#pragma unroll
            for (int ai = 0; ai < 2; ++ai)
#pragma unroll
                for (int m = 0; m < 4; ++m) { const int r = row0 + ai * HALF + m * 16; const float rs = rstd16(ssq, r); bf16_t* rowp = O + (size_t)r * ldc + col0;
#pragma unroll
                    for (int bj = 0; bj < 2; ++bj) { const f32x4 v0 = acc[ai][bj][m][0] * rs, v1 = acc[ai][bj][m][1] * rs;
                        u32x4 w; w.x = cvt_pk_bf16(v0[0], v0[1]); w.y = cvt_pk_bf16(v0[2], v0[3]); w.z = cvt_pk_bf16(v1[0], v1[1]); w.w = cvt_pk_bf16(v1[2], v1[3]);
                        *(u32x4*)(rowp + bj * HALF) = w; } }
        } else if (wc == 0 && fq < 2) {
#pragma unroll
            for (int ai = 0; ai < 2; ++ai)
#pragma unroll
                for (int m = 0; m < 4; ++m) { const int r = row0 + ai * HALF + m * 16; const float rs = rstd16(ssq, r); float* dp = dtr + (size_t)r * 12 + 8 * fq;
                    *(f32x4*)dp = acc[ai][0][m][0] * rs; if (fq == 0) *(f32x4*)(dp + 4) = acc[ai][0][m][1] * rs; }
        }
    }
};
struct EpiResid {
    static constexpr bool PERM = false, AFTER_DRAIN = false;
    const float* res; const float* res2; int split; float* out; bf16_t* outb; float alpha; const float* ssq_in; float* ssq_out;
    __device__ __forceinline__ void operator()(const f32x4 (&acc)[2][2][4][2], const Unit& u, int wr, int wc, int fr, int fq) const {
        const int row0 = u.pm * BM + wr * 64 + fr, col0 = u.pn * BM + wc * 32 + 4 * fq;
#pragma unroll
        for (int ai = 0; ai < 2; ++ai)
#pragma unroll
            for (int m = 0; m < 4; ++m) { const int r = row0 + ai * HALF + m * 16; const float sc = alpha * (ssq_in ? rstd16(ssq_in, r) : 1.0f);
                const float* rp = (r < split) ? res + (size_t)r * 1024 : res2 + (size_t)(r - split) * 1024; const size_t off = (size_t)r * 1024 + col0; float q = 0.f;
#pragma unroll
                for (int bj = 0; bj < 2; ++bj)
#pragma unroll
                    for (int n = 0; n < 2; ++n) { const int cc = bj * HALF + n * 16; const f32x4 bs = *(const f32x4*)(rp + col0 + cc); const f32x4 o = bs + acc[ai][bj][m][n] * sc;
                        *(f32x4*)(out + off + cc) = o; q += (o[0] * o[0] + o[1] * o[1]) + (o[2] * o[2] + o[3] * o[3]);
                        if (outb) { u32x2 w; w.x = cvt_pk_bf16(o[0], o[1]); w.y = cvt_pk_bf16(o[2], o[3]); *(u32x2*)(outb + off + cc) = w; } }
                q += __shfl_xor(q, 16); q += __shfl_xor(q, 32);
                if (fq == 0) ssq_out[(size_t)r * 16 + u.pn * 4 + wc] = q; }
    }
};
struct EpiMem {
    static constexpr bool PERM = false, AFTER_DRAIN = false;
    float* outk; float* outv; bf16_t* km; bf16_t* vt; const float* ssq;
    __device__ __forceinline__ void operator()(const f32x4 (&acc)[2][2][4][2], const Unit& u, int wr, int wc, int fr, int fq) const {
        const int row0 = u.pm * BM + wr * 64 + fr; const bool isv = u.pn >= 4; const int col0 = (u.pn & 3) * BM + wc * 32 + 4 * fq;
#pragma unroll
        for (int ai = 0; ai < 2; ++ai)
#pragma unroll
            for (int m = 0; m < 4; ++m) { const int r = row0 + ai * HALF + m * 16; const float rs = rstd16(ssq, r); const size_t off = (size_t)r * 1024 + col0;
#pragma unroll
                for (int bj = 0; bj < 2; ++bj)
#pragma unroll
                    for (int n = 0; n < 2; ++n) { const int cc = bj * HALF + n * 16; const f32x4 o = acc[ai][bj][m][n] * rs;
                        if (!isv) { *(f32x4*)(outk + off + cc) = o; u32x2 w; w.x = cvt_pk_bf16(o[0], o[1]); w.y = cvt_pk_bf16(o[2], o[3]); *(u32x2*)(km + off + cc) = w; }
                        else { *(f32x4*)(outv + off + cc) = o; const int b = r >> 8, mm = r & 255; const int c = col0 + cc; const int h = c >> 8, d = c & 255;
                            bf16_t* vp = vt + ((size_t)(4 * b + h) * 256 + d) * 256 + mm; const unsigned w0 = cvt_pk_bf16(o[0], o[1]), w1 = cvt_pk_bf16(o[2], o[3]);
                            vp[0] = (bf16_t)(w0 & 0xffffu); vp[256] = (bf16_t)(w0 >> 16); vp[512] = (bf16_t)(w1 & 0xffffu); vp[768] = (bf16_t)(w1 >> 16); } } }
    }
};
struct EpiSoftmax {
    static constexpr bool PERM = true, AFTER_DRAIN = true;
    bf16_t* P;
    __device__ __forceinline__ void fused(f32x4 (&acc)[2][2][4][2], const Unit& u, int wr, int wc, int fr, int fq, PG8_LAS unsigned char* lds, int wid, int lane) const {
        PG8_LAS float* red = (PG8_LAS float*)lds;
        PG8_LAS float* red2 = (PG8_LAS float*)(lds + 4096);
#pragma unroll
        for (int ai = 0; ai < 2; ++ai)
#pragma unroll
            for (int m = 0; m < 4; ++m) { float mx = -3.0e38f;
#pragma unroll
                for (int bj = 0; bj < 2; ++bj)
#pragma unroll
                    for (int n = 0; n < 2; ++n) { const f32x4 x = acc[ai][bj][m][n]; mx = fmaxf(mx, fmaxf(fmaxf(x[0], x[1]), fmaxf(x[2], x[3]))); }
                mx = fmaxf(mx, __shfl_xor(mx, 16)); mx = fmaxf(mx, __shfl_xor(mx, 32));
                if (fq == 0) red[(ai * HALF + wr * 64 + m * 16 + fr) * 4 + wc] = mx; }
        asm volatile("s_waitcnt lgkmcnt(0)" ::: "memory"); __builtin_amdgcn_s_barrier(); asm volatile("" ::: "memory");
#pragma unroll
        for (int ai = 0; ai < 2; ++ai)
#pragma unroll
            for (int m = 0; m < 4; ++m) { const int rr = ai * HALF + wr * 64 + m * 16 + fr; const f32x4 q = *(const PG8_LAS f32x4*)(red + rr * 4);
                const float mx = fmaxf(fmaxf(q[0], q[1]), fmaxf(q[2], q[3])); float s = 0.f;
#pragma unroll
                for (int bj = 0; bj < 2; ++bj)
#pragma unroll
                    for (int n = 0; n < 2; ++n) { f32x4 x = acc[ai][bj][m][n];
#pragma unroll
                        for (int j = 0; j < 4; ++j) { x[j] = __expf(x[j] - mx); s += x[j]; }
                        acc[ai][bj][m][n] = x; }
                s += __shfl_xor(s, 16); s += __shfl_xor(s, 32);
                if (fq == 0) red2[rr * 4 + wc] = s; }
        asm volatile("s_waitcnt lgkmcnt(0)" ::: "memory"); __builtin_amdgcn_s_barrier(); asm volatile("" ::: "memory");
        const int col0 = u.pn * BM + wc * 32 + 8 * fq;
#pragma unroll
        for (int ai = 0; ai < 2; ++ai)
#pragma unroll
            for (int m = 0; m < 4; ++m) { const int rr = ai * HALF + wr * 64 + m * 16 + fr; const f32x4 q = *(const PG8_LAS f32x4*)(red2 + rr * 4);
                const float inv = 1.0f / ((q[0] + q[1]) + (q[2] + q[3])); bf16_t* rowp = P + (size_t)(u.pm * BM + rr) * 1024 + col0;
#pragma unroll
                for (int bj = 0; bj < 2; ++bj) { const f32x4 v0 = acc[ai][bj][m][0] * inv, v1 = acc[ai][bj][m][1] * inv;
                    u32x4 w; w.x = cvt_pk_bf16(v0[0], v0[1]); w.y = cvt_pk_bf16(v0[2], v0[3]); w.z = cvt_pk_bf16(v1[0], v1[1]); w.w = cvt_pk_bf16(v1[2], v1[3]);
                    *(u32x4*)(rowp + bj * HALF) = w; } }
        asm volatile("s_waitcnt lgkmcnt(0)" ::: "memory"); __builtin_amdgcn_s_barrier(); asm volatile("" ::: "memory");
    }
};

template <class Epi, class Sched, bool ALIGN_EPI = false, bool SP2 = false>
__device__ __forceinline__ void gemm_phase(PG8_LAS unsigned char* lds, const Gemm g, const Sched& S, const Epi& E) {
    const int tid = threadIdx.x, wid = __builtin_amdgcn_readfirstlane(tid >> 6), lane = tid & 63, wr = wid >> 2, wc = wid & 3, fr = lane & 15, fq = lane >> 4;
    const int K = g.K, nt = K / BK;
    unsigned voffA[2], voffB[2];
#pragma unroll
    for (int i = 0; i < 2; ++i) { int R, C; stage_rc(tid * 16 + i * 8192, R, C); const int Rb = Epi::PERM ? ((R & ~31) + perm32(R & 31)) : R;
        voffA[i] = (unsigned)(R * g.lda + C) * 2u; voffB[i] = (unsigned)(Rb * g.ldb + C) * 2u; }
    const size_t kstep = (size_t)(BK * 2);
    const size_t hstepA = (size_t)HALF * g.lda * 2, hstepB = (size_t)HALF * g.ldb * 2;
    const unsigned ldsw = (unsigned)wid * 1024u;
    const int aoff = lds_byte(wr * 64 + fr, fq * 8), boff = lds_byte(wc * 32 + fr, fq * 8);
#define PG8_SA(b, h) (((b) * 2 + (h)) * HTB)
#define PG8_SB(b, h) ((4 + (b) * 2 + (h)) * HTB)
#define PG8_STAGE(bufoff, gbase, voff) do { _Pragma("unroll") for (int _i = 0; _i < 2; ++_i) \
        __builtin_amdgcn_global_load_lds((const unsigned*)((const char*)(gbase) + (voff)[_i]), (PG8_LAS unsigned*)(lds + (bufoff) + ldsw + _i * 8192), 16, 0, 0); } while (0)
#define PG8_LDA(dst, b, h) do { _Pragma("unroll") for (int m = 0; m < 4; ++m) _Pragma("unroll") for (int k = 0; k < 2; ++k) dst[m][k] = *(const PG8_LAS bf16x8*)(lds + PG8_SA(b, h) + aoff + m * 2048 + k * 1024); } while (0)
#define PG8_LDB(dst, b, h) do { _Pragma("unroll") for (int n = 0; n < 2; ++n) _Pragma("unroll") for (int k = 0; k < 2; ++k) dst[n][k] = *(const PG8_LAS bf16x8*)(lds + PG8_SB(b, h) + boff + n * 2048 + k * 1024); } while (0)
#define PG8_MMA(ai, bj, At, Bt) do { __builtin_amdgcn_s_setprio(1); _Pragma("unroll") for (int m = 0; m < 4; ++m) _Pragma("unroll") for (int n = 0; n < 2; ++n) _Pragma("unroll") for (int k = 0; k < 2; ++k) \
        acc[ai][bj][m][n] = __builtin_amdgcn_mfma_f32_16x16x32_bf16(Bt[n][k], At[m][k], acc[ai][bj][m][n], 0, 0, 0); __builtin_amdgcn_s_setprio(0); } while (0)
#define PG8_WAIT_V(n) asm volatile("s_waitcnt vmcnt(" #n ")" ::: "memory")
#define PG8_WAIT_L(n) asm volatile("s_waitcnt lgkmcnt(" #n ")" ::: "memory")
#define PG8_BAR __builtin_amdgcn_s_barrier()
#define PG8_SCHED __builtin_amdgcn_sched_barrier(0)
    Unit cur, nxt; int ui = 0;
    if (!S.next(0, cur)) return;
    f32x4 acc[2][2][4][2];
#pragma unroll
    for (int a = 0; a < 2; ++a)
#pragma unroll
        for (int b = 0; b < 2; ++b)
#pragma unroll
            for (int m = 0; m < 4; ++m)
#pragma unroll
                for (int n = 0; n < 2; ++n) acc[a][b][m][n] = (f32x4){0.f, 0.f, 0.f, 0.f};
    bf16x8 At[4][2], B0[2][2], B1[2][2];
    const char* cA = S.abase(g, cur); const char* cB = S.bbase(g, cur);
    S.a_ready(cur);
    if constexpr (SP2) {
        PG8_STAGE(PG8_SB(0, 0), cB, voffB); PG8_STAGE(PG8_SB(0, 1), cB + hstepB, voffB); PG8_STAGE(PG8_SA(0, 0), cA, voffA); PG8_STAGE(PG8_SA(0, 1), cA + hstepA, voffA);
        if (wr == 1) PG8_BAR;
        PG8_WAIT_V(2); PG8_BAR;
        PG8_STAGE(PG8_SB(1, 0), cB + kstep, voffB); PG8_STAGE(PG8_SA(1, 0), cA + kstep, voffA); PG8_STAGE(PG8_SB(1, 1), cB + hstepB + kstep, voffB);
        PG8_WAIT_V(6); PG8_BAR;
    } else {
        PG8_STAGE(PG8_SB(0, 0), cB, voffB); PG8_STAGE(PG8_SA(0, 0), cA, voffA); PG8_STAGE(PG8_SB(0, 1), cB + hstepB, voffB); PG8_STAGE(PG8_SA(0, 1), cA + hstepA, voffA);
        if (wr == 1) PG8_BAR;
        PG8_WAIT_V(4); PG8_BAR;
        PG8_STAGE(PG8_SB(1, 0), cB + kstep, voffB); PG8_STAGE(PG8_SA(1, 0), cA + kstep, voffA); PG8_STAGE(PG8_SB(1, 1), cB + hstepB + kstep, voffB);
        PG8_WAIT_V(6); PG8_BAR;
    }
    for (;;) {
        const bool has_next = S.next(ui + 1, nxt);
        const char* nA = has_next ? S.abase(g, nxt) : cA; const char* nB = has_next ? S.bbase(g, nxt) : cB;
        for (int t = 0; t < nt; t += 2) {
            const bool last = (t == nt - 2);
            const char* a1 = cA + (size_t)(t + 1) * kstep;
            const char* a2 = last ? nA : cA + (size_t)(t + 2) * kstep; const char* b2 = last ? nB : cB + (size_t)(t + 2) * kstep;
            const char* a3 = a2 + kstep; const char* b3 = b2 + kstep;
            if (last && has_next) S.a_ready(nxt);
            if constexpr (SP2) {
            PG8_LDB(B0, 0, 0); PG8_LDB(B1, 0, 1); PG8_SCHED; PG8_LDA(At, 0, 0); PG8_STAGE(PG8_SA(1, 1), a1 + hstepA, voffA);
            PG8_WAIT_V(8); PG8_WAIT_L(0); PG8_BAR; PG8_MMA(0, 0, At, B0); PG8_MMA(0, 1, At, B1); PG8_BAR; PG8_SCHED;
            PG8_LDA(At, 0, 1); PG8_STAGE(PG8_SB(0, 0), b2, voffB); PG8_STAGE(PG8_SB(0, 1), b2 + hstepB, voffB); PG8_STAGE(PG8_SA(0, 0), a2, voffA);
            PG8_WAIT_V(8); PG8_WAIT_L(0); PG8_BAR; PG8_MMA(1, 0, At, B0); PG8_MMA(1, 1, At, B1); PG8_BAR; PG8_SCHED;
            PG8_LDB(B0, 1, 0); PG8_LDB(B1, 1, 1); PG8_SCHED; PG8_LDA(At, 1, 0); PG8_STAGE(PG8_SA(0, 1), a2 + hstepA, voffA);
            PG8_WAIT_V(8); PG8_WAIT_L(0); PG8_BAR; PG8_MMA(0, 0, At, B0); PG8_MMA(0, 1, At, B1); PG8_BAR; PG8_SCHED;
            PG8_LDA(At, 1, 1); PG8_STAGE(PG8_SB(1, 0), b3, voffB); PG8_STAGE(PG8_SB(1, 1), b3 + hstepB, voffB); PG8_STAGE(PG8_SA(1, 0), a3, voffA);
            PG8_WAIT_V(8); PG8_WAIT_L(0); PG8_BAR; PG8_MMA(1, 0, At, B0); PG8_MMA(1, 1, At, B1); PG8_BAR; PG8_SCHED;
            } else {
            PG8_LDB(B0, 0, 0); PG8_SCHED; PG8_LDA(At, 0, 0); PG8_STAGE(PG8_SA(1, 1), a1 + hstepA, voffA);
            PG8_WAIT_L(8); PG8_BAR; PG8_WAIT_L(0); PG8_MMA(0, 0, At, B0); PG8_BAR; PG8_SCHED;
            PG8_LDB(B1, 0, 1); PG8_STAGE(PG8_SB(0, 0), b2, voffB);
            PG8_BAR; PG8_WAIT_L(0); PG8_MMA(0, 1, At, B1); PG8_BAR;
            PG8_LDA(At, 0, 1); PG8_STAGE(PG8_SA(0, 0), a2, voffA);
            PG8_BAR; PG8_WAIT_L(0); PG8_MMA(1, 0, At, B0); PG8_BAR; PG8_SCHED;
            PG8_STAGE(PG8_SB(0, 1), b2 + hstepB, voffB);
            PG8_WAIT_V(6); PG8_BAR; PG8_MMA(1, 1, At, B1); PG8_BAR;
            PG8_LDB(B0, 1, 0); PG8_SCHED; PG8_LDA(At, 1, 0); PG8_STAGE(PG8_SA(0, 1), a2 + hstepA, voffA);
            PG8_WAIT_L(8); PG8_BAR; PG8_WAIT_L(0); PG8_MMA(0, 0, At, B0); PG8_BAR; PG8_SCHED;
            PG8_LDB(B1, 1, 1); PG8_STAGE(PG8_SB(1, 0), b3, voffB);
            PG8_BAR; PG8_WAIT_L(0); PG8_MMA(0, 1, At, B1); PG8_BAR;
            PG8_LDA(At, 1, 1); PG8_STAGE(PG8_SA(1, 0), a3, voffA);
            PG8_BAR; PG8_WAIT_L(0); PG8_MMA(1, 0, At, B0); PG8_BAR; PG8_SCHED;
            PG8_STAGE(PG8_SB(1, 1), b3 + hstepB, voffB);
            PG8_WAIT_V(6); PG8_BAR; PG8_MMA(1, 1, At, B1); PG8_BAR;
            }
        }
        if constexpr (ALIGN_EPI) { if (wr == 0) PG8_BAR; }
        if constexpr (!Epi::AFTER_DRAIN) { E(acc, cur, wr, wc, fr, fq); S.done(cur); }
        if (!has_next) break;
#pragma unroll
        for (int a = 0; a < 2; ++a)
#pragma unroll
            for (int b = 0; b < 2; ++b)
#pragma unroll
                for (int m = 0; m < 4; ++m)
#pragma unroll
                    for (int n = 0; n < 2; ++n) acc[a][b][m][n] = (f32x4){0.f, 0.f, 0.f, 0.f};
        cur = nxt; cA = nA; cB = nB; ++ui;
        if constexpr (ALIGN_EPI) { if (wr == 1) PG8_BAR; }
    }
    PG8_WAIT_V(0);
    if constexpr (!ALIGN_EPI) { if (wr == 0) PG8_BAR; }
    PG8_BAR;
    if constexpr (Epi::AFTER_DRAIN) { E.fused(acc, cur, wr, wc, fr, fq, lds, wid, lane); S.done(cur); }
#undef PG8_SA
#undef PG8_SB
#undef PG8_STAGE
#undef PG8_LDA
#undef PG8_LDB
#undef PG8_MMA
#undef PG8_WAIT_V
#undef PG8_WAIT_L
#undef PG8_BAR
#undef PG8_SCHED
}
}

constexpr int NWAVES = 8, NTHREADS = 512;
constexpr int N_PHASES = 15;
constexpr int N_LAUNCHES = MK_N_LAUNCHES;
constexpr int D = 1024, FF = 2816, NGU = 2 * FF, NIN = 2304, D_INP = 2316;
constexpr int BATCH = 8, SEQ = 2048, MP = BATCH * SEQ, DEC_B = 128, DEC_T = 4, MS = DEC_B * DEC_T, M = MP + MS;
constexpr int D_POOL = 256, D_SSM = 768, NH = 12, HD = 64, NST = 128, CONV_DIM = 1280, CHUNK = 128, NCH = SEQ / CHUNK;
constexpr int XBC0 = 1024;
constexpr int NMEM = 256, MEMROWS = BATCH * NMEM;
constexpr float EPS = 1e-6f;

constexpr size_t MiB = 1u << 20;
constexpr size_t WS_CTL = 0, CTL_ZERO_BYTES = 1 * MiB;
constexpr size_t WS_W1GU = 2 * MiB, WS_W1D = 13 * MiB, WS_WIN = 19 * MiB, WS_WOUT = 24 * MiB, WS_WQ = 26 * MiB, WS_WO = 28 * MiB, WS_WMKV = 30 * MiB, WS_W2GU = 34 * MiB, WS_W2D = 45 * MiB, WS_DTR = 51 * MiB;
constexpr size_t WS_SSQ0 = 52 * MiB, WS_SSQ1 = 54 * MiB, WS_SSQY = 56 * MiB, WS_SSQ2 = 58 * MiB, WS_SSQ3 = 60 * MiB, WS_SSQ4 = 62 * MiB, WS_SSQM = 64 * MiB;
constexpr size_t WS_EXPA = 65 * MiB, WS_CD = 66 * MiB;
constexpr size_t WS_MBF = 68 * MiB, WS_KM = 72 * MiB, WS_VT = 76 * MiB;
constexpr size_t WS_XB = 80 * MiB;
constexpr size_t WS_X = 114 * MiB;
constexpr size_t WS_A2 = 180 * MiB;
constexpr size_t WS_ACT = 214 * MiB;
constexpr size_t WS_YD = 214 * MiB, WS_ST = 262 * MiB;
constexpr size_t WS_PROJ = 310 * MiB;
constexpr size_t WS_Q = 310 * MiB, WS_PB = 343 * MiB;
constexpr size_t WS_HP = 385 * MiB, WS_CB = 409 * MiB;
constexpr size_t WS_O = 385 * MiB;
constexpr size_t WS_END = 420 * MiB;
static_assert(WS_W1GU + (size_t)NGU * D * 2 <= WS_W1D && WS_W1D + (size_t)D * FF * 2 <= WS_WIN && WS_WIN + (size_t)NIN * D * 2 <= WS_WOUT && WS_W2GU + (size_t)NGU * D * 2 <= WS_W2D && WS_W2D + (size_t)D * FF * 2 <= WS_DTR && WS_DTR + (size_t)M * 12 * 4 <= WS_SSQ0 && WS_WIN + (size_t)(NIN + 256) * D * 2 <= WS_WOUT, "weights map");
static_assert(WS_SSQ0 + (size_t)M * 64 <= WS_SSQ1 && WS_XB + (size_t)M * D * 2 <= WS_X && WS_X + (size_t)M * D * 4 <= WS_A2 && WS_A2 + (size_t)M * D * 2 <= WS_ACT, "ws map 1");
static_assert(WS_ACT + (size_t)M * FF * 2 <= WS_PROJ && WS_YD + (size_t)MP * D_SSM * 4 <= WS_ST && WS_ST + (size_t)BATCH * NCH * NH * HD * NST * 4 <= WS_PROJ, "ws map 2");
static_assert(WS_PROJ + (size_t)M * NIN * 2 <= WS_HP && WS_Q + (size_t)M * D * 2 <= WS_PB && WS_PB + (size_t)MP * D * 2 <= WS_HP, "ws map 3");
static_assert(WS_HP + (size_t)BATCH * NCH * NH * HD * NST * 2 <= WS_CB && WS_CB + (size_t)MP * 256 * 2 <= WS_END && WS_O + (size_t)M * D * 2 <= WS_END, "ws map 4");
constexpr int CW_BAR = 4096;

constexpr size_t OUT_Y = 0, OUT_MK = (size_t)M * D, OUT_MV = OUT_MK + (size_t)MEMROWS * D, OUT_POOLP = OUT_MV + (size_t)MEMROWS * D, OUT_CONVP = OUT_POOLP + (size_t)BATCH * 15 * D_POOL,
    OUT_SSMP = OUT_CONVP + (size_t)BATCH * 3 * CONV_DIM, OUT_POOLS = OUT_SSMP + (size_t)BATCH * NH * HD * NST, OUT_CONVS = OUT_POOLS + (size_t)DEC_B * 15 * D_POOL, OUT_SSMS = OUT_CONVS + (size_t)DEC_B * 3 * CONV_DIM,
    OUT_TOTAL = OUT_SSMS + (size_t)DEC_B * NH * HD * NST;
static_assert(OUT_TOTAL == 35909632, "output size");

constexpr int RING_OFF = 0, RING_BYTES = 153600;
constexpr int LDSCTL_OFF = RING_BYTES, MISC_OFF = LDSCTL_OFF + 320;
constexpr int LDS_BYTES = 163840;
static_assert(MISC_OFF + 128 <= LDS_BYTES, "LDS map");

#define GAS __attribute__((address_space(1)))
#define LAS __attribute__((address_space(3)))
typedef unsigned short bf16;
typedef unsigned v4u __attribute__((ext_vector_type(4)));
typedef unsigned v2u __attribute__((ext_vector_type(2)));
typedef float f32x4 __attribute__((ext_vector_type(4)));
typedef short bf16x8 __attribute__((ext_vector_type(8)));
typedef GAS unsigned gu32;
#define RLX_AGENT __ATOMIC_RELAXED, __HIP_MEMORY_SCOPE_AGENT
#define LDS_WAIT() asm volatile("s_waitcnt lgkmcnt(0)" ::: "memory")
#define VM_WAIT() asm volatile("s_waitcnt vmcnt(0)" ::: "memory")
__device__ __forceinline__ unsigned f2bf(float f) { unsigned u = __builtin_bit_cast(unsigned, f); return (u + 0x7fffu + ((u >> 16) & 1u)) >> 16; }
__device__ __forceinline__ unsigned pk2(float lo, float hi) { return f2bf(lo) | (f2bf(hi) << 16); }
__device__ __forceinline__ float bf2f(unsigned b) { return __builtin_bit_cast(float, (b & 0xffffu) << 16); }
__device__ __forceinline__ float bflo(unsigned w) { return __builtin_bit_cast(float, w << 16); }
__device__ __forceinline__ float bfhi(unsigned w) { return __builtin_bit_cast(float, w & 0xffff0000u); }
__device__ __forceinline__ float siluf(float x) { return x / (1.0f + __expf(-x)); }
__device__ __forceinline__ float softplusf(float x) { return fmaxf(x, 0.f) + log1pf(__expf(-fabsf(x))); }
__device__ __forceinline__ float wave_sum(float v) {
#pragma unroll
    for (int o = 1; o < 64; o <<= 1) v += __shfl_xor(v, o);
    return v;
}
#define WG_BAR() do { asm volatile("s_waitcnt vmcnt(0) lgkmcnt(0)" ::: "memory"); __builtin_amdgcn_s_barrier(); asm volatile("" ::: "memory"); } while (0)
#define MFMA16(a, b, c) __builtin_amdgcn_mfma_f32_16x16x32_bf16((a), (b), (c), 0, 0, 0)

#define XB_TMO      128
#define XB_XCNT(j)  (256  + 64 * (j))
#define XB_XSUB(j)  (1280 + 64 * (j))
#define XB_XGEN(j)  (2304 + 64 * (j))
#define XB_TOP      3328
#define XB_TOPGEN   3392
#define XCD_BAR_WORDS 3456
#define XB_SPIN_CAP (1u << 18)

__device__ __forceinline__ unsigned xb_ld(unsigned* p)              { return __hip_atomic_load(p, __ATOMIC_RELAXED, __HIP_MEMORY_SCOPE_AGENT); }
__device__ __forceinline__ unsigned xb_add(unsigned* p, unsigned v) { return __hip_atomic_fetch_add(p, v, __ATOMIC_RELAXED, __HIP_MEMORY_SCOPE_AGENT); }
__device__ __forceinline__ unsigned xb_xcc_id() { return (unsigned)__builtin_amdgcn_s_getreg((3 << 11) | 20) & 0xFu; }
#define XB_SPIN(cond, bar) do { unsigned _sp = 0; while (cond) { __builtin_amdgcn_s_sleep(1); \
    if ((++_sp & 255u) == 0u) { if (xb_ld(&(bar)[XB_TMO])) break; if (_sp > XB_SPIN_CAP) { atomicAdd(&(bar)[XB_TMO], 1u); break; } } } } while (0)

struct XcdBarrier {
    unsigned* bar; unsigned x;
    volatile LAS unsigned* st;
};

__device__ __forceinline__ XcdBarrier xcd_barrier_post(unsigned* bar, volatile LAS unsigned* st) {
    XcdBarrier b; b.bar = bar; b.x = xb_xcc_id(); b.st = st;
    if (threadIdx.x == 0) (void)xb_add(&bar[XB_XCNT(b.x)], 1u);
    return b;
}
__device__ __forceinline__ void xcd_barrier_complete(unsigned* bar, unsigned x, unsigned& nloc, unsigned& nx) {
    const unsigned G = gridDim.x * gridDim.y * gridDim.z;
    unsigned sum, cnt, mine, sp = 0u;
    for (;;) {
        sum = 0u; cnt = 0u; mine = 0u;
#pragma unroll
        for (unsigned j = 0; j < 16; ++j) { const unsigned c = xb_ld(&bar[XB_XCNT(j)]); sum += c; cnt += (c > 0u) ? 1u : 0u; mine = (j == x) ? c : mine; }
        if (sum == G) break;
        __builtin_amdgcn_s_sleep(1);
        if ((++sp & 255u) == 0u) { if (xb_ld(&bar[XB_TMO])) break; if (sp > XB_SPIN_CAP) { atomicAdd(&bar[XB_TMO], 1u); break; } }
    }
    nloc = mine > 0u ? mine : 1u; nx = cnt > 0u ? cnt : 1u;
}

__device__ __forceinline__ void xcd_barrier(const XcdBarrier& b) {
    asm volatile("s_waitcnt vmcnt(0)" ::: "memory");
    __syncthreads();
    if (threadIdx.x == 0) {
        unsigned* bar = b.bar;
        __builtin_amdgcn_s_waitcnt(0);
        unsigned nloc = b.st[0], nx = b.st[1];
        if (nloc == 0u) { xcd_barrier_complete(bar, b.x, nloc, nx); b.st[0] = nloc; b.st[1] = nx; }
        const unsigned old = xb_add(&bar[XB_XSUB(b.x)], 1u);
        const unsigned gen = old / nloc;
        if (old + 1u == (gen + 1u) * nloc) {
            __builtin_amdgcn_fence(__ATOMIC_RELEASE, "agent");
            asm volatile("s_waitcnt vmcnt(0)" ::: "memory");
            const unsigned og = xb_add(&bar[XB_TOP], 1u);
            const unsigned tg = og / nx;
            if (og + 1u == (tg + 1u) * nx) xb_add(&bar[XB_TOPGEN], 1u);
            else XB_SPIN(xb_ld(&bar[XB_TOPGEN]) == tg, bar);
            __builtin_amdgcn_fence(__ATOMIC_ACQUIRE, "agent");
            xb_add(&bar[XB_XGEN(b.x)], 1u);
            asm volatile("s_waitcnt vmcnt(0)" ::: "memory");
        } else {
            XB_SPIN(xb_ld(&bar[XB_XGEN(b.x)]) == gen, bar);
            __builtin_amdgcn_fence(__ATOMIC_ACQUIRE, "agent");
            asm volatile("s_waitcnt vmcnt(0)" ::: "memory");
        }
    }
    __syncthreads();
}

struct Frame {
    LAS unsigned char* lds;
    volatile LAS unsigned* MISC;
    gu32* ctl;
    int tid, lane, wave, G, bid;
    LAS unsigned* ptab;
    float* out; unsigned char* ws;
};
__device__ __forceinline__ const float* ld_inp(const Frame& F, int i) {
    const unsigned lo = __builtin_amdgcn_readfirstlane(F.ptab[2 * i]), hi = __builtin_amdgcn_readfirstlane(F.ptab[2 * i + 1]);
    return (const float*)(const GAS float*)(((unsigned long long)hi << 32) | lo);
}
#define INP(i) ld_inp(F, (i))
enum { I_XP = 0, I_XS, I_MEMP, I_CK, I_CV, I_SPOOL, I_SCONV, I_SSSM, I_GFFN1, I_W1G, I_W1U, I_W1D, I_GMIX, I_WIN, I_CONVW, I_CONVB, I_DTB, I_ALOG, I_DSKIP, I_SSMN, I_WPOOL, I_PSCALE, I_WOUT,
       I_GMEM, I_WMK, I_WMV, I_GXQ, I_WXQ, I_WXO, I_GFFN2, I_W2G, I_W2U, I_W2D, I_GFIN };
#define WSP(T, off) ((T*)(F.ws + (off)))

__device__ __forceinline__ void p0_transpose_item(const float* W, int ldw, int N, bf16* WT, int ldt, int kdst, int rowmode, int row_off, const float* gain, float scale, LAS float* scr, int item, int lane) {
    const int nblk = N / 32, kb = item / nblk, nb = item % nblk, k0 = 64 * kb, n0 = 32 * nb;
#pragma unroll 8
    for (int i = 0; i < 32; ++i) { const int kk = 2 * i + (lane >> 5); const float gsc = (gain ? gain[k0 + kk] : 1.0f) * scale; scr[kk * 33 + (lane & 31)] = W[(size_t)(k0 + kk) * ldw + n0 + (lane & 31)] * gsc; }
    LDS_WAIT(); asm volatile("" ::: "memory");
    const int rowf = rowmode == 0 ? row_off + n0 : (n0 >> 7) * 256 + (rowmode == 2 ? 128 : 0) + (n0 & 127);
    const int c = lane & 7;
#pragma unroll
    for (int j = 0; j < 4; ++j) { const int n = (lane >> 3) + 8 * j; const LAS float* s = scr + (8 * c) * 33 + n;
        v4u o; o.x = pk2(s[0 * 33], s[1 * 33]); o.y = pk2(s[2 * 33], s[3 * 33]); o.z = pk2(s[4 * 33], s[5 * 33]); o.w = pk2(s[6 * 33], s[7 * 33]);
        *(GAS v4u*)(WT + (size_t)(rowf + n) * ldt + kdst + k0 + 8 * c) = o; }
    LDS_WAIT(); asm volatile("" ::: "memory");
}
__device__ __forceinline__ void row_to_bf16_ssq(const float* xrow, bf16* orow, float* ssq16, int lane) {
    const GAS f32x4* xr = (const GAS f32x4*)xrow + lane;
    f32x4 v[4]; float s = 0.f;
#pragma unroll
    for (int j = 0; j < 4; ++j) { v[j] = xr[64 * j]; s += (v[j].x * v[j].x + v[j].y * v[j].y) + (v[j].z * v[j].z + v[j].w * v[j].w); }
    s = wave_sum(s);
    GAS unsigned long long* o8 = (GAS unsigned long long*)orow + lane;
#pragma unroll
    for (int j = 0; j < 4; ++j) o8[64 * j] = (unsigned long long)pk2(v[j].x, v[j].y) | ((unsigned long long)pk2(v[j].z, v[j].w) << 32);
    if (lane < 16) ssq16[lane] = lane == 0 ? s : 0.f;
}
__device__ __forceinline__ void p0_prologue(Frame& F) {
    LAS float* scr = (LAS float*)(F.lds + RING_OFF + F.wave * 16384);
    const int gw = F.bid * NWAVES + F.wave, NGW = F.G * NWAVES, lane = F.lane;
    constexpr int I_GU = (D / 64) * (FF / 32), I_DN = (FF / 64) * (D / 32), I_IN = (D / 64) * (NIN / 32), I_OUT = (D_SSM / 64) * (D / 32), I_SQ = (D / 64) * (D / 32);
    constexpr int NT = 4 * I_GU + 2 * I_DN + I_IN + I_OUT + 4 * I_SQ;
    for (int it = gw; it < NT; it += NGW) {
        int r = it;
        if (r < I_GU) { p0_transpose_item(INP(I_W1G), FF, FF, WSP(bf16, WS_W1GU), D, 0, 1, 0, INP(I_GFFN1), 1.f, scr, r, lane); continue; } r -= I_GU;
        if (r < I_GU) { p0_transpose_item(INP(I_W1U), FF, FF, WSP(bf16, WS_W1GU), D, 0, 2, 0, INP(I_GFFN1), 1.f, scr, r, lane); continue; } r -= I_GU;
        if (r < I_GU) { p0_transpose_item(INP(I_W2G), FF, FF, WSP(bf16, WS_W2GU), D, 0, 1, 0, INP(I_GFFN2), 1.f, scr, r, lane); continue; } r -= I_GU;
        if (r < I_GU) { p0_transpose_item(INP(I_W2U), FF, FF, WSP(bf16, WS_W2GU), D, 0, 2, 0, INP(I_GFFN2), 1.f, scr, r, lane); continue; } r -= I_GU;
        if (r < I_DN) { p0_transpose_item(INP(I_W1D), D, D, WSP(bf16, WS_W1D), FF, 0, 0, 0, nullptr, 1.f, scr, r, lane); continue; } r -= I_DN;
        if (r < I_DN) { p0_transpose_item(INP(I_W2D), D, D, WSP(bf16, WS_W2D), FF, 0, 0, 0, nullptr, 1.f, scr, r, lane); continue; } r -= I_DN;
        if (r < I_IN) { p0_transpose_item(INP(I_WIN), D_INP, NIN, WSP(bf16, WS_WIN), D, 0, 0, 0, INP(I_GMIX), 1.f, scr, r, lane); continue; } r -= I_IN;
        if (r < I_OUT) { p0_transpose_item(INP(I_WOUT) + (size_t)D_POOL * D, D, D, WSP(bf16, WS_WOUT), D, D_POOL, 0, 0, INP(I_SSMN), 1.f, scr, r, lane); continue; } r -= I_OUT;
        if (r < I_SQ) { p0_transpose_item(INP(I_WXQ), D, D, WSP(bf16, WS_WQ), D, 0, 0, 0, INP(I_GXQ), 0.0625f, scr, r, lane); continue; } r -= I_SQ;
        if (r < I_SQ) { p0_transpose_item(INP(I_WXO), D, D, WSP(bf16, WS_WO), D, 0, 0, 0, nullptr, 1.f, scr, r, lane); continue; } r -= I_SQ;
        if (r < I_SQ) { p0_transpose_item(INP(I_WMK), D, D, WSP(bf16, WS_WMKV), D, 0, 0, 0, INP(I_GMEM), 1.f, scr, r, lane); continue; } r -= I_SQ;
        p0_transpose_item(INP(I_WMV), D, D, WSP(bf16, WS_WMKV), D, 0, 0, D, INP(I_GMEM), 1.f, scr, r, lane);
    }
    { const float* wp = INP(I_WPOOL); const float* ps = INP(I_PSCALE); const float* wo = INP(I_WOUT); bf16* WT = WSP(bf16, WS_WOUT);
        for (int it = gw; it < D * 4; it += NGW) { const int n = it >> 2, g = it & 3; float acc = 0.f; const float* wrow = wp + (size_t)(g * 64 + lane) * 64;
#pragma unroll 8
            for (int d = 0; d < 64; ++d) acc += wrow[d] * (ps[g * 64 + d] * wo[(size_t)(g * 64 + d) * D + n]);
            WT[(size_t)n * D + g * 64 + lane] = (bf16)f2bf(acc); } }
    { bf16* wt = WSP(bf16, WS_WIN); const float* win = INP(I_WIN); const float* gm = INP(I_GMIX);
        for (int i = F.bid * NTHREADS + F.tid; i < NH * D; i += F.G * NTHREADS) { const int h = i >> 10, k = i & 1023; wt[(size_t)(NIN + h) * D + k] = (bf16)f2bf(gm[k] * win[(size_t)k * D_INP + NIN + h]); }
        v4u* z = (v4u*)(wt + (size_t)(NIN + NH) * D);
        for (int i = F.bid * NTHREADS + F.tid; i < (256 - NH) * D / 8; i += F.G * NTHREADS) z[i] = (v4u){0u, 0u, 0u, 0u}; }
    for (int m = gw; m < M; m += NGW) { const float* xr = m < MP ? INP(I_XP) + (size_t)m * D : INP(I_XS) + (size_t)(m - MP) * D; row_to_bf16_ssq(xr, WSP(bf16, WS_XB) + (size_t)m * D, WSP(float, WS_SSQ0) + (size_t)m * 16, lane); }
    for (int m = gw; m < MEMROWS; m += NGW) row_to_bf16_ssq(INP(I_MEMP) + (size_t)m * D, WSP(bf16, WS_MBF) + (size_t)m * D, WSP(float, WS_SSQM) + (size_t)m * 16, lane);
}

constexpr int MX_PITCHB = 272;
constexpr int MX_TILE = 128 * MX_PITCHB;
constexpr int MX_RC = 0, MX_RB = MX_TILE, MX_RBT = 2 * MX_TILE, MX_X1 = 3 * MX_TILE, MX_DT = 4 * MX_TILE, MX_ACS = MX_DT + 3072, MX_DE = MX_ACS + 3072, MX_END = MX_DE + 3072;
static_assert(MX_END <= RING_BYTES, "mix LDS map");

__device__ __forceinline__ void conv_load(const bf16* PROJ, const float* cw, const float* cb, size_t rowbase, int t0, int l0, int col, int cx, unsigned short (&in)[19], float (&wt)[5]) {
#pragma unroll
    for (int i = 0; i < 19; ++i) { const int t = t0 + l0 - 3 + i; const int tt = t < 0 ? 0 : t; const unsigned short x = PROJ[(unsigned)((int)rowbase + tt) * (unsigned)NIN + (unsigned)col]; in[i] = t < 0 ? (unsigned short)0 : x; }
    wt[0] = cw[cx]; wt[1] = cw[CONV_DIM + cx]; wt[2] = cw[2 * CONV_DIM + cx]; wt[3] = cw[3 * CONV_DIM + cx]; wt[4] = cb[cx];
}
__device__ __forceinline__ void conv_eval(const unsigned short (&in)[19], const float (&wt)[5], float (&v)[16]) {
    float f[19];
#pragma unroll
    for (int i = 0; i < 19; ++i) f[i] = bf2f(in[i]);
#pragma unroll
    for (int j = 0; j < 16; ++j) v[j] = siluf(f[j] * wt[0] + f[j + 1] * wt[1] + f[j + 2] * wt[2] + f[j + 3] * wt[3] + wt[4]);
}
template <int W> __device__ __forceinline__ void pool_prompt_chunk(const bf16* PROJ, bf16* A2, float* outp, int b, int t0, int l0, int ucol, bool last_chunk) {
    const size_t rowbase = (size_t)b * SEQ;
    float v[31 + W];
#pragma unroll
    for (int i = 0; i < 31 + W; ++i) { const int t = t0 + l0 - (W - 1) + i; const int tt = t < 0 ? 0 : t; const float x = bf2f(PROJ[(unsigned)((int)rowbase + tt) * (unsigned)NIN + (unsigned)ucol]); v[i] = t < 0 ? 0.f : x; }
#pragma unroll
    for (int i = 0; i < 32; ++i) { float s = 0.f;
#pragma unroll
        for (int j = 0; j < W; ++j) s += v[i + j];
        const int t = t0 + l0 + i; const float cnt = (float)(t + 1 < W ? t + 1 : W);
        const float u = v[i + W - 1], p = s / cnt - u;
        A2[(rowbase + t) * D + ucol] = (bf16)f2bf(p);
        if (last_chunk && t >= SEQ - 15) outp[((size_t)b * 15 + (t - (SEQ - 15))) * D_POOL + ucol] = u; }
}
__device__ __forceinline__ v4u pack8(const float* v) { v4u o; o.x = pk2(v[0], v[1]); o.y = pk2(v[2], v[3]); o.z = pk2(v[4], v[5]); o.w = pk2(v[6], v[7]); return o; }

__device__ __forceinline__ void mix_prompt_item(Frame& F, int b, int c, int g) {
    const int tid = F.tid, lane = F.lane, w = F.wave, fr = lane & 15, fq = lane >> 4;
    const int t0 = c * CHUNK; const size_t rowbase = (size_t)b * SEQ, row0 = rowbase + t0;
    const bf16* PROJ = WSP(const bf16, WS_PROJ); const float* DTR = WSP(const float, WS_DTR);
    float* EXPA = WSP(float, WS_EXPA); float* CDp = WSP(float, WS_CD); bf16* CB = WSP(bf16, WS_CB); float* YD = WSP(float, WS_YD); float* ST = WSP(float, WS_ST); bf16* A2 = WSP(bf16, WS_A2);
    const float* cw = INP(I_CONVW); const float* cbias = INP(I_CONVB);
    LAS float* dtL = (LAS float*)(F.lds + MX_DT); LAS float* acsL = (LAS float*)(F.lds + MX_ACS); LAS float* deL = (LAS float*)(F.lds + MX_DE);
    LAS unsigned char* lds = F.lds;
    const bool lastc = (c == NCH - 1);
    const int cn = tid & 63, lc = tid >> 6, l0 = 16 * lc;
    unsigned short inA[19], inB[19]; float wtA[5], wtB[5];
    { const float* dtb = INP(I_DTB);
        for (int idx = tid; idx < 6 * 128; idx += NTHREADS) { const int hl = idx >> 7, l = idx & 127; dtL[idx] = softplusf(DTR[(row0 + l) * NH + 6 * g + hl] + dtb[6 * g + hl]); } }
    conv_load(PROJ, cw, cbias, rowbase, t0, l0, XBC0 + D_SSM + g * 128 + cn, D_SSM + g * 128 + cn, inA, wtA);
    WG_BAR();
    if (w < 6) { const int h = 6 * g + w; const float a = -__expf(INP(I_ALOG)[h]);
        const float d0 = dtL[w * 128 + 2 * lane], d1 = dtL[w * 128 + 2 * lane + 1]; const float v0 = d0 * a, v1 = d1 * a; float s = v0 + v1;
#pragma unroll
        for (int o = 1; o < 64; o <<= 1) { const float t = __shfl_up(s, o); if (lane >= o) s += t; }
        const float a0 = s - v1, a1 = s, last = __shfl(s, 63);
        acsL[w * 128 + 2 * lane] = a0; acsL[w * 128 + 2 * lane + 1] = a1;
        deL[w * 128 + 2 * lane] = __expf(last - a0) * d0; deL[w * 128 + 2 * lane + 1] = __expf(last - a1) * d1;
        EXPA[(row0 + 2 * lane) * NH + h] = __expf(a0); EXPA[(row0 + 2 * lane + 1) * NH + h] = __expf(a1);
        if (lane == 63) CDp[((size_t)b * NCH + c) * NH + h] = __expf(last); }
#pragma unroll
    for (int rd = 0; rd < 4; ++rd) { const int isC = rd >> 1, hf = rd & 1, cx0 = D_SSM + isC * 256 + g * 128 + hf * 64;
        unsigned short (&cur)[19] = (rd & 1) ? inB : inA; float (&cwt)[5] = (rd & 1) ? wtB : wtA; unsigned short (&nxt)[19] = (rd & 1) ? inA : inB; float (&nwt)[5] = (rd & 1) ? wtA : wtB;
        if (rd < 3) { const int nx0 = D_SSM + ((rd + 1) >> 1) * 256 + g * 128 + ((rd + 1) & 1) * 64; conv_load(PROJ, cw, cbias, rowbase, t0, l0, XBC0 + nx0 + cn, nx0 + cn, nxt, nwt); }
        else conv_load(PROJ, cw, cbias, rowbase, t0, l0, XBC0 + (6 * g) * 64 + cn, (6 * g) * 64 + cn, nxt, nwt);
        float v[16]; conv_eval(cur, cwt, v); const int n = hf * 64 + cn;
        if (!isC) {
#pragma unroll
            for (int j = 0; j < 16; ++j) *(LAS unsigned short*)(lds + MX_RB + (l0 + j) * MX_PITCHB + n * 2) = (unsigned short)f2bf(v[j]);
            *(LAS v4u*)(lds + MX_RBT + n * MX_PITCHB + l0 * 2) = pack8(v); *(LAS v4u*)(lds + MX_RBT + n * MX_PITCHB + l0 * 2 + 16) = pack8(v + 8);
        } else {
#pragma unroll
            for (int j = 0; j < 16; ++j) { const unsigned short q = (unsigned short)f2bf(v[j]); *(LAS unsigned short*)(lds + MX_RC + (l0 + j) * MX_PITCHB + n * 2) = q; CB[(row0 + l0 + j) * 256 + g * 128 + n] = q; }
        }
        if (lastc && lc == 7) {
#pragma unroll
            for (int j = 0; j < 3; ++j) F.out[OUT_CONVP + ((size_t)b * 3 + j) * CONV_DIM + cx0 + cn] = bf2f(cur[16 + j]); }
        __builtin_amdgcn_sched_barrier(0); }
    WG_BAR();
    f32x4 sc[8];
    { bf16x8 cf[4];
#pragma unroll
        for (int ks = 0; ks < 4; ++ks) cf[ks] = *(const LAS bf16x8*)(lds + MX_RC + (16 * w + fr) * MX_PITCHB + (32 * ks + 8 * fq) * 2);
#pragma unroll
        for (int sb = 0; sb < 8; ++sb) { f32x4 a = (f32x4){0.f, 0.f, 0.f, 0.f};
#pragma unroll
            for (int ks = 0; ks < 4; ++ks) { const bf16x8 bf_ = *(const LAS bf16x8*)(lds + MX_RB + (16 * sb + fr) * MX_PITCHB + (32 * ks + 8 * fq) * 2); a = MFMA16(bf_, cf[ks], a); }
            sc[sb] = a; __builtin_amdgcn_sched_barrier(0); } }
    WG_BAR();
    for (int i = lane; i < 256; i += 64) *(LAS v4u*)(lds + MX_RC + (16 * w + (i >> 4)) * MX_PITCHB + (i & 15) * 16) = (v4u){0u, 0u, 0u, 0u};
    for (int hl = 0; hl < 6; ++hl) { const int h = 6 * g + hl; const int xb = (hl & 1) ? MX_X1 : MX_RB;
        if (hl > 0) conv_load(PROJ, cw, cbias, rowbase, t0, l0, XBC0 + h * 64 + cn, h * 64 + cn, inA, wtA);
        { float v[16]; conv_eval(inA, wtA, v);
            *(LAS v4u*)(lds + xb + cn * MX_PITCHB + l0 * 2) = pack8(v); *(LAS v4u*)(lds + xb + cn * MX_PITCHB + l0 * 2 + 16) = pack8(v + 8);
            float vd[16];
#pragma unroll
            for (int j = 0; j < 16; ++j) vd[j] = v[j] * deL[hl * 128 + l0 + j];
            *(LAS v4u*)(lds + xb + (64 + cn) * MX_PITCHB + l0 * 2) = pack8(vd); *(LAS v4u*)(lds + xb + (64 + cn) * MX_PITCHB + l0 * 2 + 16) = pack8(vd + 8);
            if (lastc && lc == 7) {
#pragma unroll
                for (int j = 0; j < 3; ++j) F.out[OUT_CONVP + ((size_t)b * 3 + j) * CONV_DIM + h * 64 + cn] = bf2f(inA[16 + j]); } }
        __builtin_amdgcn_sched_barrier(0);
        { const int l = 16 * w + fr; const float al = acsL[hl * 128 + l];
#pragma unroll
            for (int sb = 0; sb < 8; ++sb) if (sb <= w) { const int s0 = 16 * sb + 4 * fq; const f32x4 as = *(const LAS f32x4*)(acsL + hl * 128 + s0), ds = *(const LAS f32x4*)(dtL + hl * 128 + s0);
                float o[4];
#pragma unroll
                for (int r = 0; r < 4; ++r) o[r] = (s0 + r <= l) ? sc[sb][r] * __expf(fminf(al - as[r], 0.f)) * ds[r] : 0.f;
                v2u pw; pw.x = pk2(o[0], o[1]); pw.y = pk2(o[2], o[3]); *(LAS v2u*)(lds + MX_RC + l * MX_PITCHB + s0 * 2) = pw; } }
        WG_BAR();
        __builtin_amdgcn_sched_barrier(0);
        { f32x4 ya[4];
#pragma unroll
            for (int pb = 0; pb < 4; ++pb) ya[pb] = (f32x4){0.f, 0.f, 0.f, 0.f};
#pragma unroll
            for (int ks = 0; ks < 4; ++ks) if (32 * ks <= 16 * w + 15) { const bf16x8 wf = *(const LAS bf16x8*)(lds + MX_RC + (16 * w + fr) * MX_PITCHB + (32 * ks + 8 * fq) * 2);
#pragma unroll
                for (int pb = 0; pb < 4; ++pb) { const bf16x8 xf = *(const LAS bf16x8*)(lds + xb + (16 * pb + fr) * MX_PITCHB + (32 * ks + 8 * fq) * 2); ya[pb] = MFMA16(xf, wf, ya[pb]); }
                __builtin_amdgcn_sched_barrier(0); }
            const float dsk = INP(I_DSKIP)[h]; const int l = 16 * w + fr;
#pragma unroll
            for (int pb = 0; pb < 4; ++pb) { f32x4 o;
#pragma unroll
                for (int r = 0; r < 4; ++r) { const int p = 16 * pb + 4 * fq + r; o[r] = ya[pb][r] + dsk * bf2f(*(const LAS unsigned short*)(lds + xb + p * MX_PITCHB + l * 2)); }
                *(f32x4*)(YD + (row0 + l) * D_SSM + h * 64 + 16 * pb + 4 * fq) = o; } }
        __builtin_amdgcn_sched_barrier(0);
        { f32x4 sa[4];
#pragma unroll
            for (int pb = 0; pb < 4; ++pb) sa[pb] = (f32x4){0.f, 0.f, 0.f, 0.f};
#pragma unroll
            for (int ks = 0; ks < 4; ++ks) { const bf16x8 bf_ = *(const LAS bf16x8*)(lds + MX_RBT + (16 * w + fr) * MX_PITCHB + (32 * ks + 8 * fq) * 2);
#pragma unroll
                for (int pb = 0; pb < 4; ++pb) { const bf16x8 xf = *(const LAS bf16x8*)(lds + xb + (64 + 16 * pb + fr) * MX_PITCHB + (32 * ks + 8 * fq) * 2); sa[pb] = MFMA16(bf_, xf, sa[pb]); }
                __builtin_amdgcn_sched_barrier(0); }
#pragma unroll
            for (int pb = 0; pb < 4; ++pb) *(f32x4*)(ST + ((((size_t)b * NCH + c) * NH + h) * HD + 16 * pb + fr) * NST + 16 * w + 4 * fq) = sa[pb]; }
 }
    { const int cc = tid & 127, lq = tid >> 7, ucol = g * 128 + cc; const int grp = __builtin_amdgcn_readfirstlane(ucol >> 6);
        float* outp = F.out + OUT_POOLP;
        if (grp == 0) pool_prompt_chunk<2>(PROJ, A2, outp, b, t0, 32 * lq, ucol, lastc);
        else if (grp == 1) pool_prompt_chunk<4>(PROJ, A2, outp, b, t0, 32 * lq, ucol, lastc);
        else if (grp == 2) pool_prompt_chunk<8>(PROJ, A2, outp, b, t0, 32 * lq, ucol, lastc);
        else pool_prompt_chunk<16>(PROJ, A2, outp, b, t0, 32 * lq, ucol, lastc); }
    WG_BAR();
}

constexpr int SM_XS = 0, SM_BM = 6144, SM_CM = 8192, SM_G = 10240, SM_DT = 16384, SM_ACS = SM_DT + 96, SM_DE = SM_ACS + 96, SM_EA = SM_DE + 96, SM_CD = SM_EA + 96, SM_SC = SM_CD + 32, SM_SSQ = SM_SC + 64;
constexpr int XSG = D_SSM / 2;
template <int W> __device__ __forceinline__ void pool_sample4(const float* sp, const bf16* PROJ, float* outp, int b, size_t r0, int c, float (&p)[4]) {
    float v[19];
#pragma unroll
    for (int i = 0; i < 15; ++i) v[i] = sp[((size_t)b * 15 + i) * D_POOL + c];
#pragma unroll
    for (int t = 0; t < 4; ++t) v[15 + t] = bf2f(PROJ[(r0 + t) * NIN + c]);
#pragma unroll
    for (int t = 0; t < 4; ++t) { float s = 0.f;
#pragma unroll
        for (int j = 0; j < W; ++j) s += v[15 + t - (W - 1) + j];
        p[t] = s * (1.0f / W) - v[15 + t]; }
#pragma unroll
    for (int i = 0; i < 15; ++i) outp[((size_t)b * 15 + i) * D_POOL + c] = v[4 + i];
}
__device__ __forceinline__ void mix_sample_item(Frame& F, int b, int g) {
    const int tid = F.tid, lane = F.lane, w = F.wave, fr = lane & 15, fq = lane >> 4; const size_t r0 = (size_t)MP + 4 * b;
    const bf16* PROJ = WSP(const bf16, WS_PROJ); const float* DTR = WSP(const float, WS_DTR);
    bf16* A2 = WSP(bf16, WS_A2); float* SSQY = WSP(float, WS_SSQY);
    LAS unsigned char* lds = F.lds;
    LAS float* xsL = (LAS float*)(lds + SM_XS); LAS float* BmL = (LAS float*)(lds + SM_BM); LAS float* CmL = (LAS float*)(lds + SM_CM); LAS float* gL = (LAS float*)(lds + SM_G);
    LAS float* dtS = (LAS float*)(lds + SM_DT); LAS float* acsS = (LAS float*)(lds + SM_ACS); LAS float* deS = (LAS float*)(lds + SM_DE); LAS float* eaS = (LAS float*)(lds + SM_EA);
    LAS float* cdS = (LAS float*)(lds + SM_CD); LAS float* scS = (LAS float*)(lds + SM_SC); LAS float* ssqS = (LAS float*)(lds + SM_SSQ);
    { const float* scv = INP(I_SCONV); const float* cw = INP(I_CONVW); const float* cbias = INP(I_CONVB);
        for (int j = tid; j < XSG + 256; j += NTHREADS) { const int cx = j < XSG ? g * XSG + j : (j < XSG + 128 ? D_SSM + g * 128 + (j - XSG) : D_SSM + 256 + g * 128 + (j - XSG - 128)); float e[7];
#pragma unroll
            for (int i = 0; i < 3; ++i) e[i] = scv[((size_t)b * 3 + i) * CONV_DIM + cx];
#pragma unroll
            for (int t = 0; t < 4; ++t) e[3 + t] = bf2f(PROJ[(r0 + t) * NIN + XBC0 + cx]);
            const float w0 = cw[cx], w1 = cw[CONV_DIM + cx], w2 = cw[2 * CONV_DIM + cx], w3 = cw[3 * CONV_DIM + cx], bb = cbias[cx];
#pragma unroll
            for (int t = 0; t < 4; ++t) { const float o = siluf(e[t] * w0 + e[t + 1] * w1 + e[t + 2] * w2 + e[t + 3] * w3 + bb);
                if (j < XSG) xsL[t * XSG + j] = o; else if (j < XSG + 128) BmL[t * 128 + j - XSG] = o; else CmL[t * 128 + j - XSG - 128] = o; }
#pragma unroll
            for (int jj = 0; jj < 3; ++jj) F.out[OUT_CONVS + ((size_t)b * 3 + jj) * CONV_DIM + cx] = e[4 + jj]; } }
    float pp[4] = {0.f, 0.f, 0.f, 0.f};
    if (tid < 128) { const int ucol = g * 128 + tid; const int grp = __builtin_amdgcn_readfirstlane(ucol >> 6); const float* sp = INP(I_SPOOL); float* outp = F.out + OUT_POOLS;
        if (grp == 0) pool_sample4<2>(sp, PROJ, outp, b, r0, ucol, pp); else if (grp == 1) pool_sample4<4>(sp, PROJ, outp, b, r0, ucol, pp);
        else if (grp == 2) pool_sample4<8>(sp, PROJ, outp, b, r0, ucol, pp); else pool_sample4<16>(sp, PROJ, outp, b, r0, ucol, pp); }
    else if (tid >= 256 && tid < 280) { const int i = tid - 256, t = i / 6, hl = i - 6 * t; dtS[t * 6 + hl] = softplusf(DTR[(r0 + t) * NH + 6 * g + hl] + INP(I_DTB)[6 * g + hl]); }
    WG_BAR();
    if (tid < 6) { const int h = 6 * g + tid; const float a = -__expf(INP(I_ALOG)[h]); float acc = 0.f, ac[4];
#pragma unroll
        for (int t = 0; t < 4; ++t) { acc += dtS[t * 6 + tid] * a; ac[t] = acc; acsS[t * 6 + tid] = acc; }
#pragma unroll
        for (int t = 0; t < 4; ++t) { deS[t * 6 + tid] = __expf(acc - ac[t]) * dtS[t * 6 + tid]; eaS[t * 6 + tid] = __expf(ac[t]); }
        cdS[tid] = __expf(acc); }
#pragma unroll
    for (int k = 0; k < 2; ++k) { const int idx = 2 * w + k, l = idx >> 2, s = idx & 3;
        float v = CmL[l * 128 + lane] * BmL[s * 128 + lane] + CmL[l * 128 + 64 + lane] * BmL[s * 128 + 64 + lane];
        v = wave_sum(v); if (lane == 0) scS[idx] = v; }
    WG_BAR();
    { const float* h0 = INP(I_SSSM); float* hout = F.out + OUT_SSMS;
        bf16x8 cf[4];
#pragma unroll
        for (int ks = 0; ks < 4; ++ks) { v4u q = (v4u){0u, 0u, 0u, 0u};
            if (fr < 4) { const LAS float* cp = CmL + fr * 128 + 32 * ks + 8 * fq; q.x = pk2(cp[0], cp[1]); q.y = pk2(cp[2], cp[3]); q.z = pk2(cp[4], cp[5]); q.w = pk2(cp[6], cp[7]); }
            cf[ks] = __builtin_bit_cast(bf16x8, q); }
#pragma unroll
        for (int i = 0; i < 3; ++i) { const int blk = 3 * w + i, hl = blk >> 2, pb = blk & 3, h = 6 * g + hl, p = 16 * pb + fr;
            const float cdh = cdS[hl]; float cx[4];
#pragma unroll
            for (int l = 0; l < 4; ++l) cx[l] = deS[l * 6 + hl] * xsL[l * XSG + hl * 64 + p];
            f32x4 acc = (f32x4){0.f, 0.f, 0.f, 0.f};
#pragma unroll
            for (int ks = 0; ks < 4; ++ks) { const int n0 = 32 * ks + 8 * fq; const size_t off = (((size_t)b * NH + h) * HD + p) * NST + n0;
                const f32x4 a0 = *(const f32x4*)(h0 + off), a1 = *(const f32x4*)(h0 + off + 4);
                v4u q; q.x = pk2(a0.x, a0.y); q.y = pk2(a0.z, a0.w); q.z = pk2(a1.x, a1.y); q.w = pk2(a1.z, a1.w);
                acc = MFMA16(__builtin_bit_cast(bf16x8, q), cf[ks], acc);
                f32x4 o0 = a0 * cdh, o1 = a1 * cdh;
#pragma unroll
                for (int l = 0; l < 4; ++l) { const f32x4 b0 = *(const LAS f32x4*)(BmL + l * 128 + n0), b1 = *(const LAS f32x4*)(BmL + l * 128 + n0 + 4); o0 += b0 * cx[l]; o1 += b1 * cx[l]; }
                *(f32x4*)(hout + off) = o0; *(f32x4*)(hout + off + 4) = o1; }
            if (fr < 4) { const int l = fr; const float eal = eaS[l * 6 + hl], dsk = INP(I_DSKIP)[h], al = acsS[l * 6 + hl];
#pragma unroll
                for (int r = 0; r < 4; ++r) { const int pc = hl * 64 + 16 * pb + 4 * fq + r; float y = eal * acc[r] + dsk * xsL[l * XSG + pc];
#pragma unroll
                    for (int s = 0; s < 4; ++s) if (s <= l) y += scS[l * 4 + s] * __expf(al - acsS[s * 6 + hl]) * dtS[s * 6 + hl] * xsL[s * XSG + pc];
                    const float z = bf2f(PROJ[(r0 + l) * NIN + D_POOL + g * XSG + pc]); gL[l * XSG + pc] = y * siluf(z); } } } }
    WG_BAR();
    if (w < 4) { float s = 0.f;
#pragma unroll
        for (int j = 0; j < 6; ++j) { const float v = gL[w * XSG + lane + 64 * j]; s += v * v; }
        s = wave_sum(s); if (lane == 0) ssqS[w] = s; }
    WG_BAR();
#pragma unroll
    for (int t = 0; t < 4; ++t) {
        if (tid < XSG) A2[(r0 + t) * D + D_POOL + g * XSG + tid] = (bf16)f2bf(gL[t * XSG + tid]);
        if (tid < 128) A2[(r0 + t) * D + g * 128 + tid] = (bf16)f2bf(pp[t]);
        if (g == 0) { if (tid < 16 && tid != 1) SSQY[(r0 + t) * 16 + tid] = tid == 0 ? ssqS[t] * (1024.0f / D_SSM) : 0.f; }
        else if (tid == 1) SSQY[(r0 + t) * 16 + 1] = ssqS[t] * (1024.0f / D_SSM); }
    WG_BAR();
}

__device__ __forceinline__ void scan_phase(Frame& F) {
    const float* ST = WSP(const float, WS_ST); const float* CDp = WSP(const float, WS_CD); bf16* HP = WSP(bf16, WS_HP); float* outp = F.out + OUT_SSMP;
    constexpr size_t CS = (size_t)NH * HD * NST;
    for (int idx = F.bid * NTHREADS + F.tid; idx < BATCH * NH * HD * (NST / 4); idx += F.G * NTHREADS) { const int n4 = idx & 31, p = (idx >> 5) & 63, bh = idx >> 11, h = bh % NH, b = bh / NH;
        const size_t base = ((((size_t)b * NCH) * NH + h) * HD + p) * NST + 4 * n4;
        f32x4 st[NCH];
#pragma unroll
        for (int c = 0; c < NCH; ++c) st[c] = *(const f32x4*)(ST + base + c * CS);
        f32x4 run = (f32x4){0.f, 0.f, 0.f, 0.f};
#pragma unroll
        for (int c = 0; c < NCH; ++c) { v2u q; q.x = pk2(run.x, run.y); q.y = pk2(run.z, run.w); *(v2u*)(HP + base + c * CS) = q; run = run * CDp[((size_t)b * NCH + c) * NH + h] + st[c]; }
        *(f32x4*)(outp + (((size_t)b * NH + h) * HD + p) * NST + 4 * n4) = run; }
}

__device__ __forceinline__ void mixc_item(Frame& F, int b, int c, int hf) {
    const int tid = F.tid, lane = F.lane, w = F.wave, fr = lane & 15, fq = lane >> 4, lb = w & 3, grp = w >> 2;
    const bf16* PROJ = WSP(const bf16, WS_PROJ); const float* EXPA = WSP(const float, WS_EXPA); const bf16* CB = WSP(const bf16, WS_CB); const float* YD = WSP(const float, WS_YD); const bf16* HP = WSP(const bf16, WS_HP);
    bf16* A2 = WSP(bf16, WS_A2); float* SSQY = WSP(float, WS_SSQY);
    LAS float* ssqL = (LAS float*)(F.lds);
    const size_t rowb = (size_t)b * SEQ + c * CHUNK + 64 * hf; const size_t row = rowb + 16 * lb + fr;
    bf16x8 cf[4];
#pragma unroll
    for (int ks = 0; ks < 4; ++ks) cf[ks] = *(const bf16x8*)(CB + row * 256 + grp * 128 + 32 * ks + 8 * fq);
    float ssq = 0.f;
    for (int hl = 0; hl < 6; ++hl) { const int h = 6 * grp + hl; const float ea = EXPA[row * NH + h]; const bf16* hp = HP + ((((size_t)b * NCH + c) * NH + h) * HD) * NST;
#pragma unroll
        for (int pb = 0; pb < 4; ++pb) { f32x4 acc = (f32x4){0.f, 0.f, 0.f, 0.f};
#pragma unroll
            for (int ks = 0; ks < 4; ++ks) { const bf16x8 af = *(const bf16x8*)(hp + (size_t)(16 * pb + fr) * NST + 32 * ks + 8 * fq); acc = MFMA16(af, cf[ks], acc); }
            const int p0 = h * 64 + 16 * pb + 4 * fq; const f32x4 yd = *(const f32x4*)(YD + row * D_SSM + p0); const v2u zz = *(const v2u*)(PROJ + row * NIN + D_POOL + p0);
            const float g0 = (yd[0] + ea * acc[0]) * siluf(bflo(zz.x)), g1 = (yd[1] + ea * acc[1]) * siluf(bfhi(zz.x)), g2 = (yd[2] + ea * acc[2]) * siluf(bflo(zz.y)), g3 = (yd[3] + ea * acc[3]) * siluf(bfhi(zz.y));
            ssq += (g0 * g0 + g1 * g1) + (g2 * g2 + g3 * g3);
            v2u q; q.x = pk2(g0, g1); q.y = pk2(g2, g3); *(v2u*)(A2 + row * D + D_POOL + p0) = q; } }
    ssq += __shfl_xor(ssq, 16); ssq += __shfl_xor(ssq, 32);
    if (fq == 0) ssqL[grp * 64 + 16 * lb + fr] = ssq;
    WG_BAR();
    { const int rl = tid >> 3, seg = tid & 7; const float tot = ssqL[rl] + ssqL[64 + rl]; const float rsinv = sqrtf(tot * (1.0f / D_SSM) + EPS); const size_t r = rowb + rl;
#pragma unroll
        for (int i = 0; i < 4; ++i) { v4u q = *(const v4u*)(A2 + r * D + seg * 32 + 8 * i);
            q.x = pk2(bflo(q.x) * rsinv, bfhi(q.x) * rsinv); q.y = pk2(bflo(q.y) * rsinv, bfhi(q.y) * rsinv); q.z = pk2(bflo(q.z) * rsinv, bfhi(q.z) * rsinv); q.w = pk2(bflo(q.w) * rsinv, bfhi(q.w) * rsinv);
            *(v4u*)(A2 + r * D + seg * 32 + 8 * i) = q; }
        if (seg < 4) *(f32x4*)(SSQY + r * 16 + 4 * seg) = (f32x4){seg == 0 ? tot * (1024.0f / D_SSM) : 0.f, 0.f, 0.f, 0.f}; }
    WG_BAR();
}

__device__ __forceinline__ void sample_pool_rescale(Frame& F, int it) {
    const int rl = F.tid >> 3, seg = F.tid & 7; const size_t r = (size_t)MP + 64 * it + rl; bf16* A2 = WSP(bf16, WS_A2); const float* SSQY = WSP(const float, WS_SSQY);
    const float tot = (SSQY[r * 16] + SSQY[r * 16 + 1]) * (D_SSM / 1024.0f); const float rsinv = sqrtf(tot * (1.0f / D_SSM) + EPS);
#pragma unroll
    for (int i = 0; i < 4; ++i) { v4u q = *(const v4u*)(A2 + r * D + seg * 32 + 8 * i);
        q.x = pk2(bflo(q.x) * rsinv, bfhi(q.x) * rsinv); q.y = pk2(bflo(q.y) * rsinv, bfhi(q.y) * rsinv); q.z = pk2(bflo(q.z) * rsinv, bfhi(q.z) * rsinv); q.w = pk2(bflo(q.w) * rsinv, bfhi(q.w) * rsinv);
        *(v4u*)(A2 + r * D + seg * 32 + 8 * i) = q; }
}

constexpr int SA_REDM = 0, SA_REDS = 512, SA_P = 1024, SA_O = 1024 + 8192;
__device__ __forceinline__ void attn_sample_item(Frame& F, int b, int hp) {
    const int tid = F.tid, lane = F.lane, w = F.wave, fr = lane & 15, fq = lane >> 4, hl = w >> 2, kq = w & 3, h = 2 * hp + hl; const size_t r0 = (size_t)MP + 4 * b;
    const bf16* Q = WSP(const bf16, WS_Q); bf16* O = WSP(bf16, WS_O); const float* ck = INP(I_CK); const float* cv = INP(I_CV);
    LAS float* redM = (LAS float*)(F.lds + SA_REDM); LAS float* redS = (LAS float*)(F.lds + SA_REDS); LAS float* pL = (LAS float*)(F.lds + SA_P); LAS float* oL = (LAS float*)(F.lds + SA_O);
    bf16x8 qf[8];
#pragma unroll
    for (int ks = 0; ks < 8; ++ks) { v4u q = (v4u){0u, 0u, 0u, 0u}; if (fr < 4) q = *(const v4u*)(Q + (r0 + fr) * D + h * 256 + 32 * ks + 8 * fq); qf[ks] = __builtin_bit_cast(bf16x8, q); }
    f32x4 s[4];
#pragma unroll
    for (int mb = 0; mb < 4; ++mb) { const int m = 64 * kq + 16 * mb + fr; const float* kp = ck + (((size_t)b * NMEM + m) * 4 + h) * 256 + 8 * fq; f32x4 acc = (f32x4){0.f, 0.f, 0.f, 0.f};
#pragma unroll
        for (int ks = 0; ks < 8; ++ks) { const f32x4 a0 = *(const f32x4*)(kp + 32 * ks), a1 = *(const f32x4*)(kp + 32 * ks + 4);
            v4u q; q.x = pk2(a0.x, a0.y); q.y = pk2(a0.z, a0.w); q.z = pk2(a1.x, a1.y); q.w = pk2(a1.z, a1.w); acc = MFMA16(__builtin_bit_cast(bf16x8, q), qf[ks], acc); }
        s[mb] = acc; }
    float mx = -3.0e38f;
#pragma unroll
    for (int mb = 0; mb < 4; ++mb) mx = fmaxf(mx, fmaxf(fmaxf(s[mb][0], s[mb][1]), fmaxf(s[mb][2], s[mb][3])));
    mx = fmaxf(mx, __shfl_xor(mx, 16)); mx = fmaxf(mx, __shfl_xor(mx, 32));
    if (fq == 0) redM[w * 16 + fr] = mx;
    WG_BAR();
    mx = fmaxf(fmaxf(redM[(4 * hl) * 16 + fr], redM[(4 * hl + 1) * 16 + fr]), fmaxf(redM[(4 * hl + 2) * 16 + fr], redM[(4 * hl + 3) * 16 + fr]));
    float sm = 0.f;
#pragma unroll
    for (int mb = 0; mb < 4; ++mb)
#pragma unroll
        for (int r = 0; r < 4; ++r) { const float p = __expf(s[mb][r] - mx); sm += p; if (fr < 4) pL[(hl * 256 + 64 * kq + 16 * mb + 4 * fq + r) * 4 + fr] = p; }
    sm += __shfl_xor(sm, 16); sm += __shfl_xor(sm, 32);
    if (fq == 0) redS[w * 16 + fr] = sm;
    WG_BAR();
    f32x4 o[4];
#pragma unroll
    for (int t = 0; t < 4; ++t) o[t] = (f32x4){0.f, 0.f, 0.f, 0.f};
    { const float* vp = cv + (((size_t)b * NMEM + 64 * kq) * 4 + h) * 256 + 4 * lane;
#pragma unroll 8
        for (int mi = 0; mi < 64; ++mi) { const f32x4 v = *(const f32x4*)(vp + (size_t)mi * 1024); const f32x4 pv = *(const LAS f32x4*)(pL + (hl * 256 + 64 * kq + mi) * 4);
#pragma unroll
            for (int t = 0; t < 4; ++t) o[t] += v * pv[t]; } }
#pragma unroll
    for (int t = 0; t < 4; ++t) *(LAS f32x4*)(oL + (w * 4 + t) * 256 + 4 * lane) = o[t];
    WG_BAR();
    { const int h2 = tid >> 8, t = (tid >> 6) & 3, d4 = (tid & 63) * 4; f32x4 a = (f32x4){0.f, 0.f, 0.f, 0.f}; float l = 0.f;
#pragma unroll
        for (int k = 0; k < 4; ++k) { a += *(const LAS f32x4*)(oL + ((4 * h2 + k) * 4 + t) * 256 + d4); l += redS[(4 * h2 + k) * 16 + t]; }
        const float inv = 1.0f / l; v2u q; q.x = pk2(a.x * inv, a.y * inv); q.y = pk2(a.z * inv, a.w * inv);
        *(v2u*)(O + (r0 + t) * D + (2 * hp + h2) * 256 + d4) = q; }
    WG_BAR();
}


__device__ __forceinline__ f32x4 skinny_acc(const bf16* A, int lda, const bf16* Bt, int ldb, int K, int rowA, int colB, int fq) {
    const bf16* ap = A + (size_t)rowA * lda + 8 * fq; const bf16* bp = Bt + (size_t)colB * ldb + 8 * fq;
    f32x4 acc = (f32x4){0.f, 0.f, 0.f, 0.f};
    for (int k0 = 0; k0 < K; k0 += 256) { bf16x8 a[8], b[8];
#pragma unroll
        for (int j = 0; j < 8; ++j) { a[j] = *(const bf16x8*)(ap + k0 + 32 * j); b[j] = *(const bf16x8*)(bp + k0 + 32 * j); }
#pragma unroll
        for (int j = 0; j < 8; ++j) acc = MFMA16(b[j], a[j], acc); }
    return acc;
}
__device__ __forceinline__ void skinny_resid(Frame& F, int unit, const bf16* A, int lda, const bf16* Bt, int K, const float* res, float* out, bf16* outb, float alpha, const float* ssq_in, float* ssq_out) {
    const int w = F.wave, lane = F.lane, fr = lane & 15, fq = lane >> 4, rb = w >> 2, cb = w & 3, mi = unit >> 4, ni = unit & 15;
    const int row = 32 * mi + 16 * rb + fr, col0 = 64 * ni + 16 * cb + 4 * fq;
    const f32x4 acc = skinny_acc(A, lda, Bt, K, K, row, 64 * ni + 16 * cb + fr, fq);
    const float sc = alpha * (ssq_in ? pg8::rstd16(ssq_in, row) : 1.0f);
    const f32x4 o = *(const f32x4*)(res + (size_t)row * D + col0) + acc * sc;
    *(f32x4*)(out + (size_t)row * D + col0) = o;
    if (outb) { v2u q; q.x = pk2(o[0], o[1]); q.y = pk2(o[2], o[3]); *(v2u*)(outb + (size_t)row * D + col0) = q; }
    float q = (o[0] * o[0] + o[1] * o[1]) + (o[2] * o[2] + o[3] * o[3]); q += __shfl_xor(q, 16); q += __shfl_xor(q, 32);
    LAS float* red = (LAS float*)F.lds;
    if (fq == 0) red[(16 * rb + fr) * 4 + cb] = q;
    WG_BAR();
    if (F.tid < 32) { const f32x4 r4 = *(const LAS f32x4*)(red + F.tid * 4); ssq_out[(size_t)(32 * mi + F.tid) * 16 + ni] = (r4[0] + r4[1]) + (r4[2] + r4[3]); }
    WG_BAR();
}
__device__ __forceinline__ void skinny_rowbf16(Frame& F, int unit, const bf16* A, int lda, const bf16* Bt, int K, bf16* O, const float* ssq_in) {
    const int w = F.wave, lane = F.lane, fr = lane & 15, fq = lane >> 4, rb = w >> 2, cb = w & 3, mi = unit >> 4, ni = unit & 15;
    const int row = 32 * mi + 16 * rb + fr, col0 = 64 * ni + 16 * cb + 4 * fq;
    const f32x4 acc = skinny_acc(A, lda, Bt, K, K, row, 64 * ni + 16 * cb + fr, fq);
    const float sc = ssq_in ? pg8::rstd16(ssq_in, row) : 1.0f;
    v2u q; q.x = pk2(acc[0] * sc, acc[1] * sc); q.y = pk2(acc[2] * sc, acc[3] * sc); *(v2u*)(O + (size_t)row * D + col0) = q;
}

__device__ __forceinline__ void final_norm_phase(Frame& F) {
    const float* SSQ4 = WSP(const float, WS_SSQ4); const float* gf = INP(I_GFIN); const int gw = F.bid * NWAVES + F.wave, NGW = F.G * NWAVES, lane = F.lane;
    f32x4 gv[4];
#pragma unroll
    for (int j = 0; j < 4; ++j) gv[j] = *(const f32x4*)(gf + 4 * lane + 256 * j);
    for (int m = gw; m < M; m += NGW) { const float rs = pg8::rstd16(SSQ4, m); float* yr = F.out + OUT_Y + (size_t)m * D;
#pragma unroll
        for (int j = 0; j < 4; ++j) { f32x4 v = *(const f32x4*)(yr + 4 * lane + 256 * j); v = v * rs * gv[j]; *(f32x4*)(yr + 4 * lane + 256 * j) = v; } }
}

struct Args { const float* in[34]; float* out; unsigned char* ws; int ph_lo, ph_hi, li, pad; };
__global__ void __launch_bounds__(NTHREADS, 2) mega_fwd(Args args) {
    extern __shared__ __attribute__((aligned(16))) unsigned char lds[];
    Frame F;
    F.lds = (LAS unsigned char*)lds;
    F.MISC = (volatile LAS unsigned*)(F.lds + MISC_OFF);
    F.tid = threadIdx.x; F.lane = F.tid & 63; F.wave = __builtin_amdgcn_readfirstlane(F.tid >> 6);
    F.G = gridDim.x; F.bid = blockIdx.x;
    F.out = args.out; F.ws = args.ws; F.ptab = (LAS unsigned*)(F.lds + LDSCTL_OFF);
    F.ctl = (gu32*)(F.ws + WS_CTL);
    for (int u = F.tid; u < (LDS_BYTES - LDSCTL_OFF) / 4; u += NTHREADS) ((LAS unsigned*)(F.lds + LDSCTL_OFF))[u] = 0u;
    __syncthreads();
    if (F.tid == 0) {
#pragma unroll
        for (int i = 0; i < 34; ++i) { const unsigned long long p = (unsigned long long)args.in[i]; F.ptab[2 * i] = (unsigned)p; F.ptab[2 * i + 1] = (unsigned)(p >> 32); } }
    __syncthreads();
    XcdBarrier bar; bar.bar = (unsigned*)(F.ctl + CW_BAR) + args.li * XCD_BAR_WORDS; bar.x = 0; bar.st = nullptr;
    if (N_LAUNCHES == 1) bar = xcd_barrier_post((unsigned*)(F.ctl + CW_BAR), F.MISC + 8);
    const int lo = args.ph_lo, hi = args.ph_hi;
#ifndef PHMASK
#define PHMASK 0x7fff
#endif
#define IN(k) ((((PHMASK) >> (k)) & 1) && lo <= (k) && (k) < hi)
#define SEAM(k) do { if (IN(k) && IN((k) + 1)) xcd_barrier(bar); } while (0)
    PG8_LAS unsigned char* ring = (PG8_LAS unsigned char*)(F.lds + RING_OFF);
    int K256 = 256; asm volatile("" : "+s"(K256));
    const pg8::bf16_t* XB = WSP(const pg8::bf16_t, WS_XB);
    float* X = WSP(float, WS_X);

    if (IN(0)) { p0_prologue(F); } SEAM(0);
    if (IN(1)) {
        { pg8::Gemm g{XB, WSP(const pg8::bf16_t, WS_W1GU), M, NGU, D, D, D}; pg8::StaticOrder S; S.init(M, NGU, F.G, F.bid);
          pg8::EpiGateUp E{WSP(pg8::bf16_t, WS_ACT), FF, WSP(const float, WS_SSQ0)};
          pg8::gemm_phase<pg8::EpiGateUp, pg8::StaticOrder, true, true>(ring, g, S, E); }
        { pg8::Gemm g{WSP(const pg8::bf16_t, WS_MBF), WSP(const pg8::bf16_t, WS_WMKV), MEMROWS, 2 * D, D, D, D}; pg8::OffsetOrder S; S.init(MEMROWS, 2 * D, F.G, F.bid, ((M / 256) * (NGU / 256)) % F.G);
          pg8::EpiMem E{F.out + OUT_MK, F.out + OUT_MV, WSP(pg8::bf16_t, WS_KM), WSP(pg8::bf16_t, WS_VT), WSP(const float, WS_SSQM)};
          pg8::gemm_phase<pg8::EpiMem, pg8::OffsetOrder, true, true>(ring, g, S, E); }
    } SEAM(1);
    if (IN(2)) {
        pg8::Gemm g{WSP(const pg8::bf16_t, WS_ACT), WSP(const pg8::bf16_t, WS_W1D), MP, D, FF, FF, FF}; pg8::StaticOrder S; S.init(MP, D, F.G, F.bid);
        pg8::EpiResid E{INP(I_XP), INP(I_XS), MP, X, WSP(pg8::bf16_t, WS_XB), 0.5f, nullptr, WSP(float, WS_SSQ1)};
        pg8::gemm_phase<pg8::EpiResid, pg8::StaticOrder, true, true>(ring, g, S, E);
        for (int u = F.bid; u < 256; u += F.G) skinny_resid(F, u, WSP(const bf16, WS_ACT) + (size_t)MP * FF, FF, WSP(const bf16, WS_W1D), FF, INP(I_XS), X + (size_t)MP * D, WSP(bf16, WS_XB) + (size_t)MP * D, 0.5f, nullptr, WSP(float, WS_SSQ1) + (size_t)MP * 16);
    } SEAM(2);
    if (IN(3)) {
        pg8::Gemm g{XB, WSP(const pg8::bf16_t, WS_WIN), M, NIN + 256, D, D, D}; pg8::StaticOrder S; S.init(M, NIN + 256, F.G, F.bid);
        pg8::EpiProj E{WSP(pg8::bf16_t, WS_PROJ), NIN, WSP(const float, WS_SSQ1), WSP(float, WS_DTR)};
        pg8::gemm_phase<pg8::EpiProj, pg8::StaticOrder, true, true>(ring, g, S, E);
    } SEAM(3);
    if (IN(4)) {
        for (int it = F.bid; it < BATCH * NCH * 2; it += F.G) mix_prompt_item(F, it >> 5, (it >> 1) & 15, it & 1);
        for (int it = F.bid; it < DEC_B * 2; it += F.G) mix_sample_item(F, it >> 1, it & 1);
    } SEAM(4);
    if (IN(5)) { scan_phase(F); } SEAM(5);
    if (IN(6)) { for (int it = F.bid; it < BATCH * NCH * 2; it += F.G) mixc_item(F, it >> 5, (it >> 1) & 15, it & 1);
                 for (int it = F.bid; it < MS / 64; it += F.G) sample_pool_rescale(F, it); } SEAM(6);
    if (IN(7)) {
        pg8::Gemm g{WSP(const pg8::bf16_t, WS_A2), WSP(const pg8::bf16_t, WS_WOUT), MP, D, D, D, D}; pg8::StaticOrder S; S.init(MP, D, F.G, F.bid);
        pg8::EpiResid E{X, X, M, X, WSP(pg8::bf16_t, WS_XB), 1.0f, WSP(const float, WS_SSQY), WSP(float, WS_SSQ2)};
        pg8::gemm_phase<pg8::EpiResid, pg8::StaticOrder, true, true>(ring, g, S, E);
        for (int u = F.bid; u < 256; u += F.G) skinny_resid(F, u, WSP(const bf16, WS_A2) + (size_t)MP * D, D, WSP(const bf16, WS_WOUT), D, X + (size_t)MP * D, X + (size_t)MP * D, WSP(bf16, WS_XB) + (size_t)MP * D, 1.0f, WSP(const float, WS_SSQY) + (size_t)MP * 16, WSP(float, WS_SSQ2) + (size_t)MP * 16);
    } SEAM(7);
    if (IN(8)) {
        pg8::Gemm g{XB, WSP(const pg8::bf16_t, WS_WQ), MP, D, D, D, D}; pg8::StaticOrder S; S.init(MP, D, F.G, F.bid);
        pg8::EpiRowBf16 E{WSP(pg8::bf16_t, WS_Q), D, WSP(const float, WS_SSQ2)};
        pg8::gemm_phase<pg8::EpiRowBf16, pg8::StaticOrder, true, true>(ring, g, S, E);
        for (int u = F.bid; u < 256; u += F.G) skinny_rowbf16(F, u, WSP(const bf16, WS_XB) + (size_t)MP * D, D, WSP(const bf16, WS_WQ), D, WSP(bf16, WS_Q) + (size_t)MP * D, WSP(const float, WS_SSQ2) + (size_t)MP * 16);
    } SEAM(8);
    if (IN(9)) {
        { pg8::Gemm g{WSP(const pg8::bf16_t, WS_Q), WSP(const pg8::bf16_t, WS_KM), MP, 256, K256, D, D}; pg8::AttnOrder<0> S; S.init(F.G, F.bid);
          pg8::EpiSoftmax E{WSP(pg8::bf16_t, WS_PB)};
          pg8::gemm_phase<pg8::EpiSoftmax, pg8::AttnOrder<0>, false, true>(ring, g, S, E); }
        for (int it = F.bid; it < DEC_B * 2; it += F.G) attn_sample_item(F, it >> 1, it & 1);
    } SEAM(9);
    if (IN(10)) {
        pg8::Gemm g{WSP(const pg8::bf16_t, WS_PB), WSP(const pg8::bf16_t, WS_VT), MP, 256, K256, D, 256}; pg8::AttnOrder<1> S; S.init(F.G, F.bid);
        pg8::EpiRowBf16 E{WSP(pg8::bf16_t, WS_O), D, nullptr};
        pg8::gemm_phase<pg8::EpiRowBf16, pg8::AttnOrder<1>, true, true>(ring, g, S, E);
    } SEAM(10);
    if (IN(11)) {
        pg8::Gemm g{WSP(const pg8::bf16_t, WS_O), WSP(const pg8::bf16_t, WS_WO), MP, D, D, D, D}; pg8::StaticOrder S; S.init(MP, D, F.G, F.bid);
        pg8::EpiResid E{X, X, M, X, WSP(pg8::bf16_t, WS_XB), 1.0f, nullptr, WSP(float, WS_SSQ3)};
        pg8::gemm_phase<pg8::EpiResid, pg8::StaticOrder, true, true>(ring, g, S, E);
        for (int u = F.bid; u < 256; u += F.G) skinny_resid(F, u, WSP(const bf16, WS_O) + (size_t)MP * D, D, WSP(const bf16, WS_WO), D, X + (size_t)MP * D, X + (size_t)MP * D, WSP(bf16, WS_XB) + (size_t)MP * D, 1.0f, nullptr, WSP(float, WS_SSQ3) + (size_t)MP * 16);
    } SEAM(11);
    if (IN(12)) {
        pg8::Gemm g{XB, WSP(const pg8::bf16_t, WS_W2GU), M, NGU, D, D, D}; pg8::StaticOrder S; S.init(M, NGU, F.G, F.bid);
        pg8::EpiGateUp E{WSP(pg8::bf16_t, WS_ACT), FF, WSP(const float, WS_SSQ3)};
        pg8::gemm_phase<pg8::EpiGateUp, pg8::StaticOrder, true, true>(ring, g, S, E);
    } SEAM(12);
    if (IN(13)) {
        pg8::Gemm g{WSP(const pg8::bf16_t, WS_ACT), WSP(const pg8::bf16_t, WS_W2D), MP, D, FF, FF, FF}; pg8::StaticOrder S; S.init(MP, D, F.G, F.bid);
        pg8::EpiResid E{X, X, M, F.out + OUT_Y, nullptr, 0.5f, nullptr, WSP(float, WS_SSQ4)};
        pg8::gemm_phase<pg8::EpiResid, pg8::StaticOrder, true, true>(ring, g, S, E);
        for (int u = F.bid; u < 256; u += F.G) skinny_resid(F, u, WSP(const bf16, WS_ACT) + (size_t)MP * FF, FF, WSP(const bf16, WS_W2D), FF, X + (size_t)MP * D, F.out + OUT_Y + (size_t)MP * D, nullptr, 0.5f, nullptr, WSP(float, WS_SSQ4) + (size_t)MP * 16);
    } SEAM(13);
    if (IN(14)) { final_norm_phase(F); }
#undef IN
#undef SEAM
}

extern "C" void kernel_launch(void* const* d_in, const int* in_sizes, int n_in, void* d_out, int out_size, void* d_ws, size_t ws_size, hipStream_t stream) {
    static int grid = 0;
    if (grid == 0) {
        if (n_in != 34 || out_size != (int)OUT_TOTAL || ws_size < WS_END) { fprintf(stderr, "kernel_launch: expected 34 inputs, %zu outputs, >= %zu bytes of workspace; got n_in %d, out %d, ws %zu; nothing launched\n", (size_t)OUT_TOTAL, (size_t)WS_END, n_in, out_size, ws_size); grid = -1; return; }
        int dev = 0, cus = 0, per_cu = 0;
        if (hipGetDevice(&dev) != hipSuccess || hipDeviceGetAttribute(&cus, hipDeviceAttributeMultiprocessorCount, dev) != hipSuccess) { fprintf(stderr, "kernel_launch: device query failed\n"); grid = -1; return; }
        if (hipFuncSetAttribute((const void*)mega_fwd, hipFuncAttributeMaxDynamicSharedMemorySize, LDS_BYTES) != hipSuccess) { fprintf(stderr, "kernel_launch: hipFuncSetAttribute failed\n"); grid = -1; return; }
        if (hipOccupancyMaxActiveBlocksPerMultiprocessor(&per_cu, (const void*)mega_fwd, NTHREADS, LDS_BYTES) != hipSuccess || per_cu < 1) { fprintf(stderr, "kernel_launch: occupancy query reports %d blocks per CU; nothing launched\n", per_cu); (void)hipGetLastError(); grid = -1; return; }
        grid = cus;
        if (grid != 256) { fprintf(stderr, "kernel_launch: this kernel is built for a 256-CU device (found %d CUs); nothing launched\n", cus); grid = -1; return; }
    }
    if (grid < 0) return;
    if (hipMemsetAsync((char*)d_ws + WS_CTL, 0, CTL_ZERO_BYTES, stream) != hipSuccess) { fprintf(stderr, "kernel_launch: hipMemsetAsync failed\n"); return; }
    Args a{};
    for (int i = 0; i < 34; ++i) a.in[i] = (const float*)d_in[i];
    a.out = (float*)d_out; a.ws = (unsigned char*)d_ws;
    if (N_LAUNCHES == 1) { a.ph_lo = 0; a.ph_hi = N_PHASES; a.li = 0; hipLaunchKernelGGL(mega_fwd, dim3(grid), dim3(NTHREADS), LDS_BYTES, stream, a); }
#ifndef HOSTDUP
#define HOSTDUP 0
#endif
    else for (int li = 0; li < N_PHASES; ++li) { a.ph_lo = li; a.ph_hi = li + 1; a.li = 0;
        for (int rep = 0; rep < (((HOSTDUP >> li) & 1) ? 2 : 1); ++rep) hipLaunchKernelGGL(mega_fwd, dim3(grid), dim3(NTHREADS), LDS_BYTES, stream, a); }
    const hipError_t le = hipPeekAtLastError();
    if (le != hipSuccess) fprintf(stderr, "kernel_launch: launch failed: %s\n", hipGetErrorName(le));
}
```

```cpp
#include <hip/hip_runtime.h>
#include <cstdio>
#include <cstdint>
#include <cmath>

#ifndef MK_N_LAUNCHES
#define MK_N_LAUNCHES 1
#endif

namespace pg8 {
#define PG8_LAS __attribute__((address_space(3)))
typedef unsigned short bf16_t;
typedef short bf16x8 __attribute__((ext_vector_type(8)));
typedef float f32x4 __attribute__((ext_vector_type(4)));
typedef unsigned u32x4 __attribute__((ext_vector_type(4)));
typedef unsigned u32x2 __attribute__((ext_vector_type(2)));
constexpr int BM = 256, BK = 64, HALF = 128, HTB = HALF * BK * 2  , STAGE_BYTES = 8 * HTB, NXCD = 8, WGM = 8;

__host__ __device__ __forceinline__ int lds_byte(int r, int c) { const int st = (r >> 4) * 2 + (c >> 5), rr = r & 15, cc = c & 31, ob = rr * 64 + cc * 2; return st * 1024 + (ob ^ (((ob >> 9) & 1) << 5)); }
__host__ __device__ __forceinline__ void stage_rc(int b, int& R, int& C) { const int st = b / 1024, sb = b % 1024, swz = sb ^ (((sb >> 9) & 1) << 5); R = (st >> 1) * 16 + swz / 64; C = (st & 1) * 32 + (swz % 64) / 2; }
__host__ __device__ __forceinline__ int perm32(int rho) { const int n = rho >> 4, i = rho & 15; return 8 * (i >> 2) + 4 * n + (i & 3); }

struct Unit { int pm, pn; };
struct Gemm { const bf16_t* A; const bf16_t* Bt; int M, N, K, lda, ldb; };

struct StaticOrder {
    int nM, nN, nwg, G, c;
    __host__ __device__ void init(int M, int N, int G_, int c_) { nM = M / BM; nN = N / BM; nwg = nM * nN; G = G_; c = c_; }
    __host__ __device__ bool next(int i, Unit& u) const {
        const long L = (long)i * G + c; if (L >= nwg) return false;
        int wgid = (int)L; { const int q = nwg / NXCD, r = nwg % NXCD, xcd = wgid % NXCD, off = wgid / NXCD; wgid = (xcd < r ? xcd * (q + 1) : r * (q + 1) + (xcd - r) * q) + off; }
        const int nig = WGM * nN, gid = wgid / nig, fm = gid * WGM, gsz = (nM - fm) < WGM ? (nM - fm) : WGM;
        u.pm = fm + ((wgid % nig) % gsz); u.pn = (wgid % nig) / gsz; return true;
    }
    __device__ __forceinline__ const char* abase(const Gemm& g, const Unit& u) const { return (const char*)g.A + (size_t)u.pm * 256 * g.lda * 2; }
    __device__ __forceinline__ const char* bbase(const Gemm& g, const Unit& u) const { return (const char*)g.Bt + (size_t)u.pn * 256 * g.ldb * 2; }
    __device__ __forceinline__ void a_ready(const Unit&) const {}
    __device__ __forceinline__ void done(const Unit&) const {}
};
struct OffsetOrder {
    int nM, nN, nwg, G, c;
    __device__ void init(int M, int N, int G_, int c_, int off) { nM = M / BM; nN = N / BM; nwg = nM * nN; G = G_; c = (c_ - off % G_ + G_) % G_; }
    __device__ bool next(int i, Unit& u) const { const long L = (long)i * G + c; if (L >= nwg) return false; u.pm = (int)L % nM; u.pn = (int)L / nM; return true; }
    __device__ __forceinline__ const char* abase(const Gemm& g, const Unit& u) const { return (const char*)g.A + (size_t)u.pm * 256 * g.lda * 2; }
    __device__ __forceinline__ const char* bbase(const Gemm& g, const Unit& u) const { return (const char*)g.Bt + (size_t)u.pn * 256 * g.ldb * 2; }
    __device__ __forceinline__ void a_ready(const Unit&) const {}
    __device__ __forceinline__ void done(const Unit&) const {}
};
template <int MODE> struct AttnOrder {
    int G, c;
    __device__ void init(int G_, int c_) { G = G_; c = c_; }
    __device__ bool next(int i, Unit& u) const { const long L = (long)i * G + c; if (L >= 256) return false; const int b = (int)L >> 5, h = ((int)L >> 3) & 3, qt = (int)L & 7; u.pm = 8 * b + qt; u.pn = h; return true; }
    __device__ __forceinline__ const char* abase(const Gemm& g, const Unit& u) const { return (const char*)g.A + ((size_t)u.pm * 256 * 1024 + (size_t)u.pn * 256) * 2; }
    __device__ __forceinline__ const char* bbase(const Gemm& g, const Unit& u) const {
        const int b = u.pm >> 3;
        if (MODE == 0) return (const char*)g.Bt + ((size_t)b * 256 * 1024 + (size_t)u.pn * 256) * 2;
        return (const char*)g.Bt + (size_t)(4 * b + u.pn) * 256 * 256 * 2;
    }
    __device__ __forceinline__ void a_ready(const Unit&) const {}
    __device__ __forceinline__ void done(const Unit&) const {}
};

__device__ __forceinline__ unsigned cvt_pk_bf16(float lo, float hi) { unsigned r; asm volatile("v_cvt_pk_bf16_f32 %0, %1, %2" : "=v"(r) : "v"(lo), "v"(hi)); return r; }
constexpr float RMS_EPS = 1e-6f;
__device__ __forceinline__ float rstd16(const float* ssq, int row) {
    const f32x4* p = (const f32x4*)(ssq + (size_t)row * 16); const f32x4 a = p[0], b = p[1], c = p[2], d = p[3];
    const float s = ((a[0] + a[1]) + (a[2] + a[3])) + ((b[0] + b[1]) + (b[2] + b[3])) + ((c[0] + c[1]) + (c[2] + c[3])) + ((d[0] + d[1]) + (d[2] + d[3]));
    return 1.0f / sqrtf(s * (1.0f / 1024.0f) + RMS_EPS);
}
__device__ __forceinline__ float silu_f(float x) { return x / (1.0f + __expf(-x)); }

struct EpiGateUp {
    static constexpr bool PERM = true, AFTER_DRAIN = false;
    bf16_t* O; int ldc; const float* ssq;
    __device__ __forceinline__ void operator()(const f32x4 (&acc)[2][2][4][2], const Unit& u, int wr, int wc, int fr, int fq) const {
        const int row0 = u.pm * BM + wr * 64 + fr, col0 = u.pn * HALF + wc * 32 + 8 * fq;
#pragma unroll
        for (int ai = 0; ai < 2; ++ai)
#pragma unroll
            for (int m = 0; m < 4; ++m) { const int r = row0 + ai * HALF + m * 16; const float rs = rstd16(ssq, r);
                f32x4 g0 = acc[ai][0][m][0] * rs, g1 = acc[ai][0][m][1] * rs, u0 = acc[ai][1][m][0] * rs, u1 = acc[ai][1][m][1] * rs;
                float o[8];
#pragma unroll
                for (int j = 0; j < 4; ++j) { o[j] = silu_f(g0[j]) * u0[j]; o[4 + j] = silu_f(g1[j]) * u1[j]; }
                u32x4 w; w.x = cvt_pk_bf16(o[0], o[1]); w.y = cvt_pk_bf16(o[2], o[3]); w.z = cvt_pk_bf16(o[4], o[5]); w.w = cvt_pk_bf16(o[6], o[7]);
                *(u32x4*)(O + (size_t)r * ldc + col0) = w; }
    }
};
struct EpiRowBf16 {
    static constexpr bool PERM = true, AFTER_DRAIN = false;
    bf16_t* O; int ldc; const float* ssq;
    __device__ __forceinline__ void operator()(const f32x4 (&acc)[2][2][4][2], const Unit& u, int wr, int wc, int fr, int fq) const {
        const int row0 = u.pm * BM + wr * 64 + fr, col0 = u.pn * BM + wc * 32 + 8 * fq;
#pragma unroll
        for (int ai = 0; ai < 2; ++ai)
#pragma unroll
            for (int m = 0; m < 4; ++m) { const int r = row0 + ai * HALF + m * 16; const float rs = ssq ? rstd16(ssq, r) : 1.0f; bf16_t* rowp = O + (size_t)r * ldc + col0;
#pragma unroll
                for (int bj = 0; bj < 2; ++bj) { const f32x4 v0 = acc[ai][bj][m][0] * rs, v1 = acc[ai][bj][m][1] * rs;
                    u32x4 w; w.x = cvt_pk_bf16(v0[0], v0[1]); w.y = cvt_pk_bf16(v0[2], v0[3]); w.z = cvt_pk_bf16(v1[0], v1[1]); w.w = cvt_pk_bf16(v1[2], v1[3]);
                    *(u32x4*)(rowp + bj * HALF) = w; } }
    }
};
struct EpiProj {
    static constexpr bool PERM = true, AFTER_DRAIN = false;
    bf16_t* O; int ldc; const float* ssq; float* dtr;
    __device__ __forceinline__ void operator()(const f32x4 (&acc)[2][2][4][2], const Unit& u, int wr, int wc, int fr, int fq) const {
        const int row0 = u.pm * BM + wr * 64 + fr, col0 = u.pn * BM + wc * 32 + 8 * fq;
        if (u.pn < 9) {
#pragma unroll
            for (int ai = 0; ai < 2; ++ai)
#pragma unroll
                for (int m = 0; m < 4; ++m) { const int r = row0 + ai * HALF + m * 16; const float rs = rstd16(ssq, r); bf16_t* rowp = O + (size_t)r * ldc + col0;
#pragma unroll
                    for (int bj = 0; bj < 2; ++bj) { const f32x4 v0 = acc[ai][bj][m][0] * rs, v1 = acc[ai][bj][m][1] * rs;
                        u32x4 w; w.x = cvt_pk_bf16(v0[0], v0[1]); w.y = cvt_pk_bf16(v0[2], v0[3]); w.z = cvt_pk_bf16(v1[0], v1[1]); w.w = cvt_pk_bf16(v1[2], v1[3]);
                        *(u32x4*)(rowp + bj * HALF) = w; } }
        } else if (wc == 0 && fq < 2) {
#pragma unroll
            for (int ai = 0; ai < 2; ++ai)
#pragma unroll
                for (int m = 0; m < 4; ++m) { const int r = row0 + ai * HALF + m * 16; const float rs = rstd16(ssq, r); float* dp = dtr + (size_t)r * 12 + 8 * fq;
                    *(f32x4*)dp = acc[ai][0][m][0] * rs; if (fq == 0) *(f32x4*)(dp + 4) = acc[ai][0][m][1] * rs; }
        }
    }
};
struct EpiResid {
    static constexpr bool PERM = false, AFTER_DRAIN = false;
    const float* res; const float* res2; int split; float* out; bf16_t* outb; float alpha; const float* ssq_in; float* ssq_out;
    __device__ __forceinline__ void operator()(const f32x4 (&acc)[2][2][4][2], const Unit& u, int wr, int wc, int fr, int fq) const {
        const int row0 = u.pm * BM + wr * 64 + fr, col0 = u.pn * BM + wc * 32 + 4 * fq;
#pragma unroll
        for (int ai = 0; ai < 2; ++ai)
#pragma unroll
            for (int m = 0; m < 4; ++m) { const int r = row0 + ai * HALF + m * 16; const float sc = alpha * (ssq_in ? rstd16(ssq_in, r) : 1.0f);
                const float* rp = (r < split) ? res + (size_t)r * 1024 : res2 + (size_t)(r - split) * 1024; const size_t off = (size_t)r * 1024 + col0; float q = 0.f;
#pragma unroll
                for (int bj = 0; bj < 2; ++bj)
#pragma unroll
                    for (int n = 0; n < 2; ++n) { const int cc = bj * HALF + n * 16; const f32x4 bs = *(const f32x4*)(rp + col0 + cc); const f32x4 o = bs + acc[ai][bj][m][n] * sc;
                        *(f32x4*)(out + off + cc) = o; q += (o[0] * o[0] + o[1] * o[1]) + (o[2] * o[2] + o[3] * o[3]);
                        if (outb) { u32x2 w; w.x = cvt_pk_bf16(o[0], o[1]); w.y = cvt_pk_bf16(o[2], o[3]); *(u32x2*)(outb + off + cc) = w; } }
                q += __shfl_xor(q, 16); q += __shfl_xor(q, 32);
                if (fq == 0) ssq_out[(size_t)r * 16 + u.pn * 4 + wc] = q; }
    }
};
struct EpiMem {
    static constexpr bool PERM = false, AFTER_DRAIN = false;
    float* outk; float* outv; bf16_t* km; bf16_t* vt; const float* ssq;
    __device__ __forceinline__ void operator()(const f32x4 (&acc)[2][2][4][2], const Unit& u, int wr, int wc, int fr, int fq) const {
        const int row0 = u.pm * BM + wr * 64 + fr; const bool isv = u.pn >= 4; const int col0 = (u.pn & 3) * BM + wc * 32 + 4 * fq;
#pragma unroll
        for (int ai = 0; ai < 2; ++ai)
#pragma unroll
            for (int m = 0; m < 4; ++m) { const int r = row0 + ai * HALF + m * 16; const float rs = rstd16(ssq, r); const size_t off = (size_t)r * 1024 + col0;
#pragma unroll
                for (int bj = 0; bj < 2; ++bj)
#pragma unroll
                    for (int n = 0; n < 2; ++n) { const int cc = bj * HALF + n * 16; const f32x4 o = acc[ai][bj][m][n] * rs;
                        if (!isv) { *(f32x4*)(outk + off + cc) = o; u32x2 w; w.x = cvt_pk_bf16(o[0], o[1]); w.y = cvt_pk_bf16(o[2], o[3]); *(u32x2*)(km + off + cc) = w; }
                        else { *(f32x4*)(outv + off + cc) = o; const int b = r >> 8, mm = r & 255; const int c = col0 + cc; const int h = c >> 8, d = c & 255;
                            bf16_t* vp = vt + ((size_t)(4 * b + h) * 256 + d) * 256 + mm; const unsigned w0 = cvt_pk_bf16(o[0], o[1]), w1 = cvt_pk_bf16(o[2], o[3]);
                            vp[0] = (bf16_t)(w0 & 0xffffu); vp[256] = (bf16_t)(w0 >> 16); vp[512] = (bf16_t)(w1 & 0xffffu); vp[768] = (bf16_t)(w1 >> 16); } } }
    }
};
struct EpiSoftmax {
    static constexpr bool PERM = true, AFTER_DRAIN = true;
    bf16_t* P;
    __device__ __forceinline__ void fused(f32x4 (&acc)[2][2][4][2], const Unit& u, int wr, int wc, int fr, int fq, PG8_LAS unsigned char* lds, int wid, int lane) const {
        PG8_LAS float* red = (PG8_LAS float*)lds;
        PG8_LAS float* red2 = (PG8_LAS float*)(lds + 4096);
#pragma unroll
        for (int ai = 0; ai < 2; ++ai)
#pragma unroll
            for (int m = 0; m < 4; ++m) { float mx = -3.0e38f;
#pragma unroll
                for (int bj = 0; bj < 2; ++bj)
#pragma unroll
                    for (int n = 0; n < 2; ++n) { const f32x4 x = acc[ai][bj][m][n]; mx = fmaxf(mx, fmaxf(fmaxf(x[0], x[1]), fmaxf(x[2], x[3]))); }
                mx = fmaxf(mx, __shfl_xor(mx, 16)); mx = fmaxf(mx, __shfl_xor(mx, 32));
                if (fq == 0) red[(ai * HALF + wr * 64 + m * 16 + fr) * 4 + wc] = mx; }
        asm volatile("s_waitcnt lgkmcnt(0)" ::: "memory"); __builtin_amdgcn_s_barrier(); asm volatile("" ::: "memory");
#pragma unroll
        for (int ai = 0; ai < 2; ++ai)
#pragma unroll
            for (int m = 0; m < 4; ++m) { const int rr = ai * HALF + wr * 64 + m * 16 + fr; const f32x4 q = *(const PG8_LAS f32x4*)(red + rr * 4);
                const float mx = fmaxf(fmaxf(q[0], q[1]), fmaxf(q[2], q[3])); float s = 0.f;
#pragma unroll
                for (int bj = 0; bj < 2; ++bj)
#pragma unroll
                    for (int n = 0; n < 2; ++n) { f32x4 x = acc[ai][bj][m][n];
#pragma unroll
                        for (int j = 0; j < 4; ++j) { x[j] = __expf(x[j] - mx); s += x[j]; }
                        acc[ai][bj][m][n] = x; }
                s += __shfl_xor(s, 16); s += __shfl_xor(s, 32);
                if (fq == 0) red2[rr * 4 + wc] = s; }
        asm volatile("s_waitcnt lgkmcnt(0)" ::: "memory"); __builtin_amdgcn_s_barrier(); asm volatile("" ::: "memory");
        const int col0 = u.pn * BM + wc * 32 + 8 * fq;
#pragma unroll
        for (int ai = 0; ai < 2; ++ai)
#pragma unroll
            for (int m = 0; m < 4; ++m) { const int rr = ai * HALF + wr * 64 + m * 16 + fr; const f32x4 q = *(const PG8_LAS f32x4*)(red2 + rr * 4);
                const float inv = 1.0f / ((q[0] + q[1]) + (q[2] + q[3])); bf16_t* rowp = P + (size_t)(u.pm * BM + rr) * 1024 + col0;
#pragma unroll
                for (int bj = 0; bj < 2; ++bj) { const f32x4 v0 = acc[ai][bj][m][0] * inv, v1 = acc[ai][bj][m][1] * inv;
                    u32x4 w; w.x = cvt_pk_bf16(v0[0], v0[1]); w.y = cvt_pk_bf16(v0[2], v0[3]); w.z = cvt_pk_bf16(v1[0], v1[1]); w.w = cvt_pk_bf16(v1[2], v1[3]);
                    *(u32x4*)(rowp + bj * HALF) = w; } }
        asm volatile("s_waitcnt lgkmcnt(0)" ::: "memory"); __builtin_amdgcn_s_barrier(); asm volatile("" ::: "memory");
    }
};

template <class Epi, class Sched, bool ALIGN_EPI = false, bool SP2 = false>
__device__ __forceinline__ void gemm_phase(PG8_LAS unsigned char* lds, const Gemm g, const Sched& S, const Epi& E) {
    const int tid = threadIdx.x, wid = __builtin_amdgcn_readfirstlane(tid >> 6), lane = tid & 63, wr = wid >> 2, wc = wid & 3, fr = lane & 15, fq = lane >> 4;
    const int K = g.K, nt = K / BK;
    unsigned voffA[2], voffB[2];
#pragma unroll
    for (int i = 0; i < 2; ++i) { int R, C; stage_rc(tid * 16 + i * 8192, R, C); const int Rb = Epi::PERM ? ((R & ~31) + perm32(R & 31)) : R;
        voffA[i] = (unsigned)(R * g.lda + C) * 2u; voffB[i] = (unsigned)(Rb * g.ldb + C) * 2u; }
    const size_t kstep = (size_t)(BK * 2);
    const size_t hstepA = (size_t)HALF * g.lda * 2, hstepB = (size_t)HALF * g.ldb * 2;
    const unsigned ldsw = (unsigned)wid * 1024u;
    const int aoff = lds_byte(wr * 64 + fr, fq * 8), boff = lds_byte(wc * 32 + fr, fq * 8);
#define PG8_SA(b, h) (((b) * 2 + (h)) * HTB)
#define PG8_SB(b, h) ((4 + (b) * 2 + (h)) * HTB)
#define PG8_STAGE(bufoff, gbase, voff) do { _Pragma("unroll") for (int _i = 0; _i < 2; ++_i) \
        __builtin_amdgcn_global_load_lds((const unsigned*)((const char*)(gbase) + (voff)[_i]), (PG8_LAS unsigned*)(lds + (bufoff) + ldsw + _i * 8192), 16, 0, 0); } while (0)
#define PG8_LDA(dst, b, h) do { _Pragma("unroll") for (int m = 0; m < 4; ++m) _Pragma("unroll") for (int k = 0; k < 2; ++k) dst[m][k] = *(const PG8_LAS bf16x8*)(lds + PG8_SA(b, h) + aoff + m * 2048 + k * 1024); } while (0)
#define PG8_LDB(dst, b, h) do { _Pragma("unroll") for (int n = 0; n < 2; ++n) _Pragma("unroll") for (int k = 0; k < 2; ++k) dst[n][k] = *(const PG8_LAS bf16x8*)(lds + PG8_SB(b, h) + boff + n * 2048 + k * 1024); } while (0)
#define PG8_MMA(ai, bj, At, Bt) do { __builtin_amdgcn_s_setprio(1); _Pragma("unroll") for (int m = 0; m < 4; ++m) _Pragma("unroll") for (int n = 0; n < 2; ++n) _Pragma("unroll") for (int k = 0; k < 2; ++k) \
        acc[ai][bj][m][n] = __builtin_amdgcn_mfma_f32_16x16x32_bf16(Bt[n][k], At[m][k], acc[ai][bj][m][n], 0, 0, 0); __builtin_amdgcn_s_setprio(0); } while (0)
#define PG8_WAIT_V(n) asm volatile("s_waitcnt vmcnt(" #n ")" ::: "memory")
#define PG8_WAIT_L(n) asm volatile("s_waitcnt lgkmcnt(" #n ")" ::: "memory")
#define PG8_BAR __builtin_amdgcn_s_barrier()
#define PG8_SCHED __builtin_amdgcn_sched_barrier(0)
    Unit cur, nxt; int ui = 0;
    if (!S.next(0, cur)) return;
    f32x4 acc[2][2][4][2];
#pragma unroll
    for (int a = 0; a < 2; ++a)
#pragma unroll
        for (int b = 0; b < 2; ++b)
#pragma unroll
            for (int m = 0; m < 4; ++m)
#pragma unroll
                for (int n = 0; n < 2; ++n) acc[a][b][m][n] = (f32x4){0.f, 0.f, 0.f, 0.f};
    bf16x8 At[4][2], B0[2][2], B1[2][2];
    const char* cA = S.abase(g, cur); const char* cB = S.bbase(g, cur);
    S.a_ready(cur);
    if constexpr (SP2) {
        PG8_STAGE(PG8_SB(0, 0), cB, voffB); PG8_STAGE(PG8_SB(0, 1), cB + hstepB, voffB); PG8_STAGE(PG8_SA(0, 0), cA, voffA); PG8_STAGE(PG8_SA(0, 1), cA + hstepA, voffA);
        if (wr == 1) PG8_BAR;
        PG8_WAIT_V(2); PG8_BAR;
        PG8_STAGE(PG8_SB(1, 0), cB + kstep, voffB); PG8_STAGE(PG8_SA(1, 0), cA + kstep, voffA); PG8_STAGE(PG8_SB(1, 1), cB + hstepB + kstep, voffB);
        PG8_WAIT_V(6); PG8_BAR;
    } else {
        PG8_STAGE(PG8_SB(0, 0), cB, voffB); PG8_STAGE(PG8_SA(0, 0), cA, voffA); PG8_STAGE(PG8_SB(0, 1), cB + hstepB, voffB); PG8_STAGE(PG8_SA(0, 1), cA + hstepA, voffA);
        if (wr == 1) PG8_BAR;
        PG8_WAIT_V(4); PG8_BAR;
        PG8_STAGE(PG8_SB(1, 0), cB + kstep, voffB); PG8_STAGE(PG8_SA(1, 0), cA + kstep, voffA); PG8_STAGE(PG8_SB(1, 1), cB + hstepB + kstep, voffB);
        PG8_WAIT_V(6); PG8_BAR;
    }
    for (;;) {
        const bool has_next = S.next(ui + 1, nxt);
        const char* nA = has_next ? S.abase(g, nxt) : cA; const char* nB = has_next ? S.bbase(g, nxt) : cB;
        for (int t = 0; t < nt; t += 2) {
            const bool last = (t == nt - 2);
            const char* a1 = cA + (size_t)(t + 1) * kstep;
            const char* a2 = last ? nA : cA + (size_t)(t + 2) * kstep; const char* b2 = last ? nB : cB + (size_t)(t + 2) * kstep;
            const char* a3 = a2 + kstep; const char* b3 = b2 + kstep;
            if (last && has_next) S.a_ready(nxt);
            if constexpr (SP2) {
            PG8_LDB(B0, 0, 0); PG8_LDB(B1, 0, 1); PG8_SCHED; PG8_LDA(At, 0, 0); PG8_STAGE(PG8_SA(1, 1), a1 + hstepA, voffA);
            PG8_WAIT_V(8); PG8_WAIT_L(0); PG8_BAR; PG8_MMA(0, 0, At, B0); PG8_MMA(0, 1, At, B1); PG8_BAR; PG8_SCHED;
            PG8_LDA(At, 0, 1); PG8_STAGE(PG8_SB(0, 0), b2, voffB); PG8_STAGE(PG8_SB(0, 1), b2 + hstepB, voffB); PG8_STAGE(PG8_SA(0, 0), a2, voffA);
            PG8_WAIT_V(8); PG8_WAIT_L(0); PG8_BAR; PG8_MMA(1, 0, At, B0); PG8_MMA(1, 1, At, B1); PG8_BAR; PG8_SCHED;
            PG8_LDB(B0, 1, 0); PG8_LDB(B1, 1, 1); PG8_SCHED; PG8_LDA(At, 1, 0); PG8_STAGE(PG8_SA(0, 1), a2 + hstepA, voffA);
            PG8_WAIT_V(8); PG8_WAIT_L(0); PG8_BAR; PG8_MMA(0, 0, At, B0); PG8_MMA(0, 1, At, B1); PG8_BAR; PG8_SCHED;
            PG8_LDA(At, 1, 1); PG8_STAGE(PG8_SB(1, 0), b3, voffB); PG8_STAGE(PG8_SB(1, 1), b3 + hstepB, voffB); PG8_STAGE(PG8_SA(1, 0), a3, voffA);
            PG8_WAIT_V(8); PG8_WAIT_L(0); PG8_BAR; PG8_MMA(1, 0, At, B0); PG8_MMA(1, 1, At, B1); PG8_BAR; PG8_SCHED;
            } else {
            PG8_LDB(B0, 0, 0); PG8_SCHED; PG8_LDA(At, 0, 0); PG8_STAGE(PG8_SA(1, 1), a1 + hstepA, voffA);
            PG8_WAIT_L(8); PG8_BAR; PG8_WAIT_L(0); PG8_MMA(0, 0, At, B0); PG8_BAR; PG8_SCHED;
            PG8_LDB(B1, 0, 1); PG8_STAGE(PG8_SB(0, 0), b2, voffB);
            PG8_BAR; PG8_WAIT_L(0); PG8_MMA(0, 1, At, B1); PG8_BAR;
            PG8_LDA(At, 0, 1); PG8_STAGE(PG8_SA(0, 0), a2, voffA);
            PG8_BAR; PG8_WAIT_L(0); PG8_MMA(1, 0, At, B0); PG8_BAR; PG8_SCHED;
            PG8_STAGE(PG8_SB(0, 1), b2 + hstepB, voffB);
            PG8_WAIT_V(6); PG8_BAR; PG8_MMA(1, 1, At, B1); PG8_BAR;
            PG8_LDB(B0, 1, 0); PG8_SCHED; PG8_LDA(At, 1, 0); PG8_STAGE(PG8_SA(0, 1), a2 + hstepA, voffA);
            PG8_WAIT_L(8); PG8_BAR; PG8_WAIT_L(0); PG8_MMA(0, 0, At, B0); PG8_BAR; PG8_SCHED;
            PG8_LDB(B1, 1, 1); PG8_STAGE(PG8_SB(1, 0), b3, voffB);
            PG8_BAR; PG8_WAIT_L(0); PG8_MMA(0, 1, At, B1); PG8_BAR;
            PG8_LDA(At, 1, 1); PG8_STAGE(PG8_SA(1, 0), a3, voffA);
            PG8_BAR; PG8_WAIT_L(0); PG8_MMA(1, 0, At, B0); PG8_BAR; PG8_SCHED;
            PG8_STAGE(PG8_SB(1, 1), b3 + hstepB, voffB);
            PG8_WAIT_V(6); PG8_BAR; PG8_MMA(1, 1, At, B1); PG8_BAR;
            }
        }
        if constexpr (ALIGN_EPI) { if (wr == 0) PG8_BAR; }
        if constexpr (!Epi::AFTER_DRAIN) { E(acc, cur, wr, wc, fr, fq); S.done(cur); }
        if (!has_next) break;
#pragma unroll
        for (int a = 0; a < 2; ++a)
#pragma unroll
            for (int b = 0; b < 2; ++b)
#pragma unroll
                for (int m = 0; m < 4; ++m)
#pragma unroll
                    for (int n = 0; n < 2; ++n) acc[a][b][m][n] = (f32x4){0.f, 0.f, 0.f, 0.f};
        cur = nxt; cA = nA; cB = nB; ++ui;
        if constexpr (ALIGN_EPI) { if (wr == 1) PG8_BAR; }
    }
    PG8_WAIT_V(0);
    if constexpr (!ALIGN_EPI) { if (wr == 0) PG8_BAR; }
    PG8_BAR;
    if constexpr (Epi::AFTER_DRAIN) { E.fused(acc, cur, wr, wc, fr, fq, lds, wid, lane); S.done(cur); }
#undef PG8_SA
#undef PG8_SB
#undef PG8_STAGE
#undef PG8_LDA
#undef PG8_LDB
#undef PG8_MMA
#undef PG8_WAIT_V
#undef PG8_WAIT_L
#undef PG8_BAR
#undef PG8_SCHED
}
}

constexpr int NWAVES = 8, NTHREADS = 512;
constexpr int N_PHASES = 15;
constexpr int N_LAUNCHES = MK_N_LAUNCHES;
constexpr int D = 1024, FF = 2816, NGU = 2 * FF, NIN = 2304, D_INP = 2316;
constexpr int BATCH = 8, SEQ = 2048, MP = BATCH * SEQ, DEC_B = 128, DEC_T = 4, MS = DEC_B * DEC_T, M = MP + MS;
constexpr int D_POOL = 256, D_SSM = 768, NH = 12, HD = 64, NST = 128, CONV_DIM = 1280, CHUNK = 128, NCH = SEQ / CHUNK;
constexpr int XBC0 = 1024;
constexpr int NMEM = 256, MEMROWS = BATCH * NMEM;
constexpr float EPS = 1e-6f;

constexpr size_t MiB = 1u << 20;
constexpr size_t WS_CTL = 0, CTL_ZERO_BYTES = 1 * MiB;
constexpr size_t WS_W1GU = 2 * MiB, WS_W1D = 13 * MiB, WS_WIN = 19 * MiB, WS_WOUT = 24 * MiB, WS_WQ = 26 * MiB, WS_WO = 28 * MiB, WS_WMKV = 30 * MiB, WS_W2GU = 34 * MiB, WS_W2D = 45 * MiB, WS_DTR = 51 * MiB;
constexpr size_t WS_SSQ0 = 52 * MiB, WS_SSQ1 = 54 * MiB, WS_SSQY = 56 * MiB, WS_SSQ2 = 58 * MiB, WS_SSQ3 = 60 * MiB, WS_SSQ4 = 62 * MiB, WS_SSQM = 64 * MiB;
constexpr size_t WS_EXPA = 65 * MiB, WS_CD = 66 * MiB;
constexpr size_t WS_MBF = 68 * MiB, WS_KM = 72 * MiB, WS_VT = 76 * MiB;
constexpr size_t WS_XB = 80 * MiB;
constexpr size_t WS_X = 114 * MiB;
constexpr size_t WS_A2 = 180 * MiB;
constexpr size_t WS_ACT = 214 * MiB;
constexpr size_t WS_YD = 214 * MiB, WS_ST = 262 * MiB;
constexpr size_t WS_PROJ = 310 * MiB;
constexpr size_t WS_Q = 310 * MiB, WS_PB = 343 * MiB;
constexpr size_t WS_HP = 385 * MiB, WS_CB = 409 * MiB;
constexpr size_t WS_O = 385 * MiB;
constexpr size_t WS_END = 420 * MiB;
static_assert(WS_W1GU + (size_t)NGU * D * 2 <= WS_W1D && WS_W1D + (size_t)D * FF * 2 <= WS_WIN && WS_WIN + (size_t)NIN * D * 2 <= WS_WOUT && WS_W2GU + (size_t)NGU * D * 2 <= WS_W2D && WS_W2D + (size_t)D * FF * 2 <= WS_DTR && WS_DTR + (size_t)M * 12 * 4 <= WS_SSQ0 && WS_WIN + (size_t)(NIN + 256) * D * 2 <= WS_WOUT, "weights map");
static_assert(WS_SSQ0 + (size_t)M * 64 <= WS_SSQ1 && WS_XB + (size_t)M * D * 2 <= WS_X && WS_X + (size_t)M * D * 4 <= WS_A2 && WS_A2 + (size_t)M * D * 2 <= WS_ACT, "ws map 1");
static_assert(WS_ACT + (size_t)M * FF * 2 <= WS_PROJ && WS_YD + (size_t)MP * D_SSM * 4 <= WS_ST && WS_ST + (size_t)BATCH * NCH * NH * HD * NST * 4 <= WS_PROJ, "ws map 2");
static_assert(WS_PROJ + (size_t)M * NIN * 2 <= WS_HP && WS_Q + (size_t)M * D * 2 <= WS_PB && WS_PB + (size_t)MP * D * 2 <= WS_HP, "ws map 3");
static_assert(WS_HP + (size_t)BATCH * NCH * NH * HD * NST * 2 <= WS_CB && WS_CB + (size_t)MP * 256 * 2 <= WS_END && WS_O + (size_t)M * D * 2 <= WS_END, "ws map 4");
constexpr int CW_BAR = 4096;

constexpr size_t OUT_Y = 0, OUT_MK = (size_t)M * D, OUT_MV = OUT_MK + (size_t)MEMROWS * D, OUT_POOLP = OUT_MV + (size_t)MEMROWS * D, OUT_CONVP = OUT_POOLP + (size_t)BATCH * 15 * D_POOL,
    OUT_SSMP = OUT_CONVP + (size_t)BATCH * 3 * CONV_DIM, OUT_POOLS = OUT_SSMP + (size_t)BATCH * NH * HD * NST, OUT_CONVS = OUT_POOLS + (size_t)DEC_B * 15 * D_POOL, OUT_SSMS = OUT_CONVS + (size_t)DEC_B * 3 * CONV_DIM,
    OUT_TOTAL = OUT_SSMS + (size_t)DEC_B * NH * HD * NST;
static_assert(OUT_TOTAL == 35909632, "output size");

constexpr int RING_OFF = 0, RING_BYTES = 153600;
constexpr int LDSCTL_OFF = RING_BYTES, MISC_OFF = LDSCTL_OFF + 320;
constexpr int LDS_BYTES = 163840;
static_assert(MISC_OFF + 128 <= LDS_BYTES, "LDS map");

#define GAS __attribute__((address_space(1)))
#define LAS __attribute__((address_space(3)))
typedef unsigned short bf16;
typedef unsigned v4u __attribute__((ext_vector_type(4)));
typedef unsigned v2u __attribute__((ext_vector_type(2)));
typedef float f32x4 __attribute__((ext_vector_type(4)));
typedef short bf16x8 __attribute__((ext_vector_type(8)));
typedef GAS unsigned gu32;
#define RLX_AGENT __ATOMIC_RELAXED, __HIP_MEMORY_SCOPE_AGENT
#define LDS_WAIT() asm volatile("s_waitcnt lgkmcnt(0)" ::: "memory")
#define VM_WAIT() asm volatile("s_waitcnt vmcnt(0)" ::: "memory")
__device__ __forceinline__ unsigned f2bf(float f) { unsigned u = __builtin_bit_cast(unsigned, f); return (u + 0x7fffu + ((u >> 16) & 1u)) >> 16; }
__device__ __forceinline__ unsigned pk2(float lo, float hi) { return f2bf(lo) | (f2bf(hi) << 16); }
__device__ __forceinline__ float bf2f(unsigned b) { return __builtin_bit_cast(float, (b & 0xffffu) << 16); }
__device__ __forceinline__ float bflo(unsigned w) { return __builtin_bit_cast(float, w << 16); }
__device__ __forceinline__ float bfhi(unsigned w) { return __builtin_bit_cast(float, w & 0xffff0000u); }
__device__ __forceinline__ float siluf(float x) { return x / (1.0f + __expf(-x)); }
__device__ __forceinline__ float softplusf(float x) { return fmaxf(x, 0.f) + log1pf(__expf(-fabsf(x))); }
__device__ __forceinline__ float wave_sum(float v) {
#pragma unroll
    for (int o = 1; o < 64; o <<= 1) v += __shfl_xor(v, o);
    return v;
}
#define WG_BAR() do { asm volatile("s_waitcnt vmcnt(0) lgkmcnt(0)" ::: "memory"); __builtin_amdgcn_s_barrier(); asm volatile("" ::: "memory"); } while (0)
#define MFMA16(a, b, c) __builtin_amdgcn_mfma_f32_16x16x32_bf16((a), (b), (c), 0, 0, 0)

#define XB_TMO      128
#define XB_XCNT(j)  (256  + 64 * (j))
#define XB_XSUB(j)  (1280 + 64 * (j))
#define XB_XGEN(j)  (2304 + 64 * (j))
#define XB_TOP      3328
#define XB_TOPGEN   3392
#define XCD_BAR_WORDS 3456
#define XB_SPIN_CAP (1u << 18)

__device__ __forceinline__ unsigned xb_ld(unsigned* p)              { return __hip_atomic_load(p, __ATOMIC_RELAXED, __HIP_MEMORY_SCOPE_AGENT); }
__device__ __forceinline__ unsigned xb_add(unsigned* p, unsigned v) { return __hip_atomic_fetch_add(p, v, __ATOMIC_RELAXED, __HIP_MEMORY_SCOPE_AGENT); }
__device__ __forceinline__ unsigned xb_xcc_id() { return (unsigned)__builtin_amdgcn_s_getreg((3 << 11) | 20) & 0xFu; }
#define XB_SPIN(cond, bar) do { unsigned _sp = 0; while (cond) { __builtin_amdgcn_s_sleep(1); \
    if ((++_sp & 255u) == 0u) { if (xb_ld(&(bar)[XB_TMO])) break; if (_sp > XB_SPIN_CAP) { atomicAdd(&(bar)[XB_TMO], 1u); break; } } } } while (0)

struct XcdBarrier {
    unsigned* bar; unsigned x;
    volatile LAS unsigned* st;
};

__device__ __forceinline__ XcdBarrier xcd_barrier_post(unsigned* bar, volatile LAS unsigned* st) {
    XcdBarrier b; b.bar = bar; b.x = xb_xcc_id(); b.st = st;
    if (threadIdx.x == 0) (void)xb_add(&bar[XB_XCNT(b.x)], 1u);
    return b;
}
__device__ __forceinline__ void xcd_barrier_complete(unsigned* bar, unsigned x, unsigned& nloc, unsigned& nx) {
    const unsigned G = gridDim.x * gridDim.y * gridDim.z;
    unsigned sum, cnt, mine, sp = 0u;
    for (;;) {
        sum = 0u; cnt = 0u; mine = 0u;
#pragma unroll
        for (unsigned j = 0; j < 16; ++j) { const unsigned c = xb_ld(&bar[XB_XCNT(j)]); sum += c; cnt += (c > 0u) ? 1u : 0u; mine = (j == x) ? c : mine; }
        if (sum == G) break;
        __builtin_amdgcn_s_sleep(1);
        if ((++sp & 255u) == 0u) { if (xb_ld(&bar[XB_TMO])) break; if (sp > XB_SPIN_CAP) { atomicAdd(&bar[XB_TMO], 1u); break; } }
    }
    nloc = mine > 0u ? mine : 1u; nx = cnt > 0u ? cnt : 1u;
}

__device__ __forceinline__ void xcd_barrier(const XcdBarrier& b) {
    asm volatile("s_waitcnt vmcnt(0)" ::: "memory");
    __syncthreads();
    if (threadIdx.x == 0) {
        unsigned* bar = b.bar;
        __builtin_amdgcn_s_waitcnt(0);
        unsigned nloc = b.st[0], nx = b.st[1];
        if (nloc == 0u) { xcd_barrier_complete(bar, b.x, nloc, nx); b.st[0] = nloc; b.st[1] = nx; }
        const unsigned old = xb_add(&bar[XB_XSUB(b.x)], 1u);
        const unsigned gen = old / nloc;
        if (old + 1u == (gen + 1u) * nloc) {
            __builtin_amdgcn_fence(__ATOMIC_RELEASE, "agent");
            asm volatile("s_waitcnt vmcnt(0)" ::: "memory");
            const unsigned og = xb_add(&bar[XB_TOP], 1u);
            const unsigned tg = og / nx;
            if (og + 1u == (tg + 1u) * nx) xb_add(&bar[XB_TOPGEN], 1u);
            else XB_SPIN(xb_ld(&bar[XB_TOPGEN]) == tg, bar);
            __builtin_amdgcn_fence(__ATOMIC_ACQUIRE, "agent");
            xb_add(&bar[XB_XGEN(b.x)], 1u);
            asm volatile("s_waitcnt vmcnt(0)" ::: "memory");
        } else {
            XB_SPIN(xb_ld(&bar[XB_XGEN(b.x)]) == gen, bar);
            __builtin_amdgcn_fence(__ATOMIC_ACQUIRE, "agent");
            asm volatile("s_waitcnt vmcnt(0)" ::: "memory");
        }
    }
    __syncthreads();
}

struct Frame {
    LAS unsigned char* lds;
    volatile LAS unsigned* MISC;
    gu32* ctl;
    int tid, lane, wave, G, bid;
    LAS unsigned* ptab;
    float* out; unsigned char* ws;
};
__device__ __forceinline__ const float* ld_inp(const Frame& F, int i) {
    const unsigned lo = __builtin_amdgcn_readfirstlane(F.ptab[2 * i]), hi = __builtin_amdgcn_readfirstlane(F.ptab[2 * i + 1]);
    return (const float*)(const GAS float*)(((unsigned long long)hi << 32) | lo);
}
#define INP(i) ld_inp(F, (i))
enum { I_XP = 0, I_XS, I_MEMP, I_CK, I_CV, I_SPOOL, I_SCONV, I_SSSM, I_GFFN1, I_W1G, I_W1U, I_W1D, I_GMIX, I_WIN, I_CONVW, I_CONVB, I_DTB, I_ALOG, I_DSKIP, I_SSMN, I_WPOOL, I_PSCALE, I_WOUT,
       I_GMEM, I_WMK, I_WMV, I_GXQ, I_WXQ, I_WXO, I_GFFN2, I_W2G, I_W2U, I_W2D, I_GFIN };
#define WSP(T, off) ((T*)(F.ws + (off)))

__device__ __forceinline__ void p0_transpose_item(const float* W, int ldw, int N, bf16* WT, int ldt, int kdst, int rowmode, int row_off, const float* gain, float scale, LAS float* scr, int item, int lane) {
    const int nblk = N / 32, kb = item / nblk, nb = item % nblk, k0 = 64 * kb, n0 = 32 * nb;
    { const int kq = lane >> 3, nq = lane & 7; f32x4 v[8];
#pragma unroll
        for (int i = 0; i < 8; ++i) v[i] = *(const f32x4*)(W + (size_t)(k0 + 8 * i + kq) * ldw + n0 + 4 * nq);
#pragma unroll
        for (int i = 0; i < 8; ++i) { const int kk = 8 * i + kq; const float gsc = (gain ? gain[k0 + kk] : 1.0f) * scale; LAS float* d = scr + kk * 33 + 4 * nq; d[0] = v[i].x * gsc; d[1] = v[i].y * gsc; d[2] = v[i].z * gsc; d[3] = v[i].w * gsc; } }
    LDS_WAIT(); asm volatile("" ::: "memory");
    const int rowf = rowmode == 0 ? row_off + n0 : (n0 >> 7) * 256 + (rowmode == 2 ? 128 : 0) + (n0 & 127);
    const int c = lane & 7;
#pragma unroll
    for (int j = 0; j < 4; ++j) { const int n = (lane >> 3) + 8 * j; const LAS float* s = scr + (8 * c) * 33 + n;
        v4u o; o.x = pk2(s[0 * 33], s[1 * 33]); o.y = pk2(s[2 * 33], s[3 * 33]); o.z = pk2(s[4 * 33], s[5 * 33]); o.w = pk2(s[6 * 33], s[7 * 33]);
        *(GAS v4u*)(WT + (size_t)(rowf + n) * ldt + kdst + k0 + 8 * c) = o; }
    LDS_WAIT(); asm volatile("" ::: "memory");
}
__device__ __forceinline__ void row_to_bf16_ssq(const float* xrow, bf16* orow, float* ssq16, int lane) {
    const GAS f32x4* xr = (const GAS f32x4*)xrow + lane;
    f32x4 v[4]; float s = 0.f;
#pragma unroll
    for (int j = 0; j < 4; ++j) { v[j] = xr[64 * j]; s += (v[j].x * v[j].x + v[j].y * v[j].y) + (v[j].z * v[j].z + v[j].w * v[j].w); }
    s = wave_sum(s);
    GAS unsigned long long* o8 = (GAS unsigned long long*)orow + lane;
#pragma unroll
    for (int j = 0; j < 4; ++j) o8[64 * j] = (unsigned long long)pk2(v[j].x, v[j].y) | ((unsigned long long)pk2(v[j].z, v[j].w) << 32);
    if (lane < 16) ssq16[lane] = lane == 0 ? s : 0.f;
}
__device__ __forceinline__ void p0_prologue(Frame& F) {
    LAS float* scr = (LAS float*)(F.lds + RING_OFF + F.wave * 16384);
    const int gw = F.bid * NWAVES + F.wave, NGW = F.G * NWAVES, lane = F.lane;
    constexpr int I_GU = (D / 64) * (FF / 32), I_DN = (FF / 64) * (D / 32), I_IN = (D / 64) * (NIN / 32), I_OUT = (D_SSM / 64) * (D / 32), I_SQ = (D / 64) * (D / 32);
    constexpr int NT = 4 * I_GU + 2 * I_DN + I_IN + I_OUT + 4 * I_SQ;
    for (int it = gw; it < NT; it += NGW) {
        int r = it;
        if (r < I_GU) { p0_transpose_item(INP(I_W1G), FF, FF, WSP(bf16, WS_W1GU), D, 0, 1, 0, INP(I_GFFN1), 1.f, scr, r, lane); continue; } r -= I_GU;
        if (r < I_GU) { p0_transpose_item(INP(I_W1U), FF, FF, WSP(bf16, WS_W1GU), D, 0, 2, 0, INP(I_GFFN1), 1.f, scr, r, lane); continue; } r -= I_GU;
        if (r < I_GU) { p0_transpose_item(INP(I_W2G), FF, FF, WSP(bf16, WS_W2GU), D, 0, 1, 0, INP(I_GFFN2), 1.f, scr, r, lane); continue; } r -= I_GU;
        if (r < I_GU) { p0_transpose_item(INP(I_W2U), FF, FF, WSP(bf16, WS_W2GU), D, 0, 2, 0, INP(I_GFFN2), 1.f, scr, r, lane); continue; } r -= I_GU;
        if (r < I_DN) { p0_transpose_item(INP(I_W1D), D, D, WSP(bf16, WS_W1D), FF, 0, 0, 0, nullptr, 1.f, scr, r, lane); continue; } r -= I_DN;
        if (r < I_DN) { p0_transpose_item(INP(I_W2D), D, D, WSP(bf16, WS_W2D), FF, 0, 0, 0, nullptr, 1.f, scr, r, lane); continue; } r -= I_DN;
        if (r < I_IN) { p0_transpose_item(INP(I_WIN), D_INP, NIN, WSP(bf16, WS_WIN), D, 0, 0, 0, INP(I_GMIX), 1.f, scr, r, lane); continue; } r -= I_IN;
        if (r < I_OUT) { p0_transpose_item(INP(I_WOUT) + (size_t)D_POOL * D, D, D, WSP(bf16, WS_WOUT), D, D_POOL, 0, 0, INP(I_SSMN), 1.f, scr, r, lane); continue; } r -= I_OUT;
        if (r < I_SQ) { p0_transpose_item(INP(I_WXQ), D, D, WSP(bf16, WS_WQ), D, 0, 0, 0, INP(I_GXQ), 0.0625f, scr, r, lane); continue; } r -= I_SQ;
        if (r < I_SQ) { p0_transpose_item(INP(I_WXO), D, D, WSP(bf16, WS_WO), D, 0, 0, 0, nullptr, 1.f, scr, r, lane); continue; } r -= I_SQ;
        if (r < I_SQ) { p0_transpose_item(INP(I_WMK), D, D, WSP(bf16, WS_WMKV), D, 0, 0, 0, INP(I_GMEM), 1.f, scr, r, lane); continue; } r -= I_SQ;
        p0_transpose_item(INP(I_WMV), D, D, WSP(bf16, WS_WMKV), D, 0, 0, D, INP(I_GMEM), 1.f, scr, r, lane);
    }
    { const float* wp = INP(I_WPOOL); const float* ps = INP(I_PSCALE); const float* wo = INP(I_WOUT); bf16* WT = WSP(bf16, WS_WOUT);
        for (int it = gw; it < D; it += NGW) { const int n4 = (it >> 2) * 4, g = it & 3; f32x4 acc = (f32x4){0.f, 0.f, 0.f, 0.f}; const f32x4* wrow = (const f32x4*)(wp + (size_t)(g * 64 + lane) * 64);
#pragma unroll 4
            for (int d4 = 0; d4 < 16; ++d4) { const f32x4 wv = wrow[d4]; const f32x4 pv = *(const f32x4*)(ps + g * 64 + 4 * d4);
#pragma unroll
                for (int j = 0; j < 4; ++j) { const f32x4 o = *(const f32x4*)(wo + (size_t)(g * 64 + 4 * d4 + j) * D + n4); acc += o * (wv[j] * pv[j]); } }
#pragma unroll
            for (int j = 0; j < 4; ++j) WT[(size_t)(n4 + j) * D + g * 64 + lane] = (bf16)f2bf(acc[j]); } }
    { bf16* wt = WSP(bf16, WS_WIN); const float* win = INP(I_WIN); const float* gm = INP(I_GMIX);
        for (int i = F.bid * NTHREADS + F.tid; i < NH * D; i += F.G * NTHREADS) { const int h = i >> 10, k = i & 1023; wt[(size_t)(NIN + h) * D + k] = (bf16)f2bf(gm[k] * win[(size_t)k * D_INP + NIN + h]); }
        v4u* z = (v4u*)(wt + (size_t)(NIN + NH) * D);
        for (int i = F.bid * NTHREADS + F.tid; i < (256 - NH) * D / 8; i += F.G * NTHREADS) z[i] = (v4u){0u, 0u, 0u, 0u}; }
    { const float* xp = INP(I_XP); const float* xs = INP(I_XS);
        for (int m = gw; m < M; m += NGW) { const float* xr = m < MP ? xp + (size_t)m * D : xs + (size_t)(m - MP) * D; row_to_bf16_ssq(xr, WSP(bf16, WS_XB) + (size_t)m * D, WSP(float, WS_SSQ0) + (size_t)m * 16, lane); } }
    for (int m = gw; m < MEMROWS; m += NGW) row_to_bf16_ssq(INP(I_MEMP) + (size_t)m * D, WSP(bf16, WS_MBF) + (size_t)m * D, WSP(float, WS_SSQM) + (size_t)m * 16, lane);
}

constexpr int MX_PITCHB = 272;
constexpr int MX_TILE = 128 * MX_PITCHB;
constexpr int MX_RC = 0, MX_RB = MX_TILE, MX_RBT = 2 * MX_TILE, MX_X1 = 3 * MX_TILE, MX_DT = 4 * MX_TILE, MX_ACS = MX_DT + 3072, MX_DE = MX_ACS + 3072, MX_END = MX_DE + 3072;
static_assert(MX_END <= RING_BYTES, "mix LDS map");

__device__ __forceinline__ void conv_load(const bf16* PROJ, const float* cw, const float* cb, size_t rowbase, int t0, int l0, int col, int cx, unsigned short (&in)[19], float (&wt)[5]) {
#pragma unroll
    for (int i = 0; i < 19; ++i) { const int t = t0 + l0 - 3 + i; const int tt = t < 0 ? 0 : t; const unsigned short x = PROJ[(unsigned)((int)rowbase + tt) * (unsigned)NIN + (unsigned)col]; in[i] = t < 0 ? (unsigned short)0 : x; }
    wt[0] = cw[cx]; wt[1] = cw[CONV_DIM + cx]; wt[2] = cw[2 * CONV_DIM + cx]; wt[3] = cw[3 * CONV_DIM + cx]; wt[4] = cb[cx];
}
__device__ __forceinline__ void conv_eval(const unsigned short (&in)[19], const float (&wt)[5], float (&v)[16]) {
    float f[19];
#pragma unroll
    for (int i = 0; i < 19; ++i) f[i] = bf2f(in[i]);
#pragma unroll
    for (int j = 0; j < 16; ++j) v[j] = siluf(f[j] * wt[0] + f[j + 1] * wt[1] + f[j + 2] * wt[2] + f[j + 3] * wt[3] + wt[4]);
}
template <int W> __device__ __forceinline__ void pool_prompt_chunk(const bf16* PROJ, bf16* A2, float* outp, int b, int t0, int l0, int ucol, bool last_chunk) {
    const size_t rowbase = (size_t)b * SEQ;
    float v[31 + W];
#pragma unroll
    for (int i = 0; i < 31 + W; ++i) { const int t = t0 + l0 - (W - 1) + i; const int tt = t < 0 ? 0 : t; const float x = bf2f(PROJ[(unsigned)((int)rowbase + tt) * (unsigned)NIN + (unsigned)ucol]); v[i] = t < 0 ? 0.f : x; }
#pragma unroll
    for (int i = 0; i < 32; ++i) { float s = 0.f;
#pragma unroll
        for (int j = 0; j < W; ++j) s += v[i + j];
        const int t = t0 + l0 + i; const float cnt = (float)(t + 1 < W ? t + 1 : W);
        const float u = v[i + W - 1], p = s / cnt - u;
        A2[(rowbase + t) * D + ucol] = (bf16)f2bf(p);
        if (last_chunk && t >= SEQ - 15) outp[((size_t)b * 15 + (t - (SEQ - 15))) * D_POOL + ucol] = u; }
}
__device__ __forceinline__ v4u pack8(const float* v) { v4u o; o.x = pk2(v[0], v[1]); o.y = pk2(v[2], v[3]); o.z = pk2(v[4], v[5]); o.w = pk2(v[6], v[7]); return o; }

__device__ __forceinline__ void mix_prompt_item(Frame& F, int b, int c, int g) {
    const int tid = F.tid, lane = F.lane, w = F.wave, fr = lane & 15, fq = lane >> 4;
    const int t0 = c * CHUNK; const size_t rowbase = (size_t)b * SEQ, row0 = rowbase + t0;
    const bf16* PROJ = WSP(const bf16, WS_PROJ); const float* DTR = WSP(const float, WS_DTR);
    float* EXPA = WSP(float, WS_EXPA); float* CDp = WSP(float, WS_CD); bf16* CB = WSP(bf16, WS_CB); float* YD = WSP(float, WS_YD); float* ST = WSP(float, WS_ST); bf16* A2 = WSP(bf16, WS_A2);
    const float* cw = INP(I_CONVW); const float* cbias = INP(I_CONVB);
    LAS float* dtL = (LAS float*)(F.lds + MX_DT); LAS float* acsL = (LAS float*)(F.lds + MX_ACS); LAS float* deL = (LAS float*)(F.lds + MX_DE);
    LAS unsigned char* lds = F.lds;
    const bool lastc = (c == NCH - 1);
    const int cn = tid & 63, lc = tid >> 6, l0 = 16 * lc;
    unsigned short inA[19], inB[19]; float wtA[5], wtB[5];
    { const float* dtb = INP(I_DTB);
        for (int idx = tid; idx < 6 * 128; idx += NTHREADS) { const int hl = idx >> 7, l = idx & 127; dtL[idx] = softplusf(DTR[(row0 + l) * NH + 6 * g + hl] + dtb[6 * g + hl]); } }
    conv_load(PROJ, cw, cbias, rowbase, t0, l0, XBC0 + D_SSM + g * 128 + cn, D_SSM + g * 128 + cn, inA, wtA);
    WG_BAR();
    if (w < 6) { const int h = 6 * g + w; const float a = -__expf(INP(I_ALOG)[h]);
        const float d0 = dtL[w * 128 + 2 * lane], d1 = dtL[w * 128 + 2 * lane + 1]; const float v0 = d0 * a, v1 = d1 * a; float s = v0 + v1;
#pragma unroll
        for (int o = 1; o < 64; o <<= 1) { const float t = __shfl_up(s, o); if (lane >= o) s += t; }
        const float a0 = s - v1, a1 = s, last = __shfl(s, 63);
        acsL[w * 128 + 2 * lane] = a0; acsL[w * 128 + 2 * lane + 1] = a1;
        deL[w * 128 + 2 * lane] = __expf(last - a0) * d0; deL[w * 128 + 2 * lane + 1] = __expf(last - a1) * d1;
        EXPA[(row0 + 2 * lane) * NH + h] = __expf(a0); EXPA[(row0 + 2 * lane + 1) * NH + h] = __expf(a1);
        if (lane == 63) CDp[((size_t)b * NCH + c) * NH + h] = __expf(last); }
#pragma unroll
    for (int rd = 0; rd < 4; ++rd) { const int isC = rd >> 1, hf = rd & 1, cx0 = D_SSM + isC * 256 + g * 128 + hf * 64;
        unsigned short (&cur)[19] = (rd & 1) ? inB : inA; float (&cwt)[5] = (rd & 1) ? wtB : wtA; unsigned short (&nxt)[19] = (rd & 1) ? inA : inB; float (&nwt)[5] = (rd & 1) ? wtA : wtB;
        if (rd < 3) { const int nx0 = D_SSM + ((rd + 1) >> 1) * 256 + g * 128 + ((rd + 1) & 1) * 64; conv_load(PROJ, cw, cbias, rowbase, t0, l0, XBC0 + nx0 + cn, nx0 + cn, nxt, nwt); }
        else conv_load(PROJ, cw, cbias, rowbase, t0, l0, XBC0 + (6 * g) * 64 + cn, (6 * g) * 64 + cn, nxt, nwt);
        float v[16]; conv_eval(cur, cwt, v); const int n = hf * 64 + cn;
        if (!isC) {
#pragma unroll
            for (int j = 0; j < 16; ++j) *(LAS unsigned short*)(lds + MX_RB + (l0 + j) * MX_PITCHB + n * 2) = (unsigned short)f2bf(v[j]);
            *(LAS v4u*)(lds + MX_RBT + n * MX_PITCHB + l0 * 2) = pack8(v); *(LAS v4u*)(lds + MX_RBT + n * MX_PITCHB + l0 * 2 + 16) = pack8(v + 8);
        } else {
#pragma unroll
            for (int j = 0; j < 16; ++j) { const unsigned short q = (unsigned short)f2bf(v[j]); *(LAS unsigned short*)(lds + MX_RC + (l0 + j) * MX_PITCHB + n * 2) = q; CB[(row0 + l0 + j) * 256 + g * 128 + n] = q; }
        }
        if (lastc && lc == 7) {
#pragma unroll
            for (int j = 0; j < 3; ++j) F.out[OUT_CONVP + ((size_t)b * 3 + j) * CONV_DIM + cx0 + cn] = bf2f(cur[16 + j]); }
        __builtin_amdgcn_sched_barrier(0); }
    WG_BAR();
    f32x4 sc[8];
    { bf16x8 cf[4];
#pragma unroll
        for (int ks = 0; ks < 4; ++ks) cf[ks] = *(const LAS bf16x8*)(lds + MX_RC + (16 * w + fr) * MX_PITCHB + (32 * ks + 8 * fq) * 2);
#pragma unroll
        for (int sb = 0; sb < 8; ++sb) { f32x4 a = (f32x4){0.f, 0.f, 0.f, 0.f};
#pragma unroll
            for (int ks = 0; ks < 4; ++ks) { const bf16x8 bf_ = *(const LAS bf16x8*)(lds + MX_RB + (16 * sb + fr) * MX_PITCHB + (32 * ks + 8 * fq) * 2); a = MFMA16(bf_, cf[ks], a); }
            sc[sb] = a; __builtin_amdgcn_sched_barrier(0); } }
    WG_BAR();
    for (int i = lane; i < 256; i += 64) *(LAS v4u*)(lds + MX_RC + (16 * w + (i >> 4)) * MX_PITCHB + (i & 15) * 16) = (v4u){0u, 0u, 0u, 0u};
    for (int hl = 0; hl < 6; ++hl) { const int h = 6 * g + hl; const int xb = (hl & 1) ? MX_X1 : MX_RB;
        if (hl > 0) conv_load(PROJ, cw, cbias, rowbase, t0, l0, XBC0 + h * 64 + cn, h * 64 + cn, inA, wtA);
        { float v[16]; conv_eval(inA, wtA, v);
            *(LAS v4u*)(lds + xb + cn * MX_PITCHB + l0 * 2) = pack8(v); *(LAS v4u*)(lds + xb + cn * MX_PITCHB + l0 * 2 + 16) = pack8(v + 8);
            float vd[16];
#pragma unroll
            for (int j = 0; j < 16; ++j) vd[j] = v[j] * deL[hl * 128 + l0 + j];
            *(LAS v4u*)(lds + xb + (64 + cn) * MX_PITCHB + l0 * 2) = pack8(vd); *(LAS v4u*)(lds + xb + (64 + cn) * MX_PITCHB + l0 * 2 + 16) = pack8(vd + 8);
            if (lastc && lc == 7) {
#pragma unroll
                for (int j = 0; j < 3; ++j) F.out[OUT_CONVP + ((size_t)b * 3 + j) * CONV_DIM + h * 64 + cn] = bf2f(inA[16 + j]); } }
        __builtin_amdgcn_sched_barrier(0);
        { const int l = 16 * w + fr; const float al = acsL[hl * 128 + l];
#pragma unroll
            for (int sb = 0; sb < 8; ++sb) if (sb <= w) { const int s0 = 16 * sb + 4 * fq; const f32x4 as = *(const LAS f32x4*)(acsL + hl * 128 + s0), ds = *(const LAS f32x4*)(dtL + hl * 128 + s0);
                float o[4];
#pragma unroll
                for (int r = 0; r < 4; ++r) o[r] = (s0 + r <= l) ? sc[sb][r] * __expf(fminf(al - as[r], 0.f)) * ds[r] : 0.f;
                v2u pw; pw.x = pk2(o[0], o[1]); pw.y = pk2(o[2], o[3]); *(LAS v2u*)(lds + MX_RC + l * MX_PITCHB + s0 * 2) = pw; } }
        WG_BAR();
        __builtin_amdgcn_sched_barrier(0);
        { f32x4 ya[4];
#pragma unroll
            for (int pb = 0; pb < 4; ++pb) ya[pb] = (f32x4){0.f, 0.f, 0.f, 0.f};
#pragma unroll
            for (int ks = 0; ks < 4; ++ks) if (32 * ks <= 16 * w + 15) { const bf16x8 wf = *(const LAS bf16x8*)(lds + MX_RC + (16 * w + fr) * MX_PITCHB + (32 * ks + 8 * fq) * 2);
#pragma unroll
                for (int pb = 0; pb < 4; ++pb) { const bf16x8 xf = *(const LAS bf16x8*)(lds + xb + (16 * pb + fr) * MX_PITCHB + (32 * ks + 8 * fq) * 2); ya[pb] = MFMA16(xf, wf, ya[pb]); }
                __builtin_amdgcn_sched_barrier(0); }
            const float dsk = INP(I_DSKIP)[h]; const int l = 16 * w + fr;
#pragma unroll
            for (int pb = 0; pb < 4; ++pb) { f32x4 o;
#pragma unroll
                for (int r = 0; r < 4; ++r) { const int p = 16 * pb + 4 * fq + r; o[r] = ya[pb][r] + dsk * bf2f(*(const LAS unsigned short*)(lds + xb + p * MX_PITCHB + l * 2)); }
                *(f32x4*)(YD + (row0 + l) * D_SSM + h * 64 + 16 * pb + 4 * fq) = o; } }
        __builtin_amdgcn_sched_barrier(0);
        { f32x4 sa[4];
#pragma unroll
            for (int pb = 0; pb < 4; ++pb) sa[pb] = (f32x4){0.f, 0.f, 0.f, 0.f};
#pragma unroll
            for (int ks = 0; ks < 4; ++ks) { const bf16x8 bf_ = *(const LAS bf16x8*)(lds + MX_RBT + (16 * w + fr) * MX_PITCHB + (32 * ks + 8 * fq) * 2);
#pragma unroll
                for (int pb = 0; pb < 4; ++pb) { const bf16x8 xf = *(const LAS bf16x8*)(lds + xb + (64 + 16 * pb + fr) * MX_PITCHB + (32 * ks + 8 * fq) * 2); sa[pb] = MFMA16(bf_, xf, sa[pb]); }
                __builtin_amdgcn_sched_barrier(0); }
#pragma unroll
            for (int pb = 0; pb < 4; ++pb) *(f32x4*)(ST + ((((size_t)b * NCH + c) * NH + h) * HD + 16 * pb + fr) * NST + 16 * w + 4 * fq) = sa[pb]; }
 }
    { const int cc = tid & 127, lq = tid >> 7, ucol = g * 128 + cc; const int grp = __builtin_amdgcn_readfirstlane(ucol >> 6);
        float* outp = F.out + OUT_POOLP;
        if (grp == 0) pool_prompt_chunk<2>(PROJ, A2, outp, b, t0, 32 * lq, ucol, lastc);
        else if (grp == 1) pool_prompt_chunk<4>(PROJ, A2, outp, b, t0, 32 * lq, ucol, lastc);
        else if (grp == 2) pool_prompt_chunk<8>(PROJ, A2, outp, b, t0, 32 * lq, ucol, lastc);
        else pool_prompt_chunk<16>(PROJ, A2, outp, b, t0, 32 * lq, ucol, lastc); }
    WG_BAR();
}

constexpr int SM_XS = 0, SM_BM = 6144, SM_CM = 8192, SM_G = 10240, SM_DT = 16384, SM_ACS = SM_DT + 96, SM_DE = SM_ACS + 96, SM_EA = SM_DE + 96, SM_CD = SM_EA + 96, SM_SC = SM_CD + 32, SM_SSQ = SM_SC + 64;
constexpr int XSG = D_SSM / 2;
template <int W> __device__ __forceinline__ void pool_sample4(const float* sp, const bf16* PROJ, float* outp, int b, size_t r0, int c, float (&p)[4]) {
    float v[19];
#pragma unroll
    for (int i = 0; i < 15; ++i) v[i] = sp[((size_t)b * 15 + i) * D_POOL + c];
#pragma unroll
    for (int t = 0; t < 4; ++t) v[15 + t] = bf2f(PROJ[(r0 + t) * NIN + c]);
#pragma unroll
    for (int t = 0; t < 4; ++t) { float s = 0.f;
#pragma unroll
        for (int j = 0; j < W; ++j) s += v[15 + t - (W - 1) + j];
        p[t] = s * (1.0f / W) - v[15 + t]; }
#pragma unroll
    for (int i = 0; i < 15; ++i) outp[((size_t)b * 15 + i) * D_POOL + c] = v[4 + i];
}
__device__ __forceinline__ void mix_sample_item(Frame& F, int b, int g) {
    const int tid = F.tid, lane = F.lane, w = F.wave, fr = lane & 15, fq = lane >> 4; const size_t r0 = (size_t)MP + 4 * b;
    const bf16* PROJ = WSP(const bf16, WS_PROJ); const float* DTR = WSP(const float, WS_DTR);
    bf16* A2 = WSP(bf16, WS_A2); float* SSQY = WSP(float, WS_SSQY);
    LAS unsigned char* lds = F.lds;
    LAS float* xsL = (LAS float*)(lds + SM_XS); LAS float* BmL = (LAS float*)(lds + SM_BM); LAS float* CmL = (LAS float*)(lds + SM_CM); LAS float* gL = (LAS float*)(lds + SM_G);
    LAS float* dtS = (LAS float*)(lds + SM_DT); LAS float* acsS = (LAS float*)(lds + SM_ACS); LAS float* deS = (LAS float*)(lds + SM_DE); LAS float* eaS = (LAS float*)(lds + SM_EA);
    LAS float* cdS = (LAS float*)(lds + SM_CD); LAS float* scS = (LAS float*)(lds + SM_SC); LAS float* ssqS = (LAS float*)(lds + SM_SSQ);
    { const float* scv = INP(I_SCONV); const float* cw = INP(I_CONVW); const float* cbias = INP(I_CONVB);
        for (int j = tid; j < XSG + 256; j += NTHREADS) { const int cx = j < XSG ? g * XSG + j : (j < XSG + 128 ? D_SSM + g * 128 + (j - XSG) : D_SSM + 256 + g * 128 + (j - XSG - 128)); float e[7];
#pragma unroll
            for (int i = 0; i < 3; ++i) e[i] = scv[((size_t)b * 3 + i) * CONV_DIM + cx];
#pragma unroll
            for (int t = 0; t < 4; ++t) e[3 + t] = bf2f(PROJ[(r0 + t) * NIN + XBC0 + cx]);
            const float w0 = cw[cx], w1 = cw[CONV_DIM + cx], w2 = cw[2 * CONV_DIM + cx], w3 = cw[3 * CONV_DIM + cx], bb = cbias[cx];
#pragma unroll
            for (int t = 0; t < 4; ++t) { const float o = siluf(e[t] * w0 + e[t + 1] * w1 + e[t + 2] * w2 + e[t + 3] * w3 + bb);
                if (j < XSG) xsL[t * XSG + j] = o; else if (j < XSG + 128) BmL[t * 128 + j - XSG] = o; else CmL[t * 128 + j - XSG - 128] = o; }
#pragma unroll
            for (int jj = 0; jj < 3; ++jj) F.out[OUT_CONVS + ((size_t)b * 3 + jj) * CONV_DIM + cx] = e[4 + jj]; } }
    float pp[4] = {0.f, 0.f, 0.f, 0.f};
    if (tid < 128) { const int ucol = g * 128 + tid; const int grp = __builtin_amdgcn_readfirstlane(ucol >> 6); const float* sp = INP(I_SPOOL); float* outp = F.out + OUT_POOLS;
        if (grp == 0) pool_sample4<2>(sp, PROJ, outp, b, r0, ucol, pp); else if (grp == 1) pool_sample4<4>(sp, PROJ, outp, b, r0, ucol, pp);
        else if (grp == 2) pool_sample4<8>(sp, PROJ, outp, b, r0, ucol, pp); else pool_sample4<16>(sp, PROJ, outp, b, r0, ucol, pp); }
    else if (tid >= 256 && tid < 280) { const int i = tid - 256, t = i / 6, hl = i - 6 * t; dtS[t * 6 + hl] = softplusf(DTR[(r0 + t) * NH + 6 * g + hl] + INP(I_DTB)[6 * g + hl]); }
    WG_BAR();
    if (tid < 6) { const int h = 6 * g + tid; const float a = -__expf(INP(I_ALOG)[h]); float acc = 0.f, ac[4];
#pragma unroll
        for (int t = 0; t < 4; ++t) { acc += dtS[t * 6 + tid] * a; ac[t] = acc; acsS[t * 6 + tid] = acc; }
#pragma unroll
        for (int t = 0; t < 4; ++t) { deS[t * 6 + tid] = __expf(acc - ac[t]) * dtS[t * 6 + tid]; eaS[t * 6 + tid] = __expf(ac[t]); }
        cdS[tid] = __expf(acc); }
#pragma unroll
    for (int k = 0; k < 2; ++k) { const int idx = 2 * w + k, l = idx >> 2, s = idx & 3;
        float v = CmL[l * 128 + lane] * BmL[s * 128 + lane] + CmL[l * 128 + 64 + lane] * BmL[s * 128 + 64 + lane];
        v = wave_sum(v); if (lane == 0) scS[idx] = v; }
    WG_BAR();
    { const float* h0 = INP(I_SSSM); float* hout = F.out + OUT_SSMS;
        bf16x8 cf[4];
#pragma unroll
        for (int ks = 0; ks < 4; ++ks) { v4u q = (v4u){0u, 0u, 0u, 0u};
            if (fr < 4) { const LAS float* cp = CmL + fr * 128 + 32 * ks + 8 * fq; q.x = pk2(cp[0], cp[1]); q.y = pk2(cp[2], cp[3]); q.z = pk2(cp[4], cp[5]); q.w = pk2(cp[6], cp[7]); }
            cf[ks] = __builtin_bit_cast(bf16x8, q); }
#pragma unroll
        for (int i = 0; i < 3; ++i) { const int blk = 3 * w + i, hl = blk >> 2, pb = blk & 3, h = 6 * g + hl, p = 16 * pb + fr;
            const float cdh = cdS[hl]; float cx[4];
#pragma unroll
            for (int l = 0; l < 4; ++l) cx[l] = deS[l * 6 + hl] * xsL[l * XSG + hl * 64 + p];
            f32x4 acc = (f32x4){0.f, 0.f, 0.f, 0.f};
#pragma unroll
            for (int ks = 0; ks < 4; ++ks) { const int n0 = 32 * ks + 8 * fq; const size_t off = (((size_t)b * NH + h) * HD + p) * NST + n0;
                const f32x4 a0 = *(const f32x4*)(h0 + off), a1 = *(const f32x4*)(h0 + off + 4);
                v4u q; q.x = pk2(a0.x, a0.y); q.y = pk2(a0.z, a0.w); q.z = pk2(a1.x, a1.y); q.w = pk2(a1.z, a1.w);
                acc = MFMA16(__builtin_bit_cast(bf16x8, q), cf[ks], acc);
                f32x4 o0 = a0 * cdh, o1 = a1 * cdh;
#pragma unroll
                for (int l = 0; l < 4; ++l) { const f32x4 b0 = *(const LAS f32x4*)(BmL + l * 128 + n0), b1 = *(const LAS f32x4*)(BmL + l * 128 + n0 + 4); o0 += b0 * cx[l]; o1 += b1 * cx[l]; }
                *(f32x4*)(hout + off) = o0; *(f32x4*)(hout + off + 4) = o1; }
            if (fr < 4) { const int l = fr; const float eal = eaS[l * 6 + hl], dsk = INP(I_DSKIP)[h], al = acsS[l * 6 + hl];
#pragma unroll
                for (int r = 0; r < 4; ++r) { const int pc = hl * 64 + 16 * pb + 4 * fq + r; float y = eal * acc[r] + dsk * xsL[l * XSG + pc];
#pragma unroll
                    for (int s = 0; s < 4; ++s) if (s <= l) y += scS[l * 4 + s] * __expf(al - acsS[s * 6 + hl]) * dtS[s * 6 + hl] * xsL[s * XSG + pc];
                    const float z = bf2f(PROJ[(r0 + l) * NIN + D_POOL + g * XSG + pc]); gL[l * XSG + pc] = y * siluf(z); } } } }
    WG_BAR();
    if (w < 4) { float s = 0.f;
#pragma unroll
        for (int j = 0; j < 6; ++j) { const float v = gL[w * XSG + lane + 64 * j]; s += v * v; }
        s = wave_sum(s); if (lane == 0) ssqS[w] = s; }
    WG_BAR();
#pragma unroll
    for (int t = 0; t < 4; ++t) {
        if (tid < XSG) A2[(r0 + t) * D + D_POOL + g * XSG + tid] = (bf16)f2bf(gL[t * XSG + tid]);
        if (tid < 128) A2[(r0 + t) * D + g * 128 + tid] = (bf16)f2bf(pp[t]);
        if (g == 0) { if (tid < 16 && tid != 1) SSQY[(r0 + t) * 16 + tid] = tid == 0 ? ssqS[t] * (1024.0f / D_SSM) : 0.f; }
        else if (tid == 1) SSQY[(r0 + t) * 16 + 1] = ssqS[t] * (1024.0f / D_SSM); }
    WG_BAR();
}

__device__ __forceinline__ void scan_phase(Frame& F) {
    const float* ST = WSP(const float, WS_ST); const float* CDp = WSP(const float, WS_CD); bf16* HP = WSP(bf16, WS_HP); float* outp = F.out + OUT_SSMP;
    constexpr size_t CS = (size_t)NH * HD * NST;
    for (int idx = F.bid * NTHREADS + F.tid; idx < BATCH * NH * HD * (NST / 4); idx += F.G * NTHREADS) { const int n4 = idx & 31, p = (idx >> 5) & 63, bh = idx >> 11, h = bh % NH, b = bh / NH;
        const size_t base = ((((size_t)b * NCH) * NH + h) * HD + p) * NST + 4 * n4;
        f32x4 st[NCH];
#pragma unroll
        for (int c = 0; c < NCH; ++c) st[c] = *(const f32x4*)(ST + base + c * CS);
        f32x4 run = (f32x4){0.f, 0.f, 0.f, 0.f};
#pragma unroll
        for (int c = 0; c < NCH; ++c) { v2u q; q.x = pk2(run.x, run.y); q.y = pk2(run.z, run.w); *(v2u*)(HP + base + c * CS) = q; run = run * CDp[((size_t)b * NCH + c) * NH + h] + st[c]; }
        *(f32x4*)(outp + (((size_t)b * NH + h) * HD + p) * NST + 4 * n4) = run; }
}

__device__ __forceinline__ void mixc_item(Frame& F, int b, int c, int hf) {
    const int tid = F.tid, lane = F.lane, w = F.wave, fr = lane & 15, fq = lane >> 4, lb = w & 3, grp = w >> 2;
    const bf16* PROJ = WSP(const bf16, WS_PROJ); const float* EXPA = WSP(const float, WS_EXPA); const bf16* CB = WSP(const bf16, WS_CB); const float* YD = WSP(const float, WS_YD); const bf16* HP = WSP(const bf16, WS_HP);
    bf16* A2 = WSP(bf16, WS_A2); float* SSQY = WSP(float, WS_SSQY);
    LAS float* ssqL = (LAS float*)(F.lds);
    const size_t rowb = (size_t)b * SEQ + c * CHUNK + 64 * hf; const size_t row = rowb + 16 * lb + fr;
    bf16x8 cf[4];
#pragma unroll
    for (int ks = 0; ks < 4; ++ks) cf[ks] = *(const bf16x8*)(CB + row * 256 + grp * 128 + 32 * ks + 8 * fq);
    float ssq = 0.f;
    for (int hl = 0; hl < 6; ++hl) { const int h = 6 * grp + hl; const float ea = EXPA[row * NH + h]; const bf16* hp = HP + ((((size_t)b * NCH + c) * NH + h) * HD) * NST;
#pragma unroll
        for (int pb = 0; pb < 4; ++pb) { f32x4 acc = (f32x4){0.f, 0.f, 0.f, 0.f};
#pragma unroll
            for (int ks = 0; ks < 4; ++ks) { const bf16x8 af = *(const bf16x8*)(hp + (size_t)(16 * pb + fr) * NST + 32 * ks + 8 * fq); acc = MFMA16(af, cf[ks], acc); }
            const int p0 = h * 64 + 16 * pb + 4 * fq; const f32x4 yd = *(const f32x4*)(YD + row * D_SSM + p0); const v2u zz = *(const v2u*)(PROJ + row * NIN + D_POOL + p0);
            const float g0 = (yd[0] + ea * acc[0]) * siluf(bflo(zz.x)), g1 = (yd[1] + ea * acc[1]) * siluf(bfhi(zz.x)), g2 = (yd[2] + ea * acc[2]) * siluf(bflo(zz.y)), g3 = (yd[3] + ea * acc[3]) * siluf(bfhi(zz.y));
            ssq += (g0 * g0 + g1 * g1) + (g2 * g2 + g3 * g3);
            v2u q; q.x = pk2(g0, g1); q.y = pk2(g2, g3); *(v2u*)(A2 + row * D + D_POOL + p0) = q; } }
    ssq += __shfl_xor(ssq, 16); ssq += __shfl_xor(ssq, 32);
    if (fq == 0) ssqL[grp * 64 + 16 * lb + fr] = ssq;
    WG_BAR();
    { const int rl = tid >> 3, seg = tid & 7; const float tot = ssqL[rl] + ssqL[64 + rl]; const float rsinv = sqrtf(tot * (1.0f / D_SSM) + EPS); const size_t r = rowb + rl;
#pragma unroll
        for (int i = 0; i < 4; ++i) { v4u q = *(const v4u*)(A2 + r * D + seg * 32 + 8 * i);
            q.x = pk2(bflo(q.x) * rsinv, bfhi(q.x) * rsinv); q.y = pk2(bflo(q.y) * rsinv, bfhi(q.y) * rsinv); q.z = pk2(bflo(q.z) * rsinv, bfhi(q.z) * rsinv); q.w = pk2(bflo(q.w) * rsinv, bfhi(q.w) * rsinv);
            *(v4u*)(A2 + r * D + seg * 32 + 8 * i) = q; }
        if (seg < 4) *(f32x4*)(SSQY + r * 16 + 4 * seg) = (f32x4){seg == 0 ? tot * (1024.0f / D_SSM) : 0.f, 0.f, 0.f, 0.f}; }
    WG_BAR();
}

__device__ __forceinline__ void sample_pool_rescale(Frame& F, int it) {
    const int rl = F.tid >> 3, seg = F.tid & 7; const size_t r = (size_t)MP + 64 * it + rl; bf16* A2 = WSP(bf16, WS_A2); const float* SSQY = WSP(const float, WS_SSQY);
    const float tot = (SSQY[r * 16] + SSQY[r * 16 + 1]) * (D_SSM / 1024.0f); const float rsinv = sqrtf(tot * (1.0f / D_SSM) + EPS);
#pragma unroll
    for (int i = 0; i < 4; ++i) { v4u q = *(const v4u*)(A2 + r * D + seg * 32 + 8 * i);
        q.x = pk2(bflo(q.x) * rsinv, bfhi(q.x) * rsinv); q.y = pk2(bflo(q.y) * rsinv, bfhi(q.y) * rsinv); q.z = pk2(bflo(q.z) * rsinv, bfhi(q.z) * rsinv); q.w = pk2(bflo(q.w) * rsinv, bfhi(q.w) * rsinv);
        *(v4u*)(A2 + r * D + seg * 32 + 8 * i) = q; }
}

constexpr int SA_REDM = 0, SA_REDS = 512, SA_P = 1024, SA_O = 1024 + 8192;
__device__ __forceinline__ void attn_sample_item(Frame& F, int b, int hp) {
    const int tid = F.tid, lane = F.lane, w = F.wave, fr = lane & 15, fq = lane >> 4, hl = w >> 2, kq = w & 3, h = 2 * hp + hl; const size_t r0 = (size_t)MP + 4 * b;
    const bf16* Q = WSP(const bf16, WS_Q); bf16* O = WSP(bf16, WS_O); const float* ck = INP(I_CK); const float* cv = INP(I_CV);
    LAS float* redM = (LAS float*)(F.lds + SA_REDM); LAS float* redS = (LAS float*)(F.lds + SA_REDS); LAS float* pL = (LAS float*)(F.lds + SA_P); LAS float* oL = (LAS float*)(F.lds + SA_O);
    bf16x8 qf[8];
#pragma unroll
    for (int ks = 0; ks < 8; ++ks) { v4u q = (v4u){0u, 0u, 0u, 0u}; if (fr < 4) q = *(const v4u*)(Q + (r0 + fr) * D + h * 256 + 32 * ks + 8 * fq); qf[ks] = __builtin_bit_cast(bf16x8, q); }
    f32x4 s[4];
#pragma unroll
    for (int mb = 0; mb < 4; ++mb) { const int m = 64 * kq + 16 * mb + fr; const float* kp = ck + (((size_t)b * NMEM + m) * 4 + h) * 256 + 8 * fq; f32x4 acc = (f32x4){0.f, 0.f, 0.f, 0.f};
#pragma unroll
        for (int ks = 0; ks < 8; ++ks) { const f32x4 a0 = *(const f32x4*)(kp + 32 * ks), a1 = *(const f32x4*)(kp + 32 * ks + 4);
            v4u q; q.x = pk2(a0.x, a0.y); q.y = pk2(a0.z, a0.w); q.z = pk2(a1.x, a1.y); q.w = pk2(a1.z, a1.w); acc = MFMA16(__builtin_bit_cast(bf16x8, q), qf[ks], acc); }
        s[mb] = acc; }
    float mx = -3.0e38f;
#pragma unroll
    for (int mb = 0; mb < 4; ++mb) mx = fmaxf(mx, fmaxf(fmaxf(s[mb][0], s[mb][1]), fmaxf(s[mb][2], s[mb][3])));
    mx = fmaxf(mx, __shfl_xor(mx, 16)); mx = fmaxf(mx, __shfl_xor(mx, 32));
    if (fq == 0) redM[w * 16 + fr] = mx;
    WG_BAR();
    mx = fmaxf(fmaxf(redM[(4 * hl) * 16 + fr], redM[(4 * hl + 1) * 16 + fr]), fmaxf(redM[(4 * hl + 2) * 16 + fr], redM[(4 * hl + 3) * 16 + fr]));
    float sm = 0.f;
#pragma unroll
    for (int mb = 0; mb < 4; ++mb)
#pragma unroll
        for (int r = 0; r < 4; ++r) { const float p = __expf(s[mb][r] - mx); sm += p; if (fr < 4) pL[(hl * 256 + 64 * kq + 16 * mb + 4 * fq + r) * 4 + fr] = p; }
    sm += __shfl_xor(sm, 16); sm += __shfl_xor(sm, 32);
    if (fq == 0) redS[w * 16 + fr] = sm;
    WG_BAR();
    f32x4 o[4];
#pragma unroll
    for (int t = 0; t < 4; ++t) o[t] = (f32x4){0.f, 0.f, 0.f, 0.f};
    { const float* vp = cv + (((size_t)b * NMEM + 64 * kq) * 4 + h) * 256 + 4 * lane;
#pragma unroll 8
        for (int mi = 0; mi < 64; ++mi) { const f32x4 v = *(const f32x4*)(vp + (size_t)mi * 1024); const f32x4 pv = *(const LAS f32x4*)(pL + (hl * 256 + 64 * kq + mi) * 4);
#pragma unroll
            for (int t = 0; t < 4; ++t) o[t] += v * pv[t]; } }
#pragma unroll
    for (int t = 0; t < 4; ++t) *(LAS f32x4*)(oL + (w * 4 + t) * 256 + 4 * lane) = o[t];
    WG_BAR();
    { const int h2 = tid >> 8, t = (tid >> 6) & 3, d4 = (tid & 63) * 4; f32x4 a = (f32x4){0.f, 0.f, 0.f, 0.f}; float l = 0.f;
#pragma unroll
        for (int k = 0; k < 4; ++k) { a += *(const LAS f32x4*)(oL + ((4 * h2 + k) * 4 + t) * 256 + d4); l += redS[(4 * h2 + k) * 16 + t]; }
        const float inv = 1.0f / l; v2u q; q.x = pk2(a.x * inv, a.y * inv); q.y = pk2(a.z * inv, a.w * inv);
        *(v2u*)(O + (r0 + t) * D + (2 * hp + h2) * 256 + d4) = q; }
    WG_BAR();
}


__device__ __forceinline__ f32x4 skinny_acc(Frame& F, const bf16* A, int lda, const bf16* Bt, int ldb, int K, int mi, int ni) {
    const int w = F.wave, lane = F.lane, fr = lane & 15, fq = lane >> 4; const int kw = K >> 3, nks = kw >> 5;
    const bf16* ap = A + (size_t)(32 * mi + fr) * lda + w * kw + 8 * fq; const bf16* bp = Bt + (size_t)(64 * ni + fr) * ldb + w * kw + 8 * fq;
    f32x4 acc[2][4];
#pragma unroll
    for (int r = 0; r < 2; ++r)
#pragma unroll
        for (int c = 0; c < 4; ++c) acc[r][c] = (f32x4){0.f, 0.f, 0.f, 0.f};
    for (int ks0 = 0; ks0 < nks; ks0 += 4) { bf16x8 a[4][2], b[4][4];
#pragma unroll
        for (int j = 0; j < 4; ++j) if (ks0 + j < nks) { const int k = 32 * (ks0 + j);
#pragma unroll
            for (int r = 0; r < 2; ++r) a[j][r] = *(const bf16x8*)(ap + (size_t)(16 * r) * lda + k);
#pragma unroll
            for (int c = 0; c < 4; ++c) b[j][c] = *(const bf16x8*)(bp + (size_t)(16 * c) * ldb + k); }
#pragma unroll
        for (int j = 0; j < 4; ++j) if (ks0 + j < nks) {
#pragma unroll
            for (int r = 0; r < 2; ++r)
#pragma unroll
                for (int c = 0; c < 4; ++c) acc[r][c] = MFMA16(b[j][c], a[j][r], acc[r][c]); } }
    LAS f32x4* red = (LAS f32x4*)F.lds;
#pragma unroll
    for (int r = 0; r < 2; ++r)
#pragma unroll
        for (int c = 0; c < 4; ++c) red[(w * 8 + r * 4 + c) * 64 + lane] = acc[r][c];
    WG_BAR();
    f32x4 o = (f32x4){0.f, 0.f, 0.f, 0.f};
#pragma unroll
    for (int ww = 0; ww < 8; ++ww) o += red[(ww * 8 + w) * 64 + lane];
    WG_BAR();
    return o;
}
__device__ __forceinline__ void skinny_resid(Frame& F, int unit, const bf16* A, int lda, const bf16* Bt, int K, const float* res, float* out, bf16* outb, float alpha, const float* ssq_in, float* ssq_out) {
    const int w = F.wave, lane = F.lane, fr = lane & 15, fq = lane >> 4, rb = w >> 2, cb = w & 3, mi = unit >> 4, ni = unit & 15;
    const int row = 32 * mi + 16 * rb + fr, col0 = 64 * ni + 16 * cb + 4 * fq;
    const f32x4 acc = skinny_acc(F, A, lda, Bt, K, K, mi, ni);
    const float sc = alpha * (ssq_in ? pg8::rstd16(ssq_in, row) : 1.0f);
    const f32x4 o = *(const f32x4*)(res + (size_t)row * D + col0) + acc * sc;
    *(f32x4*)(out + (size_t)row * D + col0) = o;
    if (outb) { v2u q; q.x = pk2(o[0], o[1]); q.y = pk2(o[2], o[3]); *(v2u*)(outb + (size_t)row * D + col0) = q; }
    float q = (o[0] * o[0] + o[1] * o[1]) + (o[2] * o[2] + o[3] * o[3]); q += __shfl_xor(q, 16); q += __shfl_xor(q, 32);
    LAS float* red = (LAS float*)F.lds;
    if (fq == 0) red[(16 * rb + fr) * 4 + cb] = q;
    WG_BAR();
    if (F.tid < 32) { const f32x4 r4 = *(const LAS f32x4*)(red + F.tid * 4); ssq_out[(size_t)(32 * mi + F.tid) * 16 + ni] = (r4[0] + r4[1]) + (r4[2] + r4[3]); }
    WG_BAR();
}
__device__ __forceinline__ void skinny_rowbf16(Frame& F, int unit, const bf16* A, int lda, const bf16* Bt, int K, bf16* O, const float* ssq_in) {
    const int w = F.wave, lane = F.lane, fr = lane & 15, fq = lane >> 4, rb = w >> 2, cb = w & 3, mi = unit >> 4, ni = unit & 15;
    const int row = 32 * mi + 16 * rb + fr, col0 = 64 * ni + 16 * cb + 4 * fq;
    const f32x4 acc = skinny_acc(F, A, lda, Bt, K, K, mi, ni);
    const float sc = ssq_in ? pg8::rstd16(ssq_in, row) : 1.0f;
    v2u q; q.x = pk2(acc[0] * sc, acc[1] * sc); q.y = pk2(acc[2] * sc, acc[3] * sc); *(v2u*)(O + (size_t)row * D + col0) = q;
}

__device__ __forceinline__ void final_norm_phase(Frame& F) {
    const float* SSQ4 = WSP(const float, WS_SSQ4); const float* gf = INP(I_GFIN); const int gw = F.bid * NWAVES + F.wave, NGW = F.G * NWAVES, lane = F.lane;
    f32x4 gv[4];
#pragma unroll
    for (int j = 0; j < 4; ++j) gv[j] = *(const f32x4*)(gf + 4 * lane + 256 * j);
    for (int m = gw; m < M; m += NGW) { const float rs = pg8::rstd16(SSQ4, m); float* yr = F.out + OUT_Y + (size_t)m * D;
#pragma unroll
        for (int j = 0; j < 4; ++j) { f32x4 v = *(const f32x4*)(yr + 4 * lane + 256 * j); v = v * rs * gv[j]; *(f32x4*)(yr + 4 * lane + 256 * j) = v; } }
}

struct Args { const float* in[34]; float* out; unsigned char* ws; int ph_lo, ph_hi, li, pad; };
__global__ void __launch_bounds__(NTHREADS, 2) mega_fwd(Args args) {
    extern __shared__ __attribute__((aligned(16))) unsigned char lds[];
    Frame F;
    F.lds = (LAS unsigned char*)lds;
    F.MISC = (volatile LAS unsigned*)(F.lds + MISC_OFF);
    F.tid = threadIdx.x; F.lane = F.tid & 63; F.wave = __builtin_amdgcn_readfirstlane(F.tid >> 6);
    F.G = gridDim.x; F.bid = blockIdx.x;
    F.out = args.out; F.ws = args.ws; F.ptab = (LAS unsigned*)(F.lds + LDSCTL_OFF);
    F.ctl = (gu32*)(F.ws + WS_CTL);
    for (int u = F.tid; u < (LDS_BYTES - LDSCTL_OFF) / 4; u += NTHREADS) ((LAS unsigned*)(F.lds + LDSCTL_OFF))[u] = 0u;
    __syncthreads();
    if (F.tid == 0) {
#pragma unroll
        for (int i = 0; i < 34; ++i) { const unsigned long long p = (unsigned long long)args.in[i]; F.ptab[2 * i] = (unsigned)p; F.ptab[2 * i + 1] = (unsigned)(p >> 32); } }
    __syncthreads();
    XcdBarrier bar; bar.bar = (unsigned*)(F.ctl + CW_BAR) + args.li * XCD_BAR_WORDS; bar.x = 0; bar.st = nullptr;
    if (N_LAUNCHES == 1) bar = xcd_barrier_post((unsigned*)(F.ctl + CW_BAR), F.MISC + 8);
    const int lo = args.ph_lo, hi = args.ph_hi;
#ifndef PHMASK
#define PHMASK 0x7fff
#endif
#define IN(k) ((((PHMASK) >> (k)) & 1) && lo <= (k) && (k) < hi)
#define SEAM(k) do { if (IN(k) && IN((k) + 1)) xcd_barrier(bar); } while (0)
    PG8_LAS unsigned char* ring = (PG8_LAS unsigned char*)(F.lds + RING_OFF);
    int K256 = 256; asm volatile("" : "+s"(K256));
    const pg8::bf16_t* XB = WSP(const pg8::bf16_t, WS_XB);
    float* X = WSP(float, WS_X);

    if (IN(0)) { p0_prologue(F); } SEAM(0);
    if (IN(1)) {
        { pg8::Gemm g{XB, WSP(const pg8::bf16_t, WS_W1GU), M, NGU, D, D, D}; pg8::StaticOrder S; S.init(M, NGU, F.G, F.bid);
          pg8::EpiGateUp E{WSP(pg8::bf16_t, WS_ACT), FF, WSP(const float, WS_SSQ0)};
          pg8::gemm_phase<pg8::EpiGateUp, pg8::StaticOrder, true, true>(ring, g, S, E); }
        { pg8::Gemm g{WSP(const pg8::bf16_t, WS_MBF), WSP(const pg8::bf16_t, WS_WMKV), MEMROWS, 2 * D, D, D, D}; pg8::OffsetOrder S; S.init(MEMROWS, 2 * D, F.G, F.bid, ((M / 256) * (NGU / 256)) % F.G);
          pg8::EpiMem E{F.out + OUT_MK, F.out + OUT_MV, WSP(pg8::bf16_t, WS_KM), WSP(pg8::bf16_t, WS_VT), WSP(const float, WS_SSQM)};
          pg8::gemm_phase<pg8::EpiMem, pg8::OffsetOrder, true, true>(ring, g, S, E); }
    } SEAM(1);
    if (IN(2)) {
        pg8::Gemm g{WSP(const pg8::bf16_t, WS_ACT), WSP(const pg8::bf16_t, WS_W1D), MP, D, FF, FF, FF}; pg8::StaticOrder S; S.init(MP, D, F.G, F.bid);
        pg8::EpiResid E{INP(I_XP), INP(I_XS), MP, X, WSP(pg8::bf16_t, WS_XB), 0.5f, nullptr, WSP(float, WS_SSQ1)};
        pg8::gemm_phase<pg8::EpiResid, pg8::StaticOrder, true, true>(ring, g, S, E);
        for (int u = F.bid; u < 256; u += F.G) skinny_resid(F, u, WSP(const bf16, WS_ACT) + (size_t)MP * FF, FF, WSP(const bf16, WS_W1D), FF, INP(I_XS), X + (size_t)MP * D, WSP(bf16, WS_XB) + (size_t)MP * D, 0.5f, nullptr, WSP(float, WS_SSQ1) + (size_t)MP * 16);
    } SEAM(2);
    if (IN(3)) {
        pg8::Gemm g{XB, WSP(const pg8::bf16_t, WS_WIN), M, NIN + 256, D, D, D}; pg8::StaticOrder S; S.init(M, NIN + 256, F.G, F.bid);
        pg8::EpiProj E{WSP(pg8::bf16_t, WS_PROJ), NIN, WSP(const float, WS_SSQ1), WSP(float, WS_DTR)};
        pg8::gemm_phase<pg8::EpiProj, pg8::StaticOrder, true, true>(ring, g, S, E);
    } SEAM(3);
    if (IN(4)) {
        for (int it = F.bid; it < BATCH * NCH * 2; it += F.G) mix_prompt_item(F, it >> 5, (it >> 1) & 15, it & 1);
        for (int it = F.bid; it < DEC_B * 2; it += F.G) mix_sample_item(F, it >> 1, it & 1);
    } SEAM(4);
    if (IN(5)) { scan_phase(F); } SEAM(5);
    if (IN(6)) { for (int it = F.bid; it < BATCH * NCH * 2; it += F.G) mixc_item(F, it >> 5, (it >> 1) & 15, it & 1);
                 for (int it = F.bid; it < MS / 64; it += F.G) sample_pool_rescale(F, it); } SEAM(6);
    if (IN(7)) {
        pg8::Gemm g{WSP(const pg8::bf16_t, WS_A2), WSP(const pg8::bf16_t, WS_WOUT), MP, D, D, D, D}; pg8::StaticOrder S; S.init(MP, D, F.G, F.bid);
        pg8::EpiResid E{X, X, M, X, WSP(pg8::bf16_t, WS_XB), 1.0f, WSP(const float, WS_SSQY), WSP(float, WS_SSQ2)};
        pg8::gemm_phase<pg8::EpiResid, pg8::StaticOrder, true, true>(ring, g, S, E);
        for (int u = F.bid; u < 256; u += F.G) skinny_resid(F, u, WSP(const bf16, WS_A2) + (size_t)MP * D, D, WSP(const bf16, WS_WOUT), D, X + (size_t)MP * D, X + (size_t)MP * D, WSP(bf16, WS_XB) + (size_t)MP * D, 1.0f, WSP(const float, WS_SSQY) + (size_t)MP * 16, WSP(float, WS_SSQ2) + (size_t)MP * 16);
    } SEAM(7);
    if (IN(8)) {
        pg8::Gemm g{XB, WSP(const pg8::bf16_t, WS_WQ), MP, D, D, D, D}; pg8::StaticOrder S; S.init(MP, D, F.G, F.bid);
        pg8::EpiRowBf16 E{WSP(pg8::bf16_t, WS_Q), D, WSP(const float, WS_SSQ2)};
        pg8::gemm_phase<pg8::EpiRowBf16, pg8::StaticOrder, true, true>(ring, g, S, E);
        for (int u = F.bid; u < 256; u += F.G) skinny_rowbf16(F, u, WSP(const bf16, WS_XB) + (size_t)MP * D, D, WSP(const bf16, WS_WQ), D, WSP(bf16, WS_Q) + (size_t)MP * D, WSP(const float, WS_SSQ2) + (size_t)MP * 16);
    } SEAM(8);
    if (IN(9)) {
        { pg8::Gemm g{WSP(const pg8::bf16_t, WS_Q), WSP(const pg8::bf16_t, WS_KM), MP, 256, K256, D, D}; pg8::AttnOrder<0> S; S.init(F.G, F.bid);
          pg8::EpiSoftmax E{WSP(pg8::bf16_t, WS_PB)};
          pg8::gemm_phase<pg8::EpiSoftmax, pg8::AttnOrder<0>, false, true>(ring, g, S, E); }
        for (int it = F.bid; it < DEC_B * 2; it += F.G) attn_sample_item(F, it >> 1, it & 1);
    } SEAM(9);
    if (IN(10)) {
        pg8::Gemm g{WSP(const pg8::bf16_t, WS_PB), WSP(const pg8::bf16_t, WS_VT), MP, 256, K256, D, 256}; pg8::AttnOrder<1> S; S.init(F.G, F.bid);
        pg8::EpiRowBf16 E{WSP(pg8::bf16_t, WS_O), D, nullptr};
        pg8::gemm_phase<pg8::EpiRowBf16, pg8::AttnOrder<1>, true, true>(ring, g, S, E);
    } SEAM(10);
    if (IN(11)) {
        pg8::Gemm g{WSP(const pg8::bf16_t, WS_O), WSP(const pg8::bf16_t, WS_WO), MP, D, D, D, D}; pg8::StaticOrder S; S.init(MP, D, F.G, F.bid);
        pg8::EpiResid E{X, X, M, X, WSP(pg8::bf16_t, WS_XB), 1.0f, nullptr, WSP(float, WS_SSQ3)};
        pg8::gemm_phase<pg8::EpiResid, pg8::StaticOrder, true, true>(ring, g, S, E);
        for (int u = F.bid; u < 256; u += F.G) skinny_resid(F, u, WSP(const bf16, WS_O) + (size_t)MP * D, D, WSP(const bf16, WS_WO), D, X + (size_t)MP * D, X + (size_t)MP * D, WSP(bf16, WS_XB) + (size_t)MP * D, 1.0f, nullptr, WSP(float, WS_SSQ3) + (size_t)MP * 16);
    } SEAM(11);
    if (IN(12)) {
        pg8::Gemm g{XB, WSP(const pg8::bf16_t, WS_W2GU), M, NGU, D, D, D}; pg8::StaticOrder S; S.init(M, NGU, F.G, F.bid);
        pg8::EpiGateUp E{WSP(pg8::bf16_t, WS_ACT), FF, WSP(const float, WS_SSQ3)};
        pg8::gemm_phase<pg8::EpiGateUp, pg8::StaticOrder, true, true>(ring, g, S, E);
    } SEAM(12);
    if (IN(13)) {
        pg8::Gemm g{WSP(const pg8::bf16_t, WS_ACT), WSP(const pg8::bf16_t, WS_W2D), MP, D, FF, FF, FF}; pg8::StaticOrder S; S.init(MP, D, F.G, F.bid);
        pg8::EpiResid E{X, X, M, F.out + OUT_Y, nullptr, 0.5f, nullptr, WSP(float, WS_SSQ4)};
        pg8::gemm_phase<pg8::EpiResid, pg8::StaticOrder, true, true>(ring, g, S, E);
        for (int u = F.bid; u < 256; u += F.G) skinny_resid(F, u, WSP(const bf16, WS_ACT) + (size_t)MP * FF, FF, WSP(const bf16, WS_W2D), FF, X + (size_t)MP * D, F.out + OUT_Y + (size_t)MP * D, nullptr, 0.5f, nullptr, WSP(float, WS_SSQ4) + (size_t)MP * 16);
    } SEAM(13);
    if (IN(14)) { final_norm_phase(F); }
#undef IN
#undef SEAM
}

extern "C" void kernel_launch(void* const* d_in, const int* in_sizes, int n_in, void* d_out, int out_size, void* d_ws, size_t ws_size, hipStream_t stream) {
    static int grid = 0;
    if (grid == 0) {
        if (n_in != 34 || out_size != (int)OUT_TOTAL || ws_size < WS_END) { fprintf(stderr, "kernel_launch: expected 34 inputs, %zu outputs, >= %zu bytes of workspace; got n_in %d, out %d, ws %zu; nothing launched\n", (size_t)OUT_TOTAL, (size_t)WS_END, n_in, out_size, ws_size); grid = -1; return; }
        int dev = 0, cus = 0, per_cu = 0;
        if (hipGetDevice(&dev) != hipSuccess || hipDeviceGetAttribute(&cus, hipDeviceAttributeMultiprocessorCount, dev) != hipSuccess) { fprintf(stderr, "kernel_launch: device query failed\n"); grid = -1; return; }
        if (hipFuncSetAttribute((const void*)mega_fwd, hipFuncAttributeMaxDynamicSharedMemorySize, LDS_BYTES) != hipSuccess) { fprintf(stderr, "kernel_launch: hipFuncSetAttribute failed\n"); grid = -1; return; }
        if (hipOccupancyMaxActiveBlocksPerMultiprocessor(&per_cu, (const void*)mega_fwd, NTHREADS, LDS_BYTES) != hipSuccess || per_cu < 1) { fprintf(stderr, "kernel_launch: occupancy query reports %d blocks per CU; nothing launched\n", per_cu); (void)hipGetLastError(); grid = -1; return; }
        grid = cus;
        if (grid != 256) { fprintf(stderr, "kernel_launch: this kernel is built for a 256-CU device (found %d CUs); nothing launched\n", cus); grid = -1; return; }
    }
    if (grid < 0) return;
    if (hipMemsetAsync((char*)d_ws + WS_CTL, 0, CTL_ZERO_BYTES, stream) != hipSuccess) { fprintf(stderr, "kernel_launch: hipMemsetAsync failed\n"); return; }
    Args a{};
    for (int i = 0; i < 34; ++i) a.in[i] = (const float*)d_in[i];
    a.out = (float*)d_out; a.ws = (unsigned char*)d_ws;
    if (N_LAUNCHES == 1) { a.ph_lo = 0; a.ph_hi = N_PHASES; a.li = 0; hipLaunchKernelGGL(mega_fwd, dim3(grid), dim3(NTHREADS), LDS_BYTES, stream, a); }
#ifndef HOSTDUP
#define HOSTDUP 0
#endif
    else for (int li = 0; li < N_PHASES; ++li) { a.ph_lo = li; a.ph_hi = li + 1; a.li = 0;
        for (int rep = 0; rep < (((HOSTDUP >> li) & 1) ? 2 : 1); ++rep) hipLaunchKernelGGL(mega_fwd, dim3(grid), dim3(NTHREADS), LDS_BYTES, stream, a); }
    const hipError_t le = hipPeekAtLastError();
    if (le != hipSuccess) fprintf(stderr, "kernel_launch: launch failed: %s\n", hipGetErrorName(le));
}
```

```cpp
#include <hip/hip_runtime.h>
#include <cstdio>
#include <cstdint>
#include <cmath>

#ifndef MK_N_LAUNCHES
#define MK_N_LAUNCHES 1
#endif

namespace pg8 {
#define PG8_LAS __attribute__((address_space(3)))
typedef unsigned short bf16_t;
typedef short bf16x8 __attribute__((ext_vector_type(8)));
typedef float f32x4 __attribute__((ext_vector_type(4)));
typedef unsigned u32x4 __attribute__((ext_vector_type(4)));
typedef unsigned u32x2 __attribute__((ext_vector_type(2)));
constexpr int BM = 256, BK = 64, HALF = 128, HTB = HALF * BK * 2  , STAGE_BYTES = 8 * HTB, NXCD = 8, WGM = 8;

__host__ __device__ __forceinline__ int lds_byte(int r, int c) { const int st = (r >> 4) * 2 + (c >> 5), rr = r & 15, cc = c & 31, ob = rr * 64 + cc * 2; return st * 1024 + (ob ^ (((ob >> 9) & 1) << 5)); }
__host__ __device__ __forceinline__ void stage_rc(int b, int& R, int& C) { const int st = b / 1024, sb = b % 1024, swz = sb ^ (((sb >> 9) & 1) << 5); R = (st >> 1) * 16 + swz / 64; C = (st & 1) * 32 + (swz % 64) / 2; }
__host__ __device__ __forceinline__ int perm32(int rho) { const int n = rho >> 4, i = rho & 15; return 8 * (i >> 2) + 4 * n + (i & 3); }

struct Unit { int pm, pn; };
struct Gemm { const bf16_t* A; const bf16_t* Bt; int M, N, K, lda, ldb; };

struct StaticOrder {
    int nM, nN, nwg, G, c;
    __host__ __device__ void init(int M, int N, int G_, int c_) { nM = M / BM; nN = N / BM; nwg = nM * nN; G = G_; c = c_; }
    __host__ __device__ bool next(int i, Unit& u) const {
        const long L = (long)i * G + c; if (L >= nwg) return false;
        int wgid = (int)L; { const int q = nwg / NXCD, r = nwg % NXCD, xcd = wgid % NXCD, off = wgid / NXCD; wgid = (xcd < r ? xcd * (q + 1) : r * (q + 1) + (xcd - r) * q) + off; }
        const int nig = WGM * nN, gid = wgid / nig, fm = gid * WGM, gsz = (nM - fm) < WGM ? (nM - fm) : WGM;
        u.pm = fm + ((wgid % nig) % gsz); u.pn = (wgid % nig) / gsz; return true;
    }
    __device__ __forceinline__ const char* abase(const Gemm& g, const Unit& u) const { return (const char*)g.A + (size_t)u.pm * 256 * g.lda * 2; }
    __device__ __forceinline__ const char* bbase(const Gemm& g, const Unit& u) const { return (const char*)g.Bt + (size_t)u.pn * 256 * g.ldb * 2; }
    __device__ __forceinline__ void a_ready(const Unit&) const {}
    __device__ __forceinline__ void done(const Unit&) const {}
};
struct OffsetOrder {
    int nM, nN, nwg, G, c;
    __device__ void init(int M, int N, int G_, int c_, int off) { nM = M / BM; nN = N / BM; nwg = nM * nN; G = G_; c = (c_ - off % G_ + G_) % G_; }
    __device__ bool next(int i, Unit& u) const { const long L = (long)i * G + c; if (L >= nwg) return false; u.pm = (int)L % nM; u.pn = (int)L / nM; return true; }
    __device__ __forceinline__ const char* abase(const Gemm& g, const Unit& u) const { return (const char*)g.A + (size_t)u.pm * 256 * g.lda * 2; }
    __device__ __forceinline__ const char* bbase(const Gemm& g, const Unit& u) const { return (const char*)g.Bt + (size_t)u.pn * 256 * g.ldb * 2; }
    __device__ __forceinline__ void a_ready(const Unit&) const {}
    __device__ __forceinline__ void done(const Unit&) const {}
};
template <int MODE> struct AttnOrder {
    int G, c;
    __device__ void init(int G_, int c_) { G = G_; c = c_; }
    __device__ bool next(int i, Unit& u) const { const long L = (long)i * G + c; if (L >= 256) return false; const int b = (int)L >> 5, h = ((int)L >> 3) & 3, qt = (int)L & 7; u.pm = 8 * b + qt; u.pn = h; return true; }
    __device__ __forceinline__ const char* abase(const Gemm& g, const Unit& u) const { return (const char*)g.A + ((size_t)u.pm * 256 * 1024 + (size_t)u.pn * 256) * 2; }
    __device__ __forceinline__ const char* bbase(const Gemm& g, const Unit& u) const {
        const int b = u.pm >> 3;
        if (MODE == 0) return (const char*)g.Bt + ((size_t)b * 256 * 1024 + (size_t)u.pn * 256) * 2;
        return (const char*)g.Bt + (size_t)(4 * b + u.pn) * 256 * 256 * 2;
    }
    __device__ __forceinline__ void a_ready(const Unit&) const {}
    __device__ __forceinline__ void done(const Unit&) const {}
};

__device__ __forceinline__ unsigned cvt_pk_bf16(float lo, float hi) { unsigned r; asm volatile("v_cvt_pk_bf16_f32 %0, %1, %2" : "=v"(r) : "v"(lo), "v"(hi)); return r; }
constexpr float RMS_EPS = 1e-6f;
__device__ __forceinline__ float rstd16(const float* ssq, int row) {
    const f32x4* p = (const f32x4*)(ssq + (size_t)row * 16); const f32x4 a = p[0], b = p[1], c = p[2], d = p[3];
    const float s = ((a[0] + a[1]) + (a[2] + a[3])) + ((b[0] + b[1]) + (b[2] + b[3])) + ((c[0] + c[1]) + (c[2] + c[3])) + ((d[0] + d[1]) + (d[2] + d[3]));
    return 1.0f / sqrtf(s * (1.0f / 1024.0f) + RMS_EPS);
}
__device__ __forceinline__ float silu_f(float x) { return x / (1.0f + __expf(-x)); }

struct EpiGateUp {
    static constexpr bool PERM = true, AFTER_DRAIN = false;
    bf16_t* O; int ldc; const float* ssq;
    __device__ __forceinline__ void operator()(const f32x4 (&acc)[2][2][4][2], const Unit& u, int wr, int wc, int fr, int fq) const {
        const int row0 = u.pm * BM + wr * 64 + fr, col0 = u.pn * HALF + wc * 32 + 8 * fq;
#pragma unroll
        for (int ai = 0; ai < 2; ++ai)
#pragma unroll
            for (int m = 0; m < 4; ++m) { const int r = row0 + ai * HALF + m * 16; const float rs = rstd16(ssq, r);
                f32x4 g0 = acc[ai][0][m][0] * rs, g1 = acc[ai][0][m][1] * rs, u0 = acc[ai][1][m][0] * rs, u1 = acc[ai][1][m][1] * rs;
                float o[8];
#pragma unroll
                for (int j = 0; j < 4; ++j) { o[j] = silu_f(g0[j]) * u0[j]; o[4 + j] = silu_f(g1[j]) * u1[j]; }
                u32x4 w; w.x = cvt_pk_bf16(o[0], o[1]); w.y = cvt_pk_bf16(o[2], o[3]); w.z = cvt_pk_bf16(o[4], o[5]); w.w = cvt_pk_bf16(o[6], o[7]);
                *(u32x4*)(O + (size_t)r * ldc + col0) = w; }
    }
};
struct EpiRowBf16 {
    static constexpr bool PERM = true, AFTER_DRAIN = false;
    bf16_t* O; int ldc; const float* ssq;
    __device__ __forceinline__ void operator()(const f32x4 (&acc)[2][2][4][2], const Unit& u, int wr, int wc, int fr, int fq) const {
        const int row0 = u.pm * BM + wr * 64 + fr, col0 = u.pn * BM + wc * 32 + 8 * fq;
#pragma unroll
        for (int ai = 0; ai < 2; ++ai)
#pragma unroll
            for (int m = 0; m < 4; ++m) { const int r = row0 + ai * HALF + m * 16; const float rs = ssq ? rstd16(ssq, r) : 1.0f; bf16_t* rowp = O + (size_t)r * ldc + col0;
#pragma unroll
                for (int bj = 0; bj < 2; ++bj) { const f32x4 v0 = acc[ai][bj][m][0] * rs, v1 = acc[ai][bj][m][1] * rs;
                    u32x4 w; w.x = cvt_pk_bf16(v0[0], v0[1]); w.y = cvt_pk_bf16(v0[2], v0[3]); w.z = cvt_pk_bf16(v1[0], v1[1]); w.w = cvt_pk_bf16(v1[2], v1[3]);
                    *(u32x4*)(rowp + bj * HALF) = w; } }
    }
};
struct EpiProj {
    static constexpr bool PERM = true, AFTER_DRAIN = false;
    bf16_t* O; int ldc; const float* ssq; float* dtr;
    __device__ __forceinline__ void operator()(const f32x4 (&acc)[2][2][4][2], const Unit& u, int wr, int wc, int fr, int fq) const {
        const int row0 = u.pm * BM + wr * 64 + fr, col0 = u.pn * BM + wc * 32 + 8 * fq;
        if (u.pn < 9) {
#pragma unroll
            for (int ai = 0; ai < 2; ++ai)
#pragma unroll
                for (int m = 0; m < 4; ++m) { const int r = row0 + ai * HALF + m * 16; const float rs = rstd16(ssq, r); bf16_t* rowp = O + (size_t)r * ldc + col0;
#pragma unroll
                    for (int bj = 0; bj < 2; ++bj) { const f32x4 v0 = acc[ai][bj][m][0] * rs, v1 = acc[ai][bj][m][1] * rs;
                        u32x4 w; w.x = cvt_pk_bf16(v0[0], v0[1]); w.y = cvt_pk_bf16(v0[2], v0[3]); w.z = cvt_pk_bf16(v1[0], v1[1]); w.w = cvt_pk_bf16(v1[2], v1[3]);
                        *(u32x4*)(rowp + bj * HALF) = w; } }
        } else if (wc == 0 && fq < 2) {
#pragma unroll
            for (int ai = 0; ai < 2; ++ai)
#pragma unroll
                for (int m = 0; m < 4; ++m) { const int r = row0 + ai * HALF + m * 16; const float rs = rstd16(ssq, r); float* dp = dtr + (size_t)r * 12 + 8 * fq;
                    *(f32x4*)dp = acc[ai][0][m][0] * rs; if (fq == 0) *(f32x4*)(dp + 4) = acc[ai][0][m][1] * rs; }
        }
    }
};
struct EpiResid {
    static constexpr bool PERM = false, AFTER_DRAIN = false;
    const float* res; const float* res2; int split; float* out; bf16_t* outb; float alpha; const float* ssq_in; float* ssq_out;
    __device__ __forceinline__ void operator()(const f32x4 (&acc)[2][2][4][2], const Unit& u, int wr, int wc, int fr, int fq) const {
        const int row0 = u.pm * BM + wr * 64 + fr, col0 = u.pn * BM + wc * 32 + 4 * fq;
#pragma unroll
        for (int ai = 0; ai < 2; ++ai)
#pragma unroll
            for (int m = 0; m < 4; ++m) { const int r = row0 + ai * HALF + m * 16; const float sc = alpha * (ssq_in ? rstd16(ssq_in, r) : 1.0f);
                const float* rp = (r < split) ? res + (size_t)r * 1024 : res2 + (size_t)(r - split) * 1024; const size_t off = (size_t)r * 1024 + col0; float q = 0.f;
#pragma unroll
                for (int bj = 0; bj < 2; ++bj)
#pragma unroll
                    for (int n = 0; n < 2; ++n) { const int cc = bj * HALF + n * 16; const f32x4 bs = *(const f32x4*)(rp + col0 + cc); const f32x4 o = bs + acc[ai][bj][m][n] * sc;
                        *(f32x4*)(out + off + cc) = o; q += (o[0] * o[0] + o[1] * o[1]) + (o[2] * o[2] + o[3] * o[3]);
                        if (outb) { u32x2 w; w.x = cvt_pk_bf16(o[0], o[1]); w.y = cvt_pk_bf16(o[2], o[3]); *(u32x2*)(outb + off + cc) = w; } }
                q += __shfl_xor(q, 16); q += __shfl_xor(q, 32);
                if (fq == 0) ssq_out[(size_t)r * 16 + u.pn * 4 + wc] = q; }
    }
};
struct EpiMem {
    static constexpr bool PERM = false, AFTER_DRAIN = false;
    float* outk; float* outv; bf16_t* km; bf16_t* vt; const float* ssq;
    __device__ __forceinline__ void operator()(const f32x4 (&acc)[2][2][4][2], const Unit& u, int wr, int wc, int fr, int fq) const {
        const int row0 = u.pm * BM + wr * 64 + fr; const bool isv = u.pn >= 4; const int col0 = (u.pn & 3) * BM + wc * 32 + 4 * fq;
#pragma unroll
        for (int ai = 0; ai < 2; ++ai)
#pragma unroll
            for (int m = 0; m < 4; ++m) { const int r = row0 + ai * HALF + m * 16; const float rs = rstd16(ssq, r); const size_t off = (size_t)r * 1024 + col0;
#pragma unroll
                for (int bj = 0; bj < 2; ++bj)
#pragma unroll
                    for (int n = 0; n < 2; ++n) { const int cc = bj * HALF + n * 16; const f32x4 o = acc[ai][bj][m][n] * rs;
                        if (!isv) { *(f32x4*)(outk + off + cc) = o; u32x2 w; w.x = cvt_pk_bf16(o[0], o[1]); w.y = cvt_pk_bf16(o[2], o[3]); *(u32x2*)(km + off + cc) = w; }
                        else { *(f32x4*)(outv + off + cc) = o; const int b = r >> 8, mm = r & 255; const int c = col0 + cc; const int h = c >> 8, d = c & 255;
                            bf16_t* vp = vt + ((size_t)(4 * b + h) * 256 + d) * 256 + mm; const unsigned w0 = cvt_pk_bf16(o[0], o[1]), w1 = cvt_pk_bf16(o[2], o[3]);
                            vp[0] = (bf16_t)(w0 & 0xffffu); vp[256] = (bf16_t)(w0 >> 16); vp[512] = (bf16_t)(w1 & 0xffffu); vp[768] = (bf16_t)(w1 >> 16); } } }
    }
};
struct EpiSoftmax {
    static constexpr bool PERM = true, AFTER_DRAIN = true;
    bf16_t* P;
    __device__ __forceinline__ void fused(f32x4 (&acc)[2][2][4][2], const Unit& u, int wr, int wc, int fr, int fq, PG8_LAS unsigned char* lds, int wid, int lane) const {
        PG8_LAS float* red = (PG8_LAS float*)lds;
        PG8_LAS float* red2 = (PG8_LAS float*)(lds + 4096);
#pragma unroll
        for (int ai = 0; ai < 2; ++ai)
#pragma unroll
            for (int m = 0; m < 4; ++m) { float mx = -3.0e38f;
#pragma unroll
                for (int bj = 0; bj < 2; ++bj)
#pragma unroll
                    for (int n = 0; n < 2; ++n) { const f32x4 x = acc[ai][bj][m][n]; mx = fmaxf(mx, fmaxf(fmaxf(x[0], x[1]), fmaxf(x[2], x[3]))); }
                mx = fmaxf(mx, __shfl_xor(mx, 16)); mx = fmaxf(mx, __shfl_xor(mx, 32));
                if (fq == 0) red[(ai * HALF + wr * 64 + m * 16 + fr) * 4 + wc] = mx; }
        asm volatile("s_waitcnt lgkmcnt(0)" ::: "memory"); __builtin_amdgcn_s_barrier(); asm volatile("" ::: "memory");
#pragma unroll
        for (int ai = 0; ai < 2; ++ai)
#pragma unroll
            for (int m = 0; m < 4; ++m) { const int rr = ai * HALF + wr * 64 + m * 16 + fr; const f32x4 q = *(const PG8_LAS f32x4*)(red + rr * 4);
                const float mx = fmaxf(fmaxf(q[0], q[1]), fmaxf(q[2], q[3])); float s = 0.f;
#pragma unroll
                for (int bj = 0; bj < 2; ++bj)
#pragma unroll
                    for (int n = 0; n < 2; ++n) { f32x4 x = acc[ai][bj][m][n];
#pragma unroll
                        for (int j = 0; j < 4; ++j) { x[j] = __expf(x[j] - mx); s += x[j]; }
                        acc[ai][bj][m][n] = x; }
                s += __shfl_xor(s, 16); s += __shfl_xor(s, 32);
                if (fq == 0) red2[rr * 4 + wc] = s; }
        asm volatile("s_waitcnt lgkmcnt(0)" ::: "memory"); __builtin_amdgcn_s_barrier(); asm volatile("" ::: "memory");
        const int col0 = u.pn * BM + wc * 32 + 8 * fq;
#pragma unroll
        for (int ai = 0; ai < 2; ++ai)
#pragma unroll
            for (int m = 0; m < 4; ++m) { const int rr = ai * HALF + wr * 64 + m * 16 + fr; const f32x4 q = *(const PG8_LAS f32x4*)(red2 + rr * 4);
                const float inv = 1.0f / ((q[0] + q[1]) + (q[2] + q[3])); bf16_t* rowp = P + (size_t)(u.pm * BM + rr) * 1024 + col0;
#pragma unroll
                for (int bj = 0; bj < 2; ++bj) { const f32x4 v0 = acc[ai][bj][m][0] * inv, v1 = acc[ai][bj][m][1] * inv;
                    u32x4 w; w.x = cvt_pk_bf16(v0[0], v0[1]); w.y = cvt_pk_bf16(v0[2], v0[3]); w.z = cvt_pk_bf16(v1[0], v1[1]); w.w = cvt_pk_bf16(v1[2], v1[3]);
                    *(u32x4*)(rowp + bj * HALF) = w; } }
        asm volatile("s_waitcnt lgkmcnt(0)" ::: "memory"); __builtin_amdgcn_s_barrier(); asm volatile("" ::: "memory");
    }
};

template <class Epi, class Sched, bool ALIGN_EPI = false, bool SP2 = false>
__device__ __forceinline__ void gemm_phase(PG8_LAS unsigned char* lds, const Gemm g, const Sched& S, const Epi& E) {
    const int tid = threadIdx.x, wid = __builtin_amdgcn_readfirstlane(tid >> 6), lane = tid & 63, wr = wid >> 2, wc = wid & 3, fr = lane & 15, fq = lane >> 4;
    const int K = g.K, nt = K / BK;
    unsigned voffA[2], voffB[2];
#pragma unroll
    for (int i = 0; i < 2; ++i) { int R, C; stage_rc(tid * 16 + i * 8192, R, C); const int Rb = Epi::PERM ? ((R & ~31) + perm32(R & 31)) : R;
        voffA[i] = (unsigned)(R * g.lda + C) * 2u; voffB[i] = (unsigned)(Rb * g.ldb + C) * 2u; }
    const size_t kstep = (size_t)(BK * 2);
    const size_t hstepA = (size_t)HALF * g.lda * 2, hstepB = (size_t)HALF * g.ldb * 2;
    const unsigned ldsw = (unsigned)wid * 1024u;
    const int aoff = lds_byte(wr * 64 + fr, fq * 8), boff = lds_byte(wc * 32 + fr, fq * 8);
#define PG8_SA(b, h) (((b) * 2 + (h)) * HTB)
#define PG8_SB(b, h) ((4 + (b) * 2 + (h)) * HTB)
#define PG8_STAGE(bufoff, gbase, voff) do { _Pragma("unroll") for (int _i = 0; _i < 2; ++_i) \
        __builtin_amdgcn_global_load_lds((const unsigned*)((const char*)(gbase) + (voff)[_i]), (PG8_LAS unsigned*)(lds + (bufoff) + ldsw + _i * 8192), 16, 0, 0); } while (0)
#define PG8_LDA(dst, b, h) do { _Pragma("unroll") for (int m = 0; m < 4; ++m) _Pragma("unroll") for (int k = 0; k < 2; ++k) dst[m][k] = *(const PG8_LAS bf16x8*)(lds + PG8_SA(b, h) + aoff + m * 2048 + k * 1024); } while (0)
#define PG8_LDB(dst, b, h) do { _Pragma("unroll") for (int n = 0; n < 2; ++n) _Pragma("unroll") for (int k = 0; k < 2; ++k) dst[n][k] = *(const PG8_LAS bf16x8*)(lds + PG8_SB(b, h) + boff + n * 2048 + k * 1024); } while (0)
#define PG8_MMA(ai, bj, At, Bt) do { __builtin_amdgcn_s_setprio(1); _Pragma("unroll") for (int m = 0; m < 4; ++m) _Pragma("unroll") for (int n = 0; n < 2; ++n) _Pragma("unroll") for (int k = 0; k < 2; ++k) \
        acc[ai][bj][m][n] = __builtin_amdgcn_mfma_f32_16x16x32_bf16(Bt[n][k], At[m][k], acc[ai][bj][m][n], 0, 0, 0); __builtin_amdgcn_s_setprio(0); } while (0)
#define PG8_WAIT_V(n) asm volatile("s_waitcnt vmcnt(" #n ")" ::: "memory")
#define PG8_WAIT_L(n) asm volatile("s_waitcnt lgkmcnt(" #n ")" ::: "memory")
#define PG8_BAR __builtin_amdgcn_s_barrier()
#define PG8_SCHED __builtin_amdgcn_sched_barrier(0)
    Unit cur, nxt; int ui = 0;
    if (!S.next(0, cur)) return;
    f32x4 acc[2][2][4][2];
#pragma unroll
    for (int a = 0; a < 2; ++a)
#pragma unroll
        for (int b = 0; b < 2; ++b)
#pragma unroll
            for (int m = 0; m < 4; ++m)
#pragma unroll
                for (int n = 0; n < 2; ++n) acc[a][b][m][n] = (f32x4){0.f, 0.f, 0.f, 0.f};
    bf16x8 At[4][2], B0[2][2], B1[2][2];
    const char* cA = S.abase(g, cur); const char* cB = S.bbase(g, cur);
    S.a_ready(cur);
    if constexpr (SP2) {
        PG8_STAGE(PG8_SB(0, 0), cB, voffB); PG8_STAGE(PG8_SB(0, 1), cB + hstepB, voffB); PG8_STAGE(PG8_SA(0, 0), cA, voffA); PG8_STAGE(PG8_SA(0, 1), cA + hstepA, voffA);
        if (wr == 1) PG8_BAR;
        PG8_WAIT_V(2); PG8_BAR;
        PG8_STAGE(PG8_SB(1, 0), cB + kstep, voffB); PG8_STAGE(PG8_SA(1, 0), cA + kstep, voffA); PG8_STAGE(PG8_SB(1, 1), cB + hstepB + kstep, voffB);
        PG8_WAIT_V(6); PG8_BAR;
    } else {
        PG8_STAGE(PG8_SB(0, 0), cB, voffB); PG8_STAGE(PG8_SA(0, 0), cA, voffA); PG8_STAGE(PG8_SB(0, 1), cB + hstepB, voffB); PG8_STAGE(PG8_SA(0, 1), cA + hstepA, voffA);
        if (wr == 1) PG8_BAR;
        PG8_WAIT_V(4); PG8_BAR;
        PG8_STAGE(PG8_SB(1, 0), cB + kstep, voffB); PG8_STAGE(PG8_SA(1, 0), cA + kstep, voffA); PG8_STAGE(PG8_SB(1, 1), cB + hstepB + kstep, voffB);
        PG8_WAIT_V(6); PG8_BAR;
    }
    for (;;) {
        const bool has_next = S.next(ui + 1, nxt);
        const char* nA = has_next ? S.abase(g, nxt) : cA; const char* nB = has_next ? S.bbase(g, nxt) : cB;
        for (int t = 0; t < nt; t += 2) {
            const bool last = (t == nt - 2);
            const char* a1 = cA + (size_t)(t + 1) * kstep;
            const char* a2 = last ? nA : cA + (size_t)(t + 2) * kstep; const char* b2 = last ? nB : cB + (size_t)(t + 2) * kstep;
            const char* a3 = a2 + kstep; const char* b3 = b2 + kstep;
            if (last && has_next) S.a_ready(nxt);
            if constexpr (SP2) {
            PG8_LDB(B0, 0, 0); PG8_LDB(B1, 0, 1); PG8_SCHED; PG8_LDA(At, 0, 0); PG8_STAGE(PG8_SA(1, 1), a1 + hstepA, voffA);
            PG8_WAIT_V(8); PG8_WAIT_L(0); PG8_BAR; PG8_MMA(0, 0, At, B0); PG8_MMA(0, 1, At, B1); PG8_BAR; PG8_SCHED;
            PG8_LDA(At, 0, 1); PG8_STAGE(PG8_SB(0, 0), b2, voffB); PG8_STAGE(PG8_SB(0, 1), b2 + hstepB, voffB); PG8_STAGE(PG8_SA(0, 0), a2, voffA);
            PG8_WAIT_V(8); PG8_WAIT_L(0); PG8_BAR; PG8_MMA(1, 0, At, B0); PG8_MMA(1, 1, At, B1); PG8_BAR; PG8_SCHED;
            PG8_LDB(B0, 1, 0); PG8_LDB(B1, 1, 1); PG8_SCHED; PG8_LDA(At, 1, 0); PG8_STAGE(PG8_SA(0, 1), a2 + hstepA, voffA);
            PG8_WAIT_V(8); PG8_WAIT_L(0); PG8_BAR; PG8_MMA(0, 0, At, B0); PG8_MMA(0, 1, At, B1); PG8_BAR; PG8_SCHED;
            PG8_LDA(At, 1, 1); PG8_STAGE(PG8_SB(1, 0), b3, voffB); PG8_STAGE(PG8_SB(1, 1), b3 + hstepB, voffB); PG8_STAGE(PG8_SA(1, 0), a3, voffA);
            PG8_WAIT_V(8); PG8_WAIT_L(0); PG8_BAR; PG8_MMA(1, 0, At, B0); PG8_MMA(1, 1, At, B1); PG8_BAR; PG8_SCHED;
            } else {
            PG8_LDB(B0, 0, 0); PG8_SCHED; PG8_LDA(At, 0, 0); PG8_STAGE(PG8_SA(1, 1), a1 + hstepA, voffA);
            PG8_WAIT_L(8); PG8_BAR; PG8_WAIT_L(0); PG8_MMA(0, 0, At, B0); PG8_BAR; PG8_SCHED;
            PG8_LDB(B1, 0, 1); PG8_STAGE(PG8_SB(0, 0), b2, voffB);
            PG8_BAR; PG8_WAIT_L(0); PG8_MMA(0, 1, At, B1); PG8_BAR;
            PG8_LDA(At, 0, 1); PG8_STAGE(PG8_SA(0, 0), a2, voffA);
            PG8_BAR; PG8_WAIT_L(0); PG8_MMA(1, 0, At, B0); PG8_BAR; PG8_SCHED;
            PG8_STAGE(PG8_SB(0, 1), b2 + hstepB, voffB);
            PG8_WAIT_V(6); PG8_BAR; PG8_MMA(1, 1, At, B1); PG8_BAR;
            PG8_LDB(B0, 1, 0); PG8_SCHED; PG8_LDA(At, 1, 0); PG8_STAGE(PG8_SA(0, 1), a2 + hstepA, voffA);
            PG8_WAIT_L(8); PG8_BAR; PG8_WAIT_L(0); PG8_MMA(0, 0, At, B0); PG8_BAR; PG8_SCHED;
            PG8_LDB(B1, 1, 1); PG8_STAGE(PG8_SB(1, 0), b3, voffB);
            PG8_BAR; PG8_WAIT_L(0); PG8_MMA(0, 1, At, B1); PG8_BAR;
            PG8_LDA(At, 1, 1); PG8_STAGE(PG8_SA(1, 0), a3, voffA);
            PG8_BAR; PG8_WAIT_L(0); PG8_MMA(1, 0, At, B0); PG8_BAR; PG8_SCHED;
            PG8_STAGE(PG8_SB(1, 1), b3 + hstepB, voffB);
            PG8_WAIT_V(6); PG8_BAR; PG8_MMA(1, 1, At, B1); PG8_BAR;
            }
        }
        if constexpr (ALIGN_EPI) { if (wr == 0) PG8_BAR; }
        if constexpr (!Epi::AFTER_DRAIN) { E(acc, cur, wr, wc, fr, fq); S.done(cur); }
        if (!has_next) break;
#pragma unroll
        for (int a = 0; a < 2; ++a)
#pragma unroll
            for (int b = 0; b < 2; ++b)
#pragma unroll
                for (int m = 0; m < 4; ++m)
#pragma unroll
                    for (int n = 0; n < 2; ++n) acc[a][b][m][n] = (f32x4){0.f, 0.f, 0.f, 0.f};
        cur = nxt; cA = nA; cB = nB; ++ui;
        if constexpr (ALIGN_EPI) { if (wr == 1) PG8_BAR; }
    }
    PG8_WAIT_V(0);
    if constexpr (!ALIGN_EPI) { if (wr == 0) PG8_BAR; }
    PG8_BAR;
    if constexpr (Epi::AFTER_DRAIN) { E.fused(acc, cur, wr, wc, fr, fq, lds, wid, lane); S.done(cur); }
#undef PG8_SA
#undef PG8_SB
#undef PG8_STAGE
#undef PG8_LDA
#undef PG8_LDB
#undef PG8_MMA
#undef PG8_WAIT_V
#undef PG8_WAIT_L
#undef PG8_BAR
#undef PG8_SCHED
}
}

constexpr int NWAVES = 8, NTHREADS = 512;
constexpr int N_PHASES = 15;
constexpr int N_LAUNCHES = MK_N_LAUNCHES;
constexpr int D = 1024, FF = 2816, NGU = 2 * FF, NIN = 2304, D_INP = 2316;
constexpr int BATCH = 8, SEQ = 2048, MP = BATCH * SEQ, DEC_B = 128, DEC_T = 4, MS = DEC_B * DEC_T, M = MP + MS;
constexpr int D_POOL = 256, D_SSM = 768, NH = 12, HD = 64, NST = 128, CONV_DIM = 1280, CHUNK = 128, NCH = SEQ / CHUNK;
constexpr int XBC0 = 1024;
constexpr int NMEM = 256, MEMROWS = BATCH * NMEM;
constexpr float EPS = 1e-6f;

constexpr size_t MiB = 1u << 20;
constexpr size_t WS_CTL = 0, CTL_ZERO_BYTES = 1 * MiB;
constexpr size_t WS_W1GU = 2 * MiB, WS_W1D = 13 * MiB, WS_WIN = 19 * MiB, WS_WOUT = 24 * MiB, WS_WQ = 26 * MiB, WS_WO = 28 * MiB, WS_WMKV = 30 * MiB, WS_W2GU = 34 * MiB, WS_W2D = 45 * MiB, WS_DTR = 51 * MiB;
constexpr size_t WS_SSQ0 = 52 * MiB, WS_SSQ1 = 54 * MiB, WS_SSQY = 56 * MiB, WS_SSQ2 = 58 * MiB, WS_SSQ3 = 60 * MiB, WS_SSQ4 = 62 * MiB, WS_SSQM = 64 * MiB;
constexpr size_t WS_EXPA = 65 * MiB, WS_CD = 66 * MiB;
constexpr size_t WS_MBF = 68 * MiB, WS_KM = 72 * MiB, WS_VT = 76 * MiB;
constexpr size_t WS_XB = 80 * MiB;
constexpr size_t WS_X = 114 * MiB;
constexpr size_t WS_A2 = 180 * MiB;
constexpr size_t WS_ACT = 214 * MiB;
constexpr size_t WS_YD = 214 * MiB, WS_ST = 262 * MiB;
constexpr size_t WS_PROJ = 310 * MiB;
constexpr size_t WS_Q = 310 * MiB, WS_PB = 343 * MiB;
constexpr size_t WS_HP = 385 * MiB, WS_CB = 409 * MiB;
constexpr size_t WS_O = 385 * MiB;
constexpr size_t WS_END = 420 * MiB;
static_assert(WS_W1GU + (size_t)NGU * D * 2 <= WS_W1D && WS_W1D + (size_t)D * FF * 2 <= WS_WIN && WS_WIN + (size_t)NIN * D * 2 <= WS_WOUT && WS_W2GU + (size_t)NGU * D * 2 <= WS_W2D && WS_W2D + (size_t)D * FF * 2 <= WS_DTR && WS_DTR + (size_t)M * 12 * 4 <= WS_SSQ0 && WS_WIN + (size_t)(NIN + 256) * D * 2 <= WS_WOUT, "weights map");
static_assert(WS_SSQ0 + (size_t)M * 64 <= WS_SSQ1 && WS_XB + (size_t)M * D * 2 <= WS_X && WS_X + (size_t)M * D * 4 <= WS_A2 && WS_A2 + (size_t)M * D * 2 <= WS_ACT, "ws map 1");
static_assert(WS_ACT + (size_t)M * FF * 2 <= WS_PROJ && WS_YD + (size_t)MP * D_SSM * 4 <= WS_ST && WS_ST + (size_t)BATCH * NCH * NH * HD * NST * 4 <= WS_PROJ, "ws map 2");
static_assert(WS_PROJ + (size_t)M * NIN * 2 <= WS_HP && WS_Q + (size_t)M * D * 2 <= WS_PB && WS_PB + (size_t)MP * D * 2 <= WS_HP, "ws map 3");
static_assert(WS_HP + (size_t)BATCH * NCH * NH * HD * NST * 2 <= WS_CB && WS_CB + (size_t)MP * 256 * 2 <= WS_END && WS_O + (size_t)M * D * 2 <= WS_END, "ws map 4");
constexpr int CW_BAR = 4096;

constexpr size_t OUT_Y = 0, OUT_MK = (size_t)M * D, OUT_MV = OUT_MK + (size_t)MEMROWS * D, OUT_POOLP = OUT_MV + (size_t)MEMROWS * D, OUT_CONVP = OUT_POOLP + (size_t)BATCH * 15 * D_POOL,
    OUT_SSMP = OUT_CONVP + (size_t)BATCH * 3 * CONV_DIM, OUT_POOLS = OUT_SSMP + (size_t)BATCH * NH * HD * NST, OUT_CONVS = OUT_POOLS + (size_t)DEC_B * 15 * D_POOL, OUT_SSMS = OUT_CONVS + (size_t)DEC_B * 3 * CONV_DIM,
    OUT_TOTAL = OUT_SSMS + (size_t)DEC_B * NH * HD * NST;
static_assert(OUT_TOTAL == 35909632, "output size");

constexpr int RING_OFF = 0, RING_BYTES = 153600;
constexpr int LDSCTL_OFF = RING_BYTES, MISC_OFF = LDSCTL_OFF + 320;
constexpr int LDS_BYTES = 163840;
static_assert(MISC_OFF + 128 <= LDS_BYTES, "LDS map");

#define GAS __attribute__((address_space(1)))
#define LAS __attribute__((address_space(3)))
typedef unsigned short bf16;
typedef unsigned v4u __attribute__((ext_vector_type(4)));
typedef unsigned v2u __attribute__((ext_vector_type(2)));
typedef float f32x4 __attribute__((ext_vector_type(4)));
typedef short bf16x8 __attribute__((ext_vector_type(8)));
typedef GAS unsigned gu32;
#define RLX_AGENT __ATOMIC_RELAXED, __HIP_MEMORY_SCOPE_AGENT
#define LDS_WAIT() asm volatile("s_waitcnt lgkmcnt(0)" ::: "memory")
#define VM_WAIT() asm volatile("s_waitcnt vmcnt(0)" ::: "memory")
__device__ __forceinline__ unsigned f2bf(float f) { unsigned u = __builtin_bit_cast(unsigned, f); return (u + 0x7fffu + ((u >> 16) & 1u)) >> 16; }
__device__ __forceinline__ unsigned pk2(float lo, float hi) { return f2bf(lo) | (f2bf(hi) << 16); }
__device__ __forceinline__ float bf2f(unsigned b) { return __builtin_bit_cast(float, (b & 0xffffu) << 16); }
__device__ __forceinline__ float bflo(unsigned w) { return __builtin_bit_cast(float, w << 16); }
__device__ __forceinline__ float bfhi(unsigned w) { return __builtin_bit_cast(float, w & 0xffff0000u); }
__device__ __forceinline__ float siluf(float x) { return x / (1.0f + __expf(-x)); }
__device__ __forceinline__ float softplusf(float x) { return fmaxf(x, 0.f) + log1pf(__expf(-fabsf(x))); }
__device__ __forceinline__ float wave_sum(float v) {
#pragma unroll
    for (int o = 1; o < 64; o <<= 1) v += __shfl_xor(v, o);
    return v;
}
#define WG_BAR() do { asm volatile("s_waitcnt vmcnt(0) lgkmcnt(0)" ::: "memory"); __builtin_amdgcn_s_barrier(); asm volatile("" ::: "memory"); } while (0)
#define MFMA16(a, b, c) __builtin_amdgcn_mfma_f32_16x16x32_bf16((a), (b), (c), 0, 0, 0)

#define XB_TMO      128
#define XB_XCNT(j)  (256  + 64 * (j))
#define XB_XSUB(j)  (1280 + 64 * (j))
#define XB_XGEN(j)  (2304 + 64 * (j))
#define XB_TOP      3328
#define XB_TOPGEN   3392
#define XCD_BAR_WORDS 3456
#define XB_SPIN_CAP (1u << 18)

__device__ __forceinline__ unsigned xb_ld(unsigned* p)              { return __hip_atomic_load(p, __ATOMIC_RELAXED, __HIP_MEMORY_SCOPE_AGENT); }
__device__ __forceinline__ unsigned xb_add(unsigned* p, unsigned v) { return __hip_atomic_fetch_add(p, v, __ATOMIC_RELAXED, __HIP_MEMORY_SCOPE_AGENT); }
__device__ __forceinline__ unsigned xb_xcc_id() { return (unsigned)__builtin_amdgcn_s_getreg((3 << 11) | 20) & 0xFu; }
#define XB_SPIN(cond, bar) do { unsigned _sp = 0; while (cond) { __builtin_amdgcn_s_sleep(1); \
    if ((++_sp & 255u) == 0u) { if (xb_ld(&(bar)[XB_TMO])) break; if (_sp > XB_SPIN_CAP) { atomicAdd(&(bar)[XB_TMO], 1u); break; } } } } while (0)

struct XcdBarrier {
    unsigned* bar; unsigned x;
    volatile LAS unsigned* st;
};

__device__ __forceinline__ XcdBarrier xcd_barrier_post(unsigned* bar, volatile LAS unsigned* st) {
    XcdBarrier b; b.bar = bar; b.x = xb_xcc_id(); b.st = st;
    if (threadIdx.x == 0) (void)xb_add(&bar[XB_XCNT(b.x)], 1u);
    return b;
}
__device__ __forceinline__ void xcd_barrier_complete(unsigned* bar, unsigned x, unsigned& nloc, unsigned& nx) {
    const unsigned G = gridDim.x * gridDim.y * gridDim.z;
    unsigned sum, cnt, mine, sp = 0u;
    for (;;) {
        sum = 0u; cnt = 0u; mine = 0u;
#pragma unroll
        for (unsigned j = 0; j < 16; ++j) { const unsigned c = xb_ld(&bar[XB_XCNT(j)]); sum += c; cnt += (c > 0u) ? 1u : 0u; mine = (j == x) ? c : mine; }
        if (sum == G) break;
        __builtin_amdgcn_s_sleep(1);
        if ((++sp & 255u) == 0u) { if (xb_ld(&bar[XB_TMO])) break; if (sp > XB_SPIN_CAP) { atomicAdd(&bar[XB_TMO], 1u); break; } }
    }
    nloc = mine > 0u ? mine : 1u; nx = cnt > 0u ? cnt : 1u;
}

__device__ __forceinline__ void xcd_barrier(const XcdBarrier& b) {
    asm volatile("s_waitcnt vmcnt(0)" ::: "memory");
    __syncthreads();
    if (threadIdx.x == 0) {
        unsigned* bar = b.bar;
        __builtin_amdgcn_s_waitcnt(0);
        unsigned nloc = b.st[0], nx = b.st[1];
        if (nloc == 0u) { xcd_barrier_complete(bar, b.x, nloc, nx); b.st[0] = nloc; b.st[1] = nx; }
        const unsigned old = xb_add(&bar[XB_XSUB(b.x)], 1u);
        const unsigned gen = old / nloc;
        if (old + 1u == (gen + 1u) * nloc) {
            __builtin_amdgcn_fence(__ATOMIC_RELEASE, "agent");
            asm volatile("s_waitcnt vmcnt(0)" ::: "memory");
            const unsigned og = xb_add(&bar[XB_TOP], 1u);
            const unsigned tg = og / nx;
            if (og + 1u == (tg + 1u) * nx) xb_add(&bar[XB_TOPGEN], 1u);
            else XB_SPIN(xb_ld(&bar[XB_TOPGEN]) == tg, bar);
            __builtin_amdgcn_fence(__ATOMIC_ACQUIRE, "agent");
            xb_add(&bar[XB_XGEN(b.x)], 1u);
            asm volatile("s_waitcnt vmcnt(0)" ::: "memory");
        } else {
            XB_SPIN(xb_ld(&bar[XB_XGEN(b.x)]) == gen, bar);
            __builtin_amdgcn_fence(__ATOMIC_ACQUIRE, "agent");
            asm volatile("s_waitcnt vmcnt(0)" ::: "memory");
        }
    }
    __syncthreads();
}

struct Frame {
    LAS unsigned char* lds;
    volatile LAS unsigned* MISC;
    gu32* ctl;
    int tid, lane, wave, G, bid;
    LAS unsigned* ptab;
    float* out; unsigned char* ws;
};
__device__ __forceinline__ const float* ld_inp(const Frame& F, int i) {
    const unsigned lo = __builtin_amdgcn_readfirstlane(F.ptab[2 * i]), hi = __builtin_amdgcn_readfirstlane(F.ptab[2 * i + 1]);
    return (const float*)(const GAS float*)(((unsigned long long)hi << 32) | lo);
}
#define INP(i) ld_inp(F, (i))
enum { I_XP = 0, I_XS, I_MEMP, I_CK, I_CV, I_SPOOL, I_SCONV, I_SSSM, I_GFFN1, I_W1G, I_W1U, I_W1D, I_GMIX, I_WIN, I_CONVW, I_CONVB, I_DTB, I_ALOG, I_DSKIP, I_SSMN, I_WPOOL, I_PSCALE, I_WOUT,
       I_GMEM, I_WMK, I_WMV, I_GXQ, I_WXQ, I_WXO, I_GFFN2, I_W2G, I_W2U, I_W2D, I_GFIN };
#define WSP(T, off) ((T*)(F.ws + (off)))

__device__ __forceinline__ void p0_transpose_item(const float* W, int ldw, int N, bf16* WT, int ldt, int kdst, int rowmode, int row_off, const float* gain, float scale, LAS float* scr, int item, int lane) {
    const int nblk = N / 32, kb = item / nblk, nb = item % nblk, k0 = 64 * kb, n0 = 32 * nb;
    { const int kq = lane >> 3, nq = lane & 7; f32x4 v[8];
#pragma unroll
        for (int i = 0; i < 8; ++i) v[i] = *(const f32x4*)(W + (size_t)(k0 + 8 * i + kq) * ldw + n0 + 4 * nq);
#pragma unroll
        for (int i = 0; i < 8; ++i) { const int kk = 8 * i + kq; const float gsc = (gain ? gain[k0 + kk] : 1.0f) * scale; LAS float* d = scr + kk * 33 + 4 * nq; d[0] = v[i].x * gsc; d[1] = v[i].y * gsc; d[2] = v[i].z * gsc; d[3] = v[i].w * gsc; } }
    LDS_WAIT(); asm volatile("" ::: "memory");
    const int rowf = rowmode == 0 ? row_off + n0 : (n0 >> 7) * 256 + (rowmode == 2 ? 128 : 0) + (n0 & 127);
    const int c = lane & 7;
#pragma unroll
    for (int j = 0; j < 4; ++j) { const int n = (lane >> 3) + 8 * j; const LAS float* s = scr + (8 * c) * 33 + n;
        v4u o; o.x = pk2(s[0 * 33], s[1 * 33]); o.y = pk2(s[2 * 33], s[3 * 33]); o.z = pk2(s[4 * 33], s[5 * 33]); o.w = pk2(s[6 * 33], s[7 * 33]);
        *(GAS v4u*)(WT + (size_t)(rowf + n) * ldt + kdst + k0 + 8 * c) = o; }
    LDS_WAIT(); asm volatile("" ::: "memory");
}
__device__ __forceinline__ void row_to_bf16_ssq(const float* xrow, bf16* orow, float* ssq16, int lane) {
    const GAS f32x4* xr = (const GAS f32x4*)xrow + lane;
    f32x4 v[4]; float s = 0.f;
#pragma unroll
    for (int j = 0; j < 4; ++j) { v[j] = xr[64 * j]; s += (v[j].x * v[j].x + v[j].y * v[j].y) + (v[j].z * v[j].z + v[j].w * v[j].w); }
    s = wave_sum(s);
    GAS unsigned long long* o8 = (GAS unsigned long long*)orow + lane;
#pragma unroll
    for (int j = 0; j < 4; ++j) o8[64 * j] = (unsigned long long)pk2(v[j].x, v[j].y) | ((unsigned long long)pk2(v[j].z, v[j].w) << 32);
    if (lane < 16) ssq16[lane] = lane == 0 ? s : 0.f;
}
__device__ __forceinline__ void p0_prologue(Frame& F) {
    LAS float* scr = (LAS float*)(F.lds + RING_OFF + F.wave * 16384);
    const int gw = F.bid * NWAVES + F.wave, NGW = F.G * NWAVES, lane = F.lane;
    constexpr int I_GU = (D / 64) * (FF / 32), I_DN = (FF / 64) * (D / 32), I_IN = (D / 64) * (NIN / 32), I_OUT = (D_SSM / 64) * (D / 32), I_SQ = (D / 64) * (D / 32);
    constexpr int NT = 4 * I_GU + 2 * I_DN + I_IN + I_OUT + 4 * I_SQ;
    for (int it = gw; it < NT; it += NGW) {
        int r = it;
        if (r < I_GU) { p0_transpose_item(INP(I_W1G), FF, FF, WSP(bf16, WS_W1GU), D, 0, 1, 0, INP(I_GFFN1), 1.f, scr, r, lane); continue; } r -= I_GU;
        if (r < I_GU) { p0_transpose_item(INP(I_W1U), FF, FF, WSP(bf16, WS_W1GU), D, 0, 2, 0, INP(I_GFFN1), 1.f, scr, r, lane); continue; } r -= I_GU;
        if (r < I_GU) { p0_transpose_item(INP(I_W2G), FF, FF, WSP(bf16, WS_W2GU), D, 0, 1, 0, INP(I_GFFN2), 1.f, scr, r, lane); continue; } r -= I_GU;
        if (r < I_GU) { p0_transpose_item(INP(I_W2U), FF, FF, WSP(bf16, WS_W2GU), D, 0, 2, 0, INP(I_GFFN2), 1.f, scr, r, lane); continue; } r -= I_GU;
        if (r < I_DN) { p0_transpose_item(INP(I_W1D), D, D, WSP(bf16, WS_W1D), FF, 0, 0, 0, nullptr, 1.f, scr, r, lane); continue; } r -= I_DN;
        if (r < I_DN) { p0_transpose_item(INP(I_W2D), D, D, WSP(bf16, WS_W2D), FF, 0, 0, 0, nullptr, 1.f, scr, r, lane); continue; } r -= I_DN;
        if (r < I_IN) { p0_transpose_item(INP(I_WIN), D_INP, NIN, WSP(bf16, WS_WIN), D, 0, 0, 0, INP(I_GMIX), 1.f, scr, r, lane); continue; } r -= I_IN;
        if (r < I_OUT) { p0_transpose_item(INP(I_WOUT) + (size_t)D_POOL * D, D, D, WSP(bf16, WS_WOUT), D, D_POOL, 0, 0, INP(I_SSMN), 1.f, scr, r, lane); continue; } r -= I_OUT;
        if (r < I_SQ) { p0_transpose_item(INP(I_WXQ), D, D, WSP(bf16, WS_WQ), D, 0, 0, 0, INP(I_GXQ), 0.0625f, scr, r, lane); continue; } r -= I_SQ;
        if (r < I_SQ) { p0_transpose_item(INP(I_WXO), D, D, WSP(bf16, WS_WO), D, 0, 0, 0, nullptr, 1.f, scr, r, lane); continue; } r -= I_SQ;
        if (r < I_SQ) { p0_transpose_item(INP(I_WMK), D, D, WSP(bf16, WS_WMKV), D, 0, 0, 0, INP(I_GMEM), 1.f, scr, r, lane); continue; } r -= I_SQ;
        p0_transpose_item(INP(I_WMV), D, D, WSP(bf16, WS_WMKV), D, 0, 0, D, INP(I_GMEM), 1.f, scr, r, lane);
    }
    { const float* wp = INP(I_WPOOL); const float* ps = INP(I_PSCALE); const float* wo = INP(I_WOUT); bf16* WT = WSP(bf16, WS_WOUT);
        for (int it = gw; it < D; it += NGW) { const int n4 = (it >> 2) * 4, g = it & 3; f32x4 acc = (f32x4){0.f, 0.f, 0.f, 0.f}; const f32x4* wrow = (const f32x4*)(wp + (size_t)(g * 64 + lane) * 64);
#pragma unroll 4
            for (int d4 = 0; d4 < 16; ++d4) { const f32x4 wv = wrow[d4]; const f32x4 pv = *(const f32x4*)(ps + g * 64 + 4 * d4);
#pragma unroll
                for (int j = 0; j < 4; ++j) { const f32x4 o = *(const f32x4*)(wo + (size_t)(g * 64 + 4 * d4 + j) * D + n4); acc += o * (wv[j] * pv[j]); } }
#pragma unroll
            for (int j = 0; j < 4; ++j) WT[(size_t)(n4 + j) * D + g * 64 + lane] = (bf16)f2bf(acc[j]); } }
    { bf16* wt = WSP(bf16, WS_WIN); const float* win = INP(I_WIN); const float* gm = INP(I_GMIX);
        for (int i = F.bid * NTHREADS + F.tid; i < NH * D; i += F.G * NTHREADS) { const int h = i >> 10, k = i & 1023; wt[(size_t)(NIN + h) * D + k] = (bf16)f2bf(gm[k] * win[(size_t)k * D_INP + NIN + h]); }
        v4u* z = (v4u*)(wt + (size_t)(NIN + NH) * D);
        for (int i = F.bid * NTHREADS + F.tid; i < (256 - NH) * D / 8; i += F.G * NTHREADS) z[i] = (v4u){0u, 0u, 0u, 0u}; }
    { const float* xp = INP(I_XP); const float* xs = INP(I_XS);
        for (int m = gw; m < M; m += NGW) { const float* xr = m < MP ? xp + (size_t)m * D : xs + (size_t)(m - MP) * D; row_to_bf16_ssq(xr, WSP(bf16, WS_XB) + (size_t)m * D, WSP(float, WS_SSQ0) + (size_t)m * 16, lane); } }
    for (int m = gw; m < MEMROWS; m += NGW) row_to_bf16_ssq(INP(I_MEMP) + (size_t)m * D, WSP(bf16, WS_MBF) + (size_t)m * D, WSP(float, WS_SSQM) + (size_t)m * 16, lane);
}

constexpr int MX_PITCHB = 272;
constexpr int MX_TILE = 128 * MX_PITCHB;
constexpr int MX_RC = 0, MX_RB = MX_TILE, MX_RBT = 2 * MX_TILE, MX_X1 = 3 * MX_TILE, MX_DT = 4 * MX_TILE, MX_ACS = MX_DT + 3072, MX_DE = MX_ACS + 3072, MX_END = MX_DE + 3072;
static_assert(MX_END <= RING_BYTES, "mix LDS map");

__device__ __forceinline__ void conv_load(const bf16* PROJ, const float* cw, const float* cb, size_t rowbase, int t0, int l0, int col, int cx, unsigned short (&in)[19], float (&wt)[5]) {
#pragma unroll
    for (int i = 0; i < 19; ++i) { const int t = t0 + l0 - 3 + i; const int tt = t < 0 ? 0 : t; const unsigned short x = PROJ[(unsigned)((int)rowbase + tt) * (unsigned)NIN + (unsigned)col]; in[i] = t < 0 ? (unsigned short)0 : x; }
    wt[0] = cw[cx]; wt[1] = cw[CONV_DIM + cx]; wt[2] = cw[2 * CONV_DIM + cx]; wt[3] = cw[3 * CONV_DIM + cx]; wt[4] = cb[cx];
}
__device__ __forceinline__ void conv_eval(const unsigned short (&in)[19], const float (&wt)[5], float (&v)[16]) {
    float f[19];
#pragma unroll
    for (int i = 0; i < 19; ++i) f[i] = bf2f(in[i]);
#pragma unroll
    for (int j = 0; j < 16; ++j) v[j] = siluf(f[j] * wt[0] + f[j + 1] * wt[1] + f[j + 2] * wt[2] + f[j + 3] * wt[3] + wt[4]);
}
template <int W> __device__ __forceinline__ void pool_prompt_chunk(const bf16* PROJ, bf16* A2, float* outp, int b, int t0, int l0, int ucol, bool last_chunk) {
    const size_t rowbase = (size_t)b * SEQ;
    float v[31 + W];
#pragma unroll
    for (int i = 0; i < 31 + W; ++i) { const int t = t0 + l0 - (W - 1) + i; const int tt = t < 0 ? 0 : t; const float x = bf2f(PROJ[(unsigned)((int)rowbase + tt) * (unsigned)NIN + (unsigned)ucol]); v[i] = t < 0 ? 0.f : x; }
#pragma unroll
    for (int i = 0; i < 32; ++i) { float s = 0.f;
#pragma unroll
        for (int j = 0; j < W; ++j) s += v[i + j];
        const int t = t0 + l0 + i; const float cnt = (float)(t + 1 < W ? t + 1 : W);
        const float u = v[i + W - 1], p = s / cnt - u;
        A2[(rowbase + t) * D + ucol] = (bf16)f2bf(p);
        if (last_chunk && t >= SEQ - 15) outp[((size_t)b * 15 + (t - (SEQ - 15))) * D_POOL + ucol] = u; }
}
__device__ __forceinline__ v4u pack8(const float* v) { v4u o; o.x = pk2(v[0], v[1]); o.y = pk2(v[2], v[3]); o.z = pk2(v[4], v[5]); o.w = pk2(v[6], v[7]); return o; }

__device__ __forceinline__ void mix_prompt_item(Frame& F, int b, int c, int g) {
    const int tid = F.tid, lane = F.lane, w = F.wave, fr = lane & 15, fq = lane >> 4;
    const int t0 = c * CHUNK; const size_t rowbase = (size_t)b * SEQ, row0 = rowbase + t0;
    const bf16* PROJ = WSP(const bf16, WS_PROJ); const float* DTR = WSP(const float, WS_DTR);
    float* EXPA = WSP(float, WS_EXPA); float* CDp = WSP(float, WS_CD); bf16* CB = WSP(bf16, WS_CB); float* YD = WSP(float, WS_YD); float* ST = WSP(float, WS_ST); bf16* A2 = WSP(bf16, WS_A2);
    const float* cw = INP(I_CONVW); const float* cbias = INP(I_CONVB);
    LAS float* dtL = (LAS float*)(F.lds + MX_DT); LAS float* acsL = (LAS float*)(F.lds + MX_ACS); LAS float* deL = (LAS float*)(F.lds + MX_DE);
    LAS unsigned char* lds = F.lds;
    const bool lastc = (c == NCH - 1);
    const int cn = tid & 63, lc = tid >> 6, l0 = 16 * lc;
    unsigned short inA[19], inB[19]; float wtA[5], wtB[5];
    { const float* dtb = INP(I_DTB);
        for (int idx = tid; idx < 6 * 128; idx += NTHREADS) { const int hl = idx >> 7, l = idx & 127; dtL[idx] = softplusf(DTR[(row0 + l) * NH + 6 * g + hl] + dtb[6 * g + hl]); } }
    conv_load(PROJ, cw, cbias, rowbase, t0, l0, XBC0 + D_SSM + g * 128 + cn, D_SSM + g * 128 + cn, inA, wtA);
    WG_BAR();
    if (w < 6) { const int h = 6 * g + w; const float a = -__expf(INP(I_ALOG)[h]);
        const float d0 = dtL[w * 128 + 2 * lane], d1 = dtL[w * 128 + 2 * lane + 1]; const float v0 = d0 * a, v1 = d1 * a; float s = v0 + v1;
#pragma unroll
        for (int o = 1; o < 64; o <<= 1) { const float t = __shfl_up(s, o); if (lane >= o) s += t; }
        const float a0 = s - v1, a1 = s, last = __shfl(s, 63);
        acsL[w * 128 + 2 * lane] = a0; acsL[w * 128 + 2 * lane + 1] = a1;
        deL[w * 128 + 2 * lane] = __expf(last - a0) * d0; deL[w * 128 + 2 * lane + 1] = __expf(last - a1) * d1;
        EXPA[(row0 + 2 * lane) * NH + h] = __expf(a0); EXPA[(row0 + 2 * lane + 1) * NH + h] = __expf(a1);
        if (lane == 63) CDp[((size_t)b * NCH + c) * NH + h] = __expf(last); }
#pragma unroll
    for (int rd = 0; rd < 4; ++rd) { const int isC = rd >> 1, hf = rd & 1, cx0 = D_SSM + isC * 256 + g * 128 + hf * 64;
        unsigned short (&cur)[19] = (rd & 1) ? inB : inA; float (&cwt)[5] = (rd & 1) ? wtB : wtA; unsigned short (&nxt)[19] = (rd & 1) ? inA : inB; float (&nwt)[5] = (rd & 1) ? wtA : wtB;
        if (rd < 3) { const int nx0 = D_SSM + ((rd + 1) >> 1) * 256 + g * 128 + ((rd + 1) & 1) * 64; conv_load(PROJ, cw, cbias, rowbase, t0, l0, XBC0 + nx0 + cn, nx0 + cn, nxt, nwt); }
        else conv_load(PROJ, cw, cbias, rowbase, t0, l0, XBC0 + (6 * g) * 64 + cn, (6 * g) * 64 + cn, nxt, nwt);
        float v[16]; conv_eval(cur, cwt, v); const int n = hf * 64 + cn;
        if (!isC) {
#pragma unroll
            for (int j = 0; j < 16; ++j) *(LAS unsigned short*)(lds + MX_RB + (l0 + j) * MX_PITCHB + n * 2) = (unsigned short)f2bf(v[j]);
            *(LAS v4u*)(lds + MX_RBT + n * MX_PITCHB + l0 * 2) = pack8(v); *(LAS v4u*)(lds + MX_RBT + n * MX_PITCHB + l0 * 2 + 16) = pack8(v + 8);
        } else {
#pragma unroll
            for (int j = 0; j < 16; ++j) { const unsigned short q = (unsigned short)f2bf(v[j]); *(LAS unsigned short*)(lds + MX_RC + (l0 + j) * MX_PITCHB + n * 2) = q; CB[(row0 + l0 + j) * 256 + g * 128 + n] = q; }
        }
        if (lastc && lc == 7) {
#pragma unroll
            for (int j = 0; j < 3; ++j) F.out[OUT_CONVP + ((size_t)b * 3 + j) * CONV_DIM + cx0 + cn] = bf2f(cur[16 + j]); }
        __builtin_amdgcn_sched_barrier(0); }
    WG_BAR();
    f32x4 sc[8];
    { bf16x8 cf[4];
#pragma unroll
        for (int ks = 0; ks < 4; ++ks) cf[ks] = *(const LAS bf16x8*)(lds + MX_RC + (16 * w + fr) * MX_PITCHB + (32 * ks + 8 * fq) * 2);
#pragma unroll
        for (int sb = 0; sb < 8; ++sb) { f32x4 a = (f32x4){0.f, 0.f, 0.f, 0.f};
#pragma unroll
            for (int ks = 0; ks < 4; ++ks) { const bf16x8 bf_ = *(const LAS bf16x8*)(lds + MX_RB + (16 * sb + fr) * MX_PITCHB + (32 * ks + 8 * fq) * 2); a = MFMA16(bf_, cf[ks], a); }
            sc[sb] = a; __builtin_amdgcn_sched_barrier(0); } }
    WG_BAR();
    for (int i = lane; i < 256; i += 64) *(LAS v4u*)(lds + MX_RC + (16 * w + (i >> 4)) * MX_PITCHB + (i & 15) * 16) = (v4u){0u, 0u, 0u, 0u};
    for (int hl = 0; hl < 6; ++hl) { const int h = 6 * g + hl; const int xb = (hl & 1) ? MX_X1 : MX_RB;
        if (hl > 0) conv_load(PROJ, cw, cbias, rowbase, t0, l0, XBC0 + h * 64 + cn, h * 64 + cn, inA, wtA);
        { float v[16]; conv_eval(inA, wtA, v);
            *(LAS v4u*)(lds + xb + cn * MX_PITCHB + l0 * 2) = pack8(v); *(LAS v4u*)(lds + xb + cn * MX_PITCHB + l0 * 2 + 16) = pack8(v + 8);
            float vd[16];
#pragma unroll
            for (int j = 0; j < 16; ++j) vd[j] = v[j] * deL[hl * 128 + l0 + j];
            *(LAS v4u*)(lds + xb + (64 + cn) * MX_PITCHB + l0 * 2) = pack8(vd); *(LAS v4u*)(lds + xb + (64 + cn) * MX_PITCHB + l0 * 2 + 16) = pack8(vd + 8);
            if (lastc && lc == 7) {
#pragma unroll
                for (int j = 0; j < 3; ++j) F.out[OUT_CONVP + ((size_t)b * 3 + j) * CONV_DIM + h * 64 + cn] = bf2f(inA[16 + j]); } }
        __builtin_amdgcn_sched_barrier(0);
        { const int l = 16 * w + fr; const float al = acsL[hl * 128 + l];
#pragma unroll
            for (int sb = 0; sb < 8; ++sb) if (sb <= w) { const int s0 = 16 * sb + 4 * fq; const f32x4 as = *(const LAS f32x4*)(acsL + hl * 128 + s0), ds = *(const LAS f32x4*)(dtL + hl * 128 + s0);
                float o[4];
#pragma unroll
                for (int r = 0; r < 4; ++r) o[r] = (s0 + r <= l) ? sc[sb][r] * __expf(fminf(al - as[r], 0.f)) * ds[r] : 0.f;
                v2u pw; pw.x = pk2(o[0], o[1]); pw.y = pk2(o[2], o[3]); *(LAS v2u*)(lds + MX_RC + l * MX_PITCHB + s0 * 2) = pw; } }
        WG_BAR();
        __builtin_amdgcn_sched_barrier(0);
        { f32x4 ya[4];
#pragma unroll
            for (int pb = 0; pb < 4; ++pb) ya[pb] = (f32x4){0.f, 0.f, 0.f, 0.f};
#pragma unroll
            for (int ks = 0; ks < 4; ++ks) if (32 * ks <= 16 * w + 15) { const bf16x8 wf = *(const LAS bf16x8*)(lds + MX_RC + (16 * w + fr) * MX_PITCHB + (32 * ks + 8 * fq) * 2);
#pragma unroll
                for (int pb = 0; pb < 4; ++pb) { const bf16x8 xf = *(const LAS bf16x8*)(lds + xb + (16 * pb + fr) * MX_PITCHB + (32 * ks + 8 * fq) * 2); ya[pb] = MFMA16(xf, wf, ya[pb]); }
                __builtin_amdgcn_sched_barrier(0); }
            const float dsk = INP(I_DSKIP)[h]; const int l = 16 * w + fr;
#pragma unroll
            for (int pb = 0; pb < 4; ++pb) { f32x4 o;
#pragma unroll
                for (int r = 0; r < 4; ++r) { const int p = 16 * pb + 4 * fq + r; o[r] = ya[pb][r] + dsk * bf2f(*(const LAS unsigned short*)(lds + xb + p * MX_PITCHB + l * 2)); }
                *(f32x4*)(YD + (row0 + l) * D_SSM + h * 64 + 16 * pb + 4 * fq) = o; } }
        __builtin_amdgcn_sched_barrier(0);
        { f32x4 sa[4];
#pragma unroll
            for (int pb = 0; pb < 4; ++pb) sa[pb] = (f32x4){0.f, 0.f, 0.f, 0.f};
#pragma unroll
            for (int ks = 0; ks < 4; ++ks) { const bf16x8 bf_ = *(const LAS bf16x8*)(lds + MX_RBT + (16 * w + fr) * MX_PITCHB + (32 * ks + 8 * fq) * 2);
#pragma unroll
                for (int pb = 0; pb < 4; ++pb) { const bf16x8 xf = *(const LAS bf16x8*)(lds + xb + (64 + 16 * pb + fr) * MX_PITCHB + (32 * ks + 8 * fq) * 2); sa[pb] = MFMA16(bf_, xf, sa[pb]); }
                __builtin_amdgcn_sched_barrier(0); }
#pragma unroll
            for (int pb = 0; pb < 4; ++pb) *(f32x4*)(ST + ((((size_t)b * NCH + c) * NH + h) * HD + 16 * pb + fr) * NST + 16 * w + 4 * fq) = sa[pb]; }
 }
    { const int cc = tid & 127, lq = tid >> 7, ucol = g * 128 + cc; const int grp = __builtin_amdgcn_readfirstlane(ucol >> 6);
        float* outp = F.out + OUT_POOLP;
        if (grp == 0) pool_prompt_chunk<2>(PROJ, A2, outp, b, t0, 32 * lq, ucol, lastc);
        else if (grp == 1) pool_prompt_chunk<4>(PROJ, A2, outp, b, t0, 32 * lq, ucol, lastc);
        else if (grp == 2) pool_prompt_chunk<8>(PROJ, A2, outp, b, t0, 32 * lq, ucol, lastc);
        else pool_prompt_chunk<16>(PROJ, A2, outp, b, t0, 32 * lq, ucol, lastc); }
    WG_BAR();
}

constexpr int SM_XS = 0, SM_BM = 6144, SM_CM = 8192, SM_G = 10240, SM_DT = 16384, SM_ACS = SM_DT + 96, SM_DE = SM_ACS + 96, SM_EA = SM_DE + 96, SM_CD = SM_EA + 96, SM_SC = SM_CD + 32, SM_SSQ = SM_SC + 64;
constexpr int XSG = D_SSM / 2;
template <int W> __device__ __forceinline__ void pool_sample4(const float* sp, const bf16* PROJ, float* outp, int b, size_t r0, int c, float (&p)[4]) {
    float v[19];
#pragma unroll
    for (int i = 0; i < 15; ++i) v[i] = sp[((size_t)b * 15 + i) * D_POOL + c];
#pragma unroll
    for (int t = 0; t < 4; ++t) v[15 + t] = bf2f(PROJ[(r0 + t) * NIN + c]);
#pragma unroll
    for (int t = 0; t < 4; ++t) { float s = 0.f;
#pragma unroll
        for (int j = 0; j < W; ++j) s += v[15 + t - (W - 1) + j];
        p[t] = s * (1.0f / W) - v[15 + t]; }
#pragma unroll
    for (int i = 0; i < 15; ++i) outp[((size_t)b * 15 + i) * D_POOL + c] = v[4 + i];
}
__device__ __forceinline__ void mix_sample_item(Frame& F, int b, int g) {
    const int tid = F.tid, lane = F.lane, w = F.wave, fr = lane & 15, fq = lane >> 4; const size_t r0 = (size_t)MP + 4 * b;
    const bf16* PROJ = WSP(const bf16, WS_PROJ); const float* DTR = WSP(const float, WS_DTR);
    bf16* A2 = WSP(bf16, WS_A2); float* SSQY = WSP(float, WS_SSQY);
    LAS unsigned char* lds = F.lds;
    LAS float* xsL = (LAS float*)(lds + SM_XS); LAS float* BmL = (LAS float*)(lds + SM_BM); LAS float* CmL = (LAS float*)(lds + SM_CM); LAS float* gL = (LAS float*)(lds + SM_G);
    LAS float* dtS = (LAS float*)(lds + SM_DT); LAS float* acsS = (LAS float*)(lds + SM_ACS); LAS float* deS = (LAS float*)(lds + SM_DE); LAS float* eaS = (LAS float*)(lds + SM_EA);
    LAS float* cdS = (LAS float*)(lds + SM_CD); LAS float* scS = (LAS float*)(lds + SM_SC); LAS float* ssqS = (LAS float*)(lds + SM_SSQ);
    { const float* scv = INP(I_SCONV); const float* cw = INP(I_CONVW); const float* cbias = INP(I_CONVB);
        for (int j = tid; j < XSG + 256; j += NTHREADS) { const int cx = j < XSG ? g * XSG + j : (j < XSG + 128 ? D_SSM + g * 128 + (j - XSG) : D_SSM + 256 + g * 128 + (j - XSG - 128)); float e[7];
#pragma unroll
            for (int i = 0; i < 3; ++i) e[i] = scv[((size_t)b * 3 + i) * CONV_DIM + cx];
#pragma unroll
            for (int t = 0; t < 4; ++t) e[3 + t] = bf2f(PROJ[(r0 + t) * NIN + XBC0 + cx]);
            const float w0 = cw[cx], w1 = cw[CONV_DIM + cx], w2 = cw[2 * CONV_DIM + cx], w3 = cw[3 * CONV_DIM + cx], bb = cbias[cx];
#pragma unroll
            for (int t = 0; t < 4; ++t) { const float o = siluf(e[t] * w0 + e[t + 1] * w1 + e[t + 2] * w2 + e[t + 3] * w3 + bb);
                if (j < XSG) xsL[t * XSG + j] = o; else if (j < XSG + 128) BmL[t * 128 + j - XSG] = o; else CmL[t * 128 + j - XSG - 128] = o; }
#pragma unroll
            for (int jj = 0; jj < 3; ++jj) F.out[OUT_CONVS + ((size_t)b * 3 + jj) * CONV_DIM + cx] = e[4 + jj]; } }
    float pp[4] = {0.f, 0.f, 0.f, 0.f};
    if (tid < 128) { const int ucol = g * 128 + tid; const int grp = __builtin_amdgcn_readfirstlane(ucol >> 6); const float* sp = INP(I_SPOOL); float* outp = F.out + OUT_POOLS;
        if (grp == 0) pool_sample4<2>(sp, PROJ, outp, b, r0, ucol, pp); else if (grp == 1) pool_sample4<4>(sp, PROJ, outp, b, r0, ucol, pp);
        else if (grp == 2) pool_sample4<8>(sp, PROJ, outp, b, r0, ucol, pp); else pool_sample4<16>(sp, PROJ, outp, b, r0, ucol, pp); }
    else if (tid >= 256 && tid < 280) { const int i = tid - 256, t = i / 6, hl = i - 6 * t; dtS[t * 6 + hl] = softplusf(DTR[(r0 + t) * NH + 6 * g + hl] + INP(I_DTB)[6 * g + hl]); }
    WG_BAR();
    if (tid < 6) { const int h = 6 * g + tid; const float a = -__expf(INP(I_ALOG)[h]); float acc = 0.f, ac[4];
#pragma unroll
        for (int t = 0; t < 4; ++t) { acc += dtS[t * 6 + tid] * a; ac[t] = acc; acsS[t * 6 + tid] = acc; }
#pragma unroll
        for (int t = 0; t < 4; ++t) { deS[t * 6 + tid] = __expf(acc - ac[t]) * dtS[t * 6 + tid]; eaS[t * 6 + tid] = __expf(ac[t]); }
        cdS[tid] = __expf(acc); }
#pragma unroll
    for (int k = 0; k < 2; ++k) { const int idx = 2 * w + k, l = idx >> 2, s = idx & 3;
        float v = CmL[l * 128 + lane] * BmL[s * 128 + lane] + CmL[l * 128 + 64 + lane] * BmL[s * 128 + 64 + lane];
        v = wave_sum(v); if (lane == 0) scS[idx] = v; }
    WG_BAR();
    { const float* h0 = INP(I_SSSM); float* hout = F.out + OUT_SSMS;
        bf16x8 cf[4];
#pragma unroll
        for (int ks = 0; ks < 4; ++ks) { v4u q = (v4u){0u, 0u, 0u, 0u};
            if (fr < 4) { const LAS float* cp = CmL + fr * 128 + 32 * ks + 8 * fq; q.x = pk2(cp[0], cp[1]); q.y = pk2(cp[2], cp[3]); q.z = pk2(cp[4], cp[5]); q.w = pk2(cp[6], cp[7]); }
            cf[ks] = __builtin_bit_cast(bf16x8, q); }
        f32x4 hv[3][4][2];
#pragma unroll
        for (int i = 0; i < 3; ++i) { const int blk = 3 * w + i, hl = blk >> 2, pb = blk & 3, h = 6 * g + hl, p = 16 * pb + fr;
#pragma unroll
            for (int ks = 0; ks < 4; ++ks) { const size_t off = (((size_t)b * NH + h) * HD + p) * NST + 32 * ks + 8 * fq; hv[i][ks][0] = *(const f32x4*)(h0 + off); hv[i][ks][1] = *(const f32x4*)(h0 + off + 4); } }
#pragma unroll
        for (int i = 0; i < 3; ++i) { const int blk = 3 * w + i, hl = blk >> 2, pb = blk & 3, h = 6 * g + hl, p = 16 * pb + fr;
            const float cdh = cdS[hl]; float cx[4];
#pragma unroll
            for (int l = 0; l < 4; ++l) cx[l] = deS[l * 6 + hl] * xsL[l * XSG + hl * 64 + p];
            f32x4 acc = (f32x4){0.f, 0.f, 0.f, 0.f};
#pragma unroll
            for (int ks = 0; ks < 4; ++ks) { const int n0 = 32 * ks + 8 * fq; const size_t off = (((size_t)b * NH + h) * HD + p) * NST + n0;
                const f32x4 a0 = hv[i][ks][0], a1 = hv[i][ks][1];
                v4u q; q.x = pk2(a0.x, a0.y); q.y = pk2(a0.z, a0.w); q.z = pk2(a1.x, a1.y); q.w = pk2(a1.z, a1.w);
                acc = MFMA16(__builtin_bit_cast(bf16x8, q), cf[ks], acc);
                f32x4 o0 = a0 * cdh, o1 = a1 * cdh;
#pragma unroll
                for (int l = 0; l < 4; ++l) { const f32x4 b0 = *(const LAS f32x4*)(BmL + l * 128 + n0), b1 = *(const LAS f32x4*)(BmL + l * 128 + n0 + 4); o0 += b0 * cx[l]; o1 += b1 * cx[l]; }
                *(f32x4*)(hout + off) = o0; *(f32x4*)(hout + off + 4) = o1; }
            if (fr < 4) { const int l = fr; const float eal = eaS[l * 6 + hl], dsk = INP(I_DSKIP)[h], al = acsS[l * 6 + hl];
#pragma unroll
                for (int r = 0; r < 4; ++r) { const int pc = hl * 64 + 16 * pb + 4 * fq + r; float y = eal * acc[r] + dsk * xsL[l * XSG + pc];
#pragma unroll
                    for (int s = 0; s < 4; ++s) if (s <= l) y += scS[l * 4 + s] * __expf(al - acsS[s * 6 + hl]) * dtS[s * 6 + hl] * xsL[s * XSG + pc];
                    const float z = bf2f(PROJ[(r0 + l) * NIN + D_POOL + g * XSG + pc]); gL[l * XSG + pc] = y * siluf(z); } } } }
    WG_BAR();
    if (w < 4) { float s = 0.f;
#pragma unroll
        for (int j = 0; j < 6; ++j) { const float v = gL[w * XSG + lane + 64 * j]; s += v * v; }
        s = wave_sum(s); if (lane == 0) ssqS[w] = s; }
    WG_BAR();
#pragma unroll
    for (int t = 0; t < 4; ++t) {
        if (tid < XSG) A2[(r0 + t) * D + D_POOL + g * XSG + tid] = (bf16)f2bf(gL[t * XSG + tid]);
        if (tid < 128) A2[(r0 + t) * D + g * 128 + tid] = (bf16)f2bf(pp[t]);
        if (g == 0) { if (tid < 16 && tid != 1) SSQY[(r0 + t) * 16 + tid] = tid == 0 ? ssqS[t] * (1024.0f / D_SSM) : 0.f; }
        else if (tid == 1) SSQY[(r0 + t) * 16 + 1] = ssqS[t] * (1024.0f / D_SSM); }
    WG_BAR();
}

__device__ __forceinline__ void scan_phase(Frame& F) {
    const float* ST = WSP(const float, WS_ST); const float* CDp = WSP(const float, WS_CD); bf16* HP = WSP(bf16, WS_HP); float* outp = F.out + OUT_SSMP;
    constexpr size_t CS = (size_t)NH * HD * NST;
    for (int idx = F.bid * NTHREADS + F.tid; idx < BATCH * NH * HD * (NST / 4); idx += F.G * NTHREADS) { const int n4 = idx & 31, p = (idx >> 5) & 63, bh = idx >> 11, h = bh % NH, b = bh / NH;
        const size_t base = ((((size_t)b * NCH) * NH + h) * HD + p) * NST + 4 * n4;
        f32x4 st[NCH];
#pragma unroll
        for (int c = 0; c < NCH; ++c) st[c] = *(const f32x4*)(ST + base + c * CS);
        f32x4 run = (f32x4){0.f, 0.f, 0.f, 0.f};
#pragma unroll
        for (int c = 0; c < NCH; ++c) { v2u q; q.x = pk2(run.x, run.y); q.y = pk2(run.z, run.w); *(v2u*)(HP + base + c * CS) = q; run = run * CDp[((size_t)b * NCH + c) * NH + h] + st[c]; }
        *(f32x4*)(outp + (((size_t)b * NH + h) * HD + p) * NST + 4 * n4) = run; }
}

__device__ __forceinline__ void mixc_item(Frame& F, int b, int c, int hf) {
    const int tid = F.tid, lane = F.lane, w = F.wave, fr = lane & 15, fq = lane >> 4, lb = w & 3, grp = w >> 2;
    const bf16* PROJ = WSP(const bf16, WS_PROJ); const float* EXPA = WSP(const float, WS_EXPA); const bf16* CB = WSP(const bf16, WS_CB); const float* YD = WSP(const float, WS_YD); const bf16* HP = WSP(const bf16, WS_HP);
    bf16* A2 = WSP(bf16, WS_A2); float* SSQY = WSP(float, WS_SSQY);
    LAS float* ssqL = (LAS float*)(F.lds);
    const size_t rowb = (size_t)b * SEQ + c * CHUNK + 64 * hf; const size_t row = rowb + 16 * lb + fr;
    bf16x8 cf[4];
#pragma unroll
    for (int ks = 0; ks < 4; ++ks) cf[ks] = *(const bf16x8*)(CB + row * 256 + grp * 128 + 32 * ks + 8 * fq);
    float ssq = 0.f;
    for (int hl = 0; hl < 6; ++hl) { const int h = 6 * grp + hl; const float ea = EXPA[row * NH + h]; const bf16* hp = HP + ((((size_t)b * NCH + c) * NH + h) * HD) * NST;
        bf16x8 af[4][4]; f32x4 yd[4]; v2u zz[4];
#pragma unroll
        for (int pb = 0; pb < 4; ++pb) { const int p0 = h * 64 + 16 * pb + 4 * fq;
#pragma unroll
            for (int ks = 0; ks < 4; ++ks) af[pb][ks] = *(const bf16x8*)(hp + (size_t)(16 * pb + fr) * NST + 32 * ks + 8 * fq);
            yd[pb] = *(const f32x4*)(YD + row * D_SSM + p0); zz[pb] = *(const v2u*)(PROJ + row * NIN + D_POOL + p0); }
#pragma unroll
        for (int pb = 0; pb < 4; ++pb) { f32x4 acc = (f32x4){0.f, 0.f, 0.f, 0.f};
#pragma unroll
            for (int ks = 0; ks < 4; ++ks) acc = MFMA16(af[pb][ks], cf[ks], acc);
            const int p0 = h * 64 + 16 * pb + 4 * fq;
            const float g0 = (yd[pb][0] + ea * acc[0]) * siluf(bflo(zz[pb].x)), g1 = (yd[pb][1] + ea * acc[1]) * siluf(bfhi(zz[pb].x)), g2 = (yd[pb][2] + ea * acc[2]) * siluf(bflo(zz[pb].y)), g3 = (yd[pb][3] + ea * acc[3]) * siluf(bfhi(zz[pb].y));
            ssq += (g0 * g0 + g1 * g1) + (g2 * g2 + g3 * g3);
            v2u q; q.x = pk2(g0, g1); q.y = pk2(g2, g3); *(v2u*)(A2 + row * D + D_POOL + p0) = q; } }
    ssq += __shfl_xor(ssq, 16); ssq += __shfl_xor(ssq, 32);
    if (fq == 0) ssqL[grp * 64 + 16 * lb + fr] = ssq;
    WG_BAR();
    { const int rl = tid >> 3, seg = tid & 7; const float tot = ssqL[rl] + ssqL[64 + rl]; const float rsinv = sqrtf(tot * (1.0f / D_SSM) + EPS); const size_t r = rowb + rl;
#pragma unroll
        for (int i = 0; i < 4; ++i) { v4u q = *(const v4u*)(A2 + r * D + seg * 32 + 8 * i);
            q.x = pk2(bflo(q.x) * rsinv, bfhi(q.x) * rsinv); q.y = pk2(bflo(q.y) * rsinv, bfhi(q.y) * rsinv); q.z = pk2(bflo(q.z) * rsinv, bfhi(q.z) * rsinv); q.w = pk2(bflo(q.w) * rsinv, bfhi(q.w) * rsinv);
            *(v4u*)(A2 + r * D + seg * 32 + 8 * i) = q; }
        if (seg < 4) *(f32x4*)(SSQY + r * 16 + 4 * seg) = (f32x4){seg == 0 ? tot * (1024.0f / D_SSM) : 0.f, 0.f, 0.f, 0.f}; }
    WG_BAR();
}

__device__ __forceinline__ void sample_pool_rescale(Frame& F, int it) {
    const int rl = F.tid >> 3, seg = F.tid & 7; const size_t r = (size_t)MP + 64 * it + rl; bf16* A2 = WSP(bf16, WS_A2); const float* SSQY = WSP(const float, WS_SSQY);
    const float tot = (SSQY[r * 16] + SSQY[r * 16 + 1]) * (D_SSM / 1024.0f); const float rsinv = sqrtf(tot * (1.0f / D_SSM) + EPS);
#pragma unroll
    for (int i = 0; i < 4; ++i) { v4u q = *(const v4u*)(A2 + r * D + seg * 32 + 8 * i);
        q.x = pk2(bflo(q.x) * rsinv, bfhi(q.x) * rsinv); q.y = pk2(bflo(q.y) * rsinv, bfhi(q.y) * rsinv); q.z = pk2(bflo(q.z) * rsinv, bfhi(q.z) * rsinv); q.w = pk2(bflo(q.w) * rsinv, bfhi(q.w) * rsinv);
        *(v4u*)(A2 + r * D + seg * 32 + 8 * i) = q; }
}

constexpr int SA_REDM = 0, SA_REDS = 512, SA_P = 1024, SA_O = 1024 + 8192;
__device__ __forceinline__ void attn_sample_item(Frame& F, int b, int hp) {
    const int tid = F.tid, lane = F.lane, w = F.wave, fr = lane & 15, fq = lane >> 4, hl = w >> 2, kq = w & 3, h = 2 * hp + hl; const size_t r0 = (size_t)MP + 4 * b;
    const bf16* Q = WSP(const bf16, WS_Q); bf16* O = WSP(bf16, WS_O); const float* ck = INP(I_CK); const float* cv = INP(I_CV);
    LAS float* redM = (LAS float*)(F.lds + SA_REDM); LAS float* redS = (LAS float*)(F.lds + SA_REDS); LAS float* pL = (LAS float*)(F.lds + SA_P); LAS float* oL = (LAS float*)(F.lds + SA_O);
    bf16x8 qf[8];
#pragma unroll
    for (int ks = 0; ks < 8; ++ks) { v4u q = (v4u){0u, 0u, 0u, 0u}; if (fr < 4) q = *(const v4u*)(Q + (r0 + fr) * D + h * 256 + 32 * ks + 8 * fq); qf[ks] = __builtin_bit_cast(bf16x8, q); }
    f32x4 s[4];
#pragma unroll
    for (int mb = 0; mb < 4; ++mb) { const int m = 64 * kq + 16 * mb + fr; const float* kp = ck + (((size_t)b * NMEM + m) * 4 + h) * 256 + 8 * fq; f32x4 acc = (f32x4){0.f, 0.f, 0.f, 0.f};
#pragma unroll
        for (int ks = 0; ks < 8; ++ks) { const f32x4 a0 = *(const f32x4*)(kp + 32 * ks), a1 = *(const f32x4*)(kp + 32 * ks + 4);
            v4u q; q.x = pk2(a0.x, a0.y); q.y = pk2(a0.z, a0.w); q.z = pk2(a1.x, a1.y); q.w = pk2(a1.z, a1.w); acc = MFMA16(__builtin_bit_cast(bf16x8, q), qf[ks], acc); }
        s[mb] = acc; }
    float mx = -3.0e38f;
#pragma unroll
    for (int mb = 0; mb < 4; ++mb) mx = fmaxf(mx, fmaxf(fmaxf(s[mb][0], s[mb][1]), fmaxf(s[mb][2], s[mb][3])));
    mx = fmaxf(mx, __shfl_xor(mx, 16)); mx = fmaxf(mx, __shfl_xor(mx, 32));
    if (fq == 0) redM[w * 16 + fr] = mx;
    WG_BAR();
    mx = fmaxf(fmaxf(redM[(4 * hl) * 16 + fr], redM[(4 * hl + 1) * 16 + fr]), fmaxf(redM[(4 * hl + 2) * 16 + fr], redM[(4 * hl + 3) * 16 + fr]));
    float sm = 0.f;
#pragma unroll
    for (int mb = 0; mb < 4; ++mb)
#pragma unroll
        for (int r = 0; r < 4; ++r) { const float p = __expf(s[mb][r] - mx); sm += p; if (fr < 4) pL[(hl * 256 + 64 * kq + 16 * mb + 4 * fq + r) * 4 + fr] = p; }
    sm += __shfl_xor(sm, 16); sm += __shfl_xor(sm, 32);
    if (fq == 0) redS[w * 16 + fr] = sm;
    WG_BAR();
    f32x4 o[4];
#pragma unroll
    for (int t = 0; t < 4; ++t) o[t] = (f32x4){0.f, 0.f, 0.f, 0.f};
    { const float* vp = cv + (((size_t)b * NMEM + 64 * kq) * 4 + h) * 256 + 4 * lane;
#pragma unroll 8
        for (int mi = 0; mi < 64; ++mi) { const f32x4 v = *(const f32x4*)(vp + (size_t)mi * 1024); const f32x4 pv = *(const LAS f32x4*)(pL + (hl * 256 + 64 * kq + mi) * 4);
#pragma unroll
            for (int t = 0; t < 4; ++t) o[t] += v * pv[t]; } }
#pragma unroll
    for (int t = 0; t < 4; ++t) *(LAS f32x4*)(oL + (w * 4 + t) * 256 + 4 * lane) = o[t];
    WG_BAR();
    { const int h2 = tid >> 8, t = (tid >> 6) & 3, d4 = (tid & 63) * 4; f32x4 a = (f32x4){0.f, 0.f, 0.f, 0.f}; float l = 0.f;
#pragma unroll
        for (int k = 0; k < 4; ++k) { a += *(const LAS f32x4*)(oL + ((4 * h2 + k) * 4 + t) * 256 + d4); l += redS[(4 * h2 + k) * 16 + t]; }
        const float inv = 1.0f / l; v2u q; q.x = pk2(a.x * inv, a.y * inv); q.y = pk2(a.z * inv, a.w * inv);
        *(v2u*)(O + (r0 + t) * D + (2 * hp + h2) * 256 + d4) = q; }
    WG_BAR();
}


__device__ __forceinline__ f32x4 skinny_acc(Frame& F, const bf16* A, int lda, const bf16* Bt, int ldb, int K, int mi, int ni) {
    const int w = F.wave, lane = F.lane, fr = lane & 15, fq = lane >> 4; const int kw = K >> 3, nks = kw >> 5;
    const bf16* ap = A + (size_t)(32 * mi + fr) * lda + w * kw + 8 * fq; const bf16* bp = Bt + (size_t)(64 * ni + fr) * ldb + w * kw + 8 * fq;
    f32x4 acc[2][4];
#pragma unroll
    for (int r = 0; r < 2; ++r)
#pragma unroll
        for (int c = 0; c < 4; ++c) acc[r][c] = (f32x4){0.f, 0.f, 0.f, 0.f};
    for (int ks0 = 0; ks0 < nks; ks0 += 4) { bf16x8 a[4][2], b[4][4];
#pragma unroll
        for (int j = 0; j < 4; ++j) if (ks0 + j < nks) { const int k = 32 * (ks0 + j);
#pragma unroll
            for (int r = 0; r < 2; ++r) a[j][r] = *(const bf16x8*)(ap + (size_t)(16 * r) * lda + k);
#pragma unroll
            for (int c = 0; c < 4; ++c) b[j][c] = *(const bf16x8*)(bp + (size_t)(16 * c) * ldb + k); }
#pragma unroll
        for (int j = 0; j < 4; ++j) if (ks0 + j < nks) {
#pragma unroll
            for (int r = 0; r < 2; ++r)
#pragma unroll
                for (int c = 0; c < 4; ++c) acc[r][c] = MFMA16(b[j][c], a[j][r], acc[r][c]); } }
    LAS f32x4* red = (LAS f32x4*)F.lds;
#pragma unroll
    for (int r = 0; r < 2; ++r)
#pragma unroll
        for (int c = 0; c < 4; ++c) red[(w * 8 + r * 4 + c) * 64 + lane] = acc[r][c];
    WG_BAR();
    f32x4 o = (f32x4){0.f, 0.f, 0.f, 0.f};
#pragma unroll
    for (int ww = 0; ww < 8; ++ww) o += red[(ww * 8 + w) * 64 + lane];
    WG_BAR();
    return o;
}
__device__ __forceinline__ void skinny_resid(Frame& F, int unit, const bf16* A, int lda, const bf16* Bt, int K, const float* res, float* out, bf16* outb, float alpha, const float* ssq_in, float* ssq_out) {
    const int w = F.wave, lane = F.lane, fr = lane & 15, fq = lane >> 4, rb = w >> 2, cb = w & 3, mi = unit >> 4, ni = unit & 15;
    const int row = 32 * mi + 16 * rb + fr, col0 = 64 * ni + 16 * cb + 4 * fq;
    const f32x4 acc = skinny_acc(F, A, lda, Bt, K, K, mi, ni);
    const float sc = alpha * (ssq_in ? pg8::rstd16(ssq_in, row) : 1.0f);
    const f32x4 o = *(const f32x4*)(res + (size_t)row * D + col0) + acc * sc;
    *(f32x4*)(out + (size_t)row * D + col0) = o;
    if (outb) { v2u q; q.x = pk2(o[0], o[1]); q.y = pk2(o[2], o[3]); *(v2u*)(outb + (size_t)row * D + col0) = q; }
    float q = (o[0] * o[0] + o[1] * o[1]) + (o[2] * o[2] + o[3] * o[3]); q += __shfl_xor(q, 16); q += __shfl_xor(q, 32);
    LAS float* red = (LAS float*)F.lds;
    if (fq == 0) red[(16 * rb + fr) * 4 + cb] = q;
    WG_BAR();
    if (F.tid < 32) { const f32x4 r4 = *(const LAS f32x4*)(red + F.tid * 4); ssq_out[(size_t)(32 * mi + F.tid) * 16 + ni] = (r4[0] + r4[1]) + (r4[2] + r4[3]); }
    WG_BAR();
}
__device__ __forceinline__ void skinny_rowbf16(Frame& F, int unit, const bf16* A, int lda, const bf16* Bt, int K, bf16* O, const float* ssq_in) {
    const int w = F.wave, lane = F.lane, fr = lane & 15, fq = lane >> 4, rb = w >> 2, cb = w & 3, mi = unit >> 4, ni = unit & 15;
    const int row = 32 * mi + 16 * rb + fr, col0 = 64 * ni + 16 * cb + 4 * fq;
    const f32x4 acc = skinny_acc(F, A, lda, Bt, K, K, mi, ni);
    const float sc = ssq_in ? pg8::rstd16(ssq_in, row) : 1.0f;
    v2u q; q.x = pk2(acc[0] * sc, acc[1] * sc); q.y = pk2(acc[2] * sc, acc[3] * sc); *(v2u*)(O + (size_t)row * D + col0) = q;
}

__device__ __forceinline__ void final_norm_phase(Frame& F) {
    const float* SSQ4 = WSP(const float, WS_SSQ4); const float* gf = INP(I_GFIN); const int gw = F.bid * NWAVES + F.wave, NGW = F.G * NWAVES, lane = F.lane;
    f32x4 gv[4];
#pragma unroll
    for (int j = 0; j < 4; ++j) gv[j] = *(const f32x4*)(gf + 4 * lane + 256 * j);
    for (int m = gw; m < M; m += NGW) { const float rs = pg8::rstd16(SSQ4, m); float* yr = F.out + OUT_Y + (size_t)m * D;
#pragma unroll
        for (int j = 0; j < 4; ++j) { f32x4 v = *(const f32x4*)(yr + 4 * lane + 256 * j); v = v * rs * gv[j]; *(f32x4*)(yr + 4 * lane + 256 * j) = v; } }
}

struct Args { const float* in[34]; float* out; unsigned char* ws; int ph_lo, ph_hi, li, pad; };
__global__ void __launch_bounds__(NTHREADS, 2) mega_fwd(Args args) {
    extern __shared__ __attribute__((aligned(16))) unsigned char lds[];
    Frame F;
    F.lds = (LAS unsigned char*)lds;
    F.MISC = (volatile LAS unsigned*)(F.lds + MISC_OFF);
    F.tid = threadIdx.x; F.lane = F.tid & 63; F.wave = __builtin_amdgcn_readfirstlane(F.tid >> 6);
    F.G = gridDim.x; F.bid = blockIdx.x;
    F.out = args.out; F.ws = args.ws; F.ptab = (LAS unsigned*)(F.lds + LDSCTL_OFF);
    F.ctl = (gu32*)(F.ws + WS_CTL);
    for (int u = F.tid; u < (LDS_BYTES - LDSCTL_OFF) / 4; u += NTHREADS) ((LAS unsigned*)(F.lds + LDSCTL_OFF))[u] = 0u;
    __syncthreads();
    if (F.tid == 0) {
#pragma unroll
        for (int i = 0; i < 34; ++i) { const unsigned long long p = (unsigned long long)args.in[i]; F.ptab[2 * i] = (unsigned)p; F.ptab[2 * i + 1] = (unsigned)(p >> 32); } }
    __syncthreads();
    XcdBarrier bar; bar.bar = (unsigned*)(F.ctl + CW_BAR) + args.li * XCD_BAR_WORDS; bar.x = 0; bar.st = nullptr;
    if (N_LAUNCHES == 1) bar = xcd_barrier_post((unsigned*)(F.ctl + CW_BAR), F.MISC + 8);
    const int lo = args.ph_lo, hi = args.ph_hi;
#ifndef PHMASK
#define PHMASK 0x7fff
#endif
#define IN(k) ((((PHMASK) >> (k)) & 1) && lo <= (k) && (k) < hi)
#define SEAM(k) do { if (IN(k) && IN((k) + 1)) xcd_barrier(bar); } while (0)
    PG8_LAS unsigned char* ring = (PG8_LAS unsigned char*)(F.lds + RING_OFF);
    const float alpha_ip = args.pad ? 0.0f : 1.0f;
    int K256 = 256; asm volatile("" : "+s"(K256));
    const pg8::bf16_t* XB = WSP(const pg8::bf16_t, WS_XB);
    float* X = WSP(float, WS_X);

    if (IN(0)) { p0_prologue(F); } SEAM(0);
    if (IN(1)) {
        { pg8::Gemm g{XB, WSP(const pg8::bf16_t, WS_W1GU), M, NGU, D, D, D}; pg8::StaticOrder S; S.init(M, NGU, F.G, F.bid);
          pg8::EpiGateUp E{WSP(pg8::bf16_t, WS_ACT), FF, WSP(const float, WS_SSQ0)};
          pg8::gemm_phase<pg8::EpiGateUp, pg8::StaticOrder, true, true>(ring, g, S, E); }
        { pg8::Gemm g{WSP(const pg8::bf16_t, WS_MBF), WSP(const pg8::bf16_t, WS_WMKV), MEMROWS, 2 * D, D, D, D}; pg8::OffsetOrder S; S.init(MEMROWS, 2 * D, F.G, F.bid, ((M / 256) * (NGU / 256)) % F.G);
          pg8::EpiMem E{F.out + OUT_MK, F.out + OUT_MV, WSP(pg8::bf16_t, WS_KM), WSP(pg8::bf16_t, WS_VT), WSP(const float, WS_SSQM)};
          pg8::gemm_phase<pg8::EpiMem, pg8::OffsetOrder, true, true>(ring, g, S, E); }
    } SEAM(1);
    if (IN(2)) {
        pg8::Gemm g{WSP(const pg8::bf16_t, WS_ACT), WSP(const pg8::bf16_t, WS_W1D), MP, D, FF, FF, FF}; pg8::StaticOrder S; S.init(MP, D, F.G, F.bid);
        pg8::EpiResid E{INP(I_XP), INP(I_XS), MP, X, WSP(pg8::bf16_t, WS_XB), 0.5f, nullptr, WSP(float, WS_SSQ1)};
        pg8::gemm_phase<pg8::EpiResid, pg8::StaticOrder, true, true>(ring, g, S, E);
        for (int u = F.bid; u < 256; u += F.G) skinny_resid(F, u, WSP(const bf16, WS_ACT) + (size_t)MP * FF, FF, WSP(const bf16, WS_W1D), FF, INP(I_XS), X + (size_t)MP * D, WSP(bf16, WS_XB) + (size_t)MP * D, 0.5f, nullptr, WSP(float, WS_SSQ1) + (size_t)MP * 16);
    } SEAM(2);
    if (IN(3)) {
        { pg8::Gemm g{XB, WSP(const pg8::bf16_t, WS_WIN), M, NIN + 256, D, D, D}; pg8::StaticOrder S; S.init(M, NIN + 256, F.G, F.bid);
          pg8::EpiProj E{WSP(pg8::bf16_t, WS_PROJ), NIN, WSP(const float, WS_SSQ1), WSP(float, WS_DTR)};
          pg8::gemm_phase<pg8::EpiProj, pg8::StaticOrder, true, true>(ring, g, S, E); }
    } SEAM(3);
    if (IN(4)) {
        for (int it = F.bid; it < BATCH * NCH * 2; it += F.G) mix_prompt_item(F, it >> 5, (it >> 1) & 15, it & 1);
        for (int it = F.bid; it < DEC_B * 2; it += F.G) mix_sample_item(F, it >> 1, it & 1);
    } SEAM(4);
    if (IN(5)) { scan_phase(F); } SEAM(5);
    if (IN(6)) { for (int it = F.bid; it < BATCH * NCH * 2; it += F.G) mixc_item(F, it >> 5, (it >> 1) & 15, it & 1);
                 for (int it = F.bid; it < MS / 64; it += F.G) sample_pool_rescale(F, it); } SEAM(6);
    if (IN(7)) {
        pg8::Gemm g{WSP(const pg8::bf16_t, WS_A2), WSP(const pg8::bf16_t, WS_WOUT), MP, D, D, D, D}; pg8::StaticOrder S; S.init(MP, D, F.G, F.bid);
        pg8::EpiResid E{X, X, M, X, WSP(pg8::bf16_t, WS_XB), alpha_ip, WSP(const float, WS_SSQY), WSP(float, WS_SSQ2)};
        pg8::gemm_phase<pg8::EpiResid, pg8::StaticOrder, true, true>(ring, g, S, E);
        for (int u = F.bid; u < 256; u += F.G) skinny_resid(F, u, WSP(const bf16, WS_A2) + (size_t)MP * D, D, WSP(const bf16, WS_WOUT), D, X + (size_t)MP * D, X + (size_t)MP * D, WSP(bf16, WS_XB) + (size_t)MP * D, alpha_ip, WSP(const float, WS_SSQY) + (size_t)MP * 16, WSP(float, WS_SSQ2) + (size_t)MP * 16);
    } SEAM(7);
    if (IN(8)) {
        pg8::Gemm g{XB, WSP(const pg8::bf16_t, WS_WQ), MP, D, D, D, D}; pg8::StaticOrder S; S.init(MP, D, F.G, F.bid);
        pg8::EpiRowBf16 E{WSP(pg8::bf16_t, WS_Q), D, WSP(const float, WS_SSQ2)};
        pg8::gemm_phase<pg8::EpiRowBf16, pg8::StaticOrder, true, true>(ring, g, S, E);
        for (int u = F.bid; u < 256; u += F.G) skinny_rowbf16(F, u, WSP(const bf16, WS_XB) + (size_t)MP * D, D, WSP(const bf16, WS_WQ), D, WSP(bf16, WS_Q) + (size_t)MP * D, WSP(const float, WS_SSQ2) + (size_t)MP * 16);
    } SEAM(8);
    if (IN(9)) {
        { pg8::Gemm g{WSP(const pg8::bf16_t, WS_Q), WSP(const pg8::bf16_t, WS_KM), MP, 256, K256, D, D}; pg8::AttnOrder<0> S; S.init(F.G, F.bid);
          pg8::EpiSoftmax E{WSP(pg8::bf16_t, WS_PB)};
          pg8::gemm_phase<pg8::EpiSoftmax, pg8::AttnOrder<0>, false, true>(ring, g, S, E); }
        for (int it = F.bid; it < DEC_B * 2; it += F.G) attn_sample_item(F, it >> 1, it & 1);
        WG_BAR();
    }
    if (IN(10)) {
        pg8::Gemm g{WSP(const pg8::bf16_t, WS_PB), WSP(const pg8::bf16_t, WS_VT), MP, 256, K256, D, 256}; pg8::AttnOrder<1> S; S.init(F.G, F.bid);
        pg8::EpiRowBf16 E{WSP(pg8::bf16_t, WS_O), D, nullptr};
        pg8::gemm_phase<pg8::EpiRowBf16, pg8::AttnOrder<1>, true, true>(ring, g, S, E);
    } SEAM(10);
    if (IN(11)) {
        pg8::Gemm g{WSP(const pg8::bf16_t, WS_O), WSP(const pg8::bf16_t, WS_WO), MP, D, D, D, D}; pg8::StaticOrder S; S.init(MP, D, F.G, F.bid);
        pg8::EpiResid E{X, X, M, X, WSP(pg8::bf16_t, WS_XB), alpha_ip, nullptr, WSP(float, WS_SSQ3)};
        pg8::gemm_phase<pg8::EpiResid, pg8::StaticOrder, true, true>(ring, g, S, E);
        for (int u = F.bid; u < 256; u += F.G) skinny_resid(F, u, WSP(const bf16, WS_O) + (size_t)MP * D, D, WSP(const bf16, WS_WO), D, X + (size_t)MP * D, X + (size_t)MP * D, WSP(bf16, WS_XB) + (size_t)MP * D, alpha_ip, nullptr, WSP(float, WS_SSQ3) + (size_t)MP * 16);
    } SEAM(11);
    if (IN(12)) {
        { pg8::Gemm g{XB, WSP(const pg8::bf16_t, WS_W2GU), M, NGU, D, D, D}; pg8::StaticOrder S; S.init(M, NGU, F.G, F.bid);
          pg8::EpiGateUp E{WSP(pg8::bf16_t, WS_ACT), FF, WSP(const float, WS_SSQ3)};
          pg8::gemm_phase<pg8::EpiGateUp, pg8::StaticOrder, true, true>(ring, g, S, E); }
    } SEAM(12);
    if (IN(13)) {
        pg8::Gemm g{WSP(const pg8::bf16_t, WS_ACT), WSP(const pg8::bf16_t, WS_W2D), MP, D, FF, FF, FF}; pg8::StaticOrder S; S.init(MP, D, F.G, F.bid);
        pg8::EpiResid E{X, X, M, F.out + OUT_Y, nullptr, 0.5f, nullptr, WSP(float, WS_SSQ4)};
        pg8::gemm_phase<pg8::EpiResid, pg8::StaticOrder, true, true>(ring, g, S, E);
        for (int u = F.bid; u < 256; u += F.G) skinny_resid(F, u, WSP(const bf16, WS_ACT) + (size_t)MP * FF, FF, WSP(const bf16, WS_W2D), FF, X + (size_t)MP * D, F.out + OUT_Y + (size_t)MP * D, nullptr, 0.5f, nullptr, WSP(float, WS_SSQ4) + (size_t)MP * 16);
    } SEAM(13);
    if (IN(14)) { final_norm_phase(F); }
#undef IN
#undef SEAM
}

extern "C" void kernel_launch(void* const* d_in, const int* in_sizes, int n_in, void* d_out, int out_size, void* d_ws, size_t ws_size, hipStream_t stream) {
    static int grid = 0;
    if (grid == 0) {
        if (n_in != 34 || out_size != (int)OUT_TOTAL || ws_size < WS_END) { fprintf(stderr, "kernel_launch: expected 34 inputs, %zu outputs, >= %zu bytes of workspace; got n_in %d, out %d, ws %zu; nothing launched\n", (size_t)OUT_TOTAL, (size_t)WS_END, n_in, out_size, ws_size); grid = -1; return; }
        int dev = 0, cus = 0, per_cu = 0;
        if (hipGetDevice(&dev) != hipSuccess || hipDeviceGetAttribute(&cus, hipDeviceAttributeMultiprocessorCount, dev) != hipSuccess) { fprintf(stderr, "kernel_launch: device query failed\n"); grid = -1; return; }
        if (hipFuncSetAttribute((const void*)mega_fwd, hipFuncAttributeMaxDynamicSharedMemorySize, LDS_BYTES) != hipSuccess) { fprintf(stderr, "kernel_launch: hipFuncSetAttribute failed\n"); grid = -1; return; }
        if (hipOccupancyMaxActiveBlocksPerMultiprocessor(&per_cu, (const void*)mega_fwd, NTHREADS, LDS_BYTES) != hipSuccess || per_cu < 1) { fprintf(stderr, "kernel_launch: occupancy query reports %d blocks per CU; nothing launched\n", per_cu); (void)hipGetLastError(); grid = -1; return; }
        grid = cus;
        if (grid != 256) { fprintf(stderr, "kernel_launch: this kernel is built for a 256-CU device (found %d CUs); nothing launched\n", cus); grid = -1; return; }
    }
    if (grid < 0) return;
    if (hipMemsetAsync((char*)d_ws + WS_CTL, 0, CTL_ZERO_BYTES, stream) != hipSuccess) { fprintf(stderr, "kernel_launch: hipMemsetAsync failed\n"); return; }
    Args a{};
    for (int i = 0; i < 34; ++i) a.in[i] = (const float*)d_in[i];
    a.out = (float*)d_out; a.ws = (unsigned char*)d_ws;
    if (N_LAUNCHES == 1) { a.ph_lo = 0; a.ph_hi = N_PHASES; a.li = 0; hipLaunchKernelGGL(mega_fwd, dim3(grid), dim3(NTHREADS), LDS_BYTES, stream, a); }
#ifndef HOSTDUP
#define HOSTDUP 0
#endif
#ifndef GRP_LO
#define GRP_LO 99
#define GRP_HI 99
#endif
    else for (int li = 0; li < N_PHASES; ++li) { a.ph_lo = li; a.ph_hi = li + 1; a.li = 0;
        for (int rep = 0; rep < (((HOSTDUP >> li) & 1) ? 2 : 1); ++rep) { a.pad = rep; hipLaunchKernelGGL(mega_fwd, dim3(grid), dim3(NTHREADS), LDS_BYTES, stream, a); } a.pad = 0;
        if (li == GRP_HI) for (int lj = GRP_LO; lj <= GRP_HI; ++lj) { a.ph_lo = lj; a.ph_hi = lj + 1; hipLaunchKernelGGL(mega_fwd, dim3(grid), dim3(NTHREADS), LDS_BYTES, stream, a); } }
    const hipError_t le = hipPeekAtLastError();
    if (le != hipSuccess) fprintf(stderr, "kernel_launch: launch failed: %s\n", hipGetErrorName(le));
}
```
